# Optimizing an MI355X kernel written in HIP

```python
import jax, jax.numpy as jnp
from jax import lax
import numpy as np

D_MODEL = 2048
BATCH = 4
SEQ = 2048
DEPTH = 4

CHUNK = 64
N_MIXERS = 4
D_FF = 4 * D_MODEL
NORM_EPS = 1e-6

RET_HEADS = 8
RET_DK = D_MODEL // RET_HEADS
RET_DV = 2 * D_MODEL // RET_HEADS
RET_IN = 2 * RET_HEADS * RET_DK + 2 * RET_HEADS * RET_DV
ROPE_BASE = 10000.0

GDN_HEADS = 16
GDN_DK = D_MODEL // GDN_HEADS
GDN_DV = D_MODEL // GDN_HEADS
GDN_QKV = GDN_HEADS * (2 * GDN_DK + GDN_DV)
GDN_IN = GDN_QKV + GDN_HEADS * GDN_DV + 2 * GDN_HEADS
CONV_WIDTH = 4

GLA_HEADS = 4
GLA_DK = D_MODEL // 2 // GLA_HEADS
GLA_DV = D_MODEL // GLA_HEADS
GLA_GATE_RANK = 16
GLA_TAU = 16.0
GLA_IN = 2 * GLA_HEADS * GLA_DK + 2 * GLA_HEADS * GLA_DV + GLA_GATE_RANK

LRU_WIDTH = D_MODEL
LRU_BLOCKS = 16
LRU_BLOCK = LRU_WIDTH // LRU_BLOCKS
LRU_C = 8.0

kernel_name = "interleaved_hybrid_chunk_causal_encoder"

F32 = jnp.float32


def _layers_of(m):
    return (DEPTH - m + N_MIXERS - 1) // N_MIXERS


def rmsnorm(x, g):
    xf = x.astype(F32)
    y = xf * lax.rsqrt(jnp.mean(xf * xf, axis=-1, keepdims=True) + NORM_EPS)
    return (y * g.astype(F32)).astype(x.dtype)


def head_norm(o, gain, center):
    of = o.astype(F32)
    if center:
        of = of - jnp.mean(of, axis=-1, keepdims=True)
    of = of * lax.rsqrt(jnp.mean(of * of, axis=-1, keepdims=True) + NORM_EPS)
    of = of * gain.astype(F32)
    return of.reshape(o.shape[0], o.shape[1], -1)


def l2norm(x):
    return x * lax.rsqrt(jnp.sum(x * x, axis=-1, keepdims=True) + NORM_EPS)


def causal_depthwise_conv(x, w):
    width, s = w.shape[0], x.shape[1]
    xp = jnp.pad(x, ((0, 0), (width - 1, 0), (0, 0)))
    out = xp[:, 0:s] * w[0]
    for tap in range(1, width):
        out = out + xp[:, tap:tap + s] * w[tap]
    return out


def to_chunks(x):
    b, s, h, d = x.shape
    return x.reshape(b, s // CHUNK, CHUNK, h, d).transpose(0, 3, 1, 2, 4)


def from_chunks(x):
    b, h, n, c, d = x.shape
    return x.transpose(0, 2, 3, 1, 4).reshape(b, n * c, h, d)


def scalar_chunks(x):
    b, s, h = x.shape
    return x.reshape(b, s // CHUNK, CHUNK, h).transpose(0, 3, 1, 2)


def rotary(x):
    s, d = x.shape[1], x.shape[-1]
    inv = ROPE_BASE ** (-jnp.arange(0, d, 2, dtype=F32) / d)
    ang = jnp.arange(s, dtype=F32)[:, None] * inv[None, :]
    cos, sin = jnp.cos(ang)[:, None, :], jnp.sin(ang)[:, None, :]
    x1, x2 = x[..., : d // 2], x[..., d // 2:]
    return jnp.concatenate([x1 * cos - x2 * sin, x1 * sin + x2 * cos], axis=-1)


def retention_mixer(h, w_in, gn_gain, w_out):
    b, s, _ = h.shape
    H, DK, DV = RET_HEADS, RET_DK, RET_DV
    q, k, v, g = jnp.split(h @ w_in, [H * DK, 2 * H * DK, 2 * H * DK + H * DV], axis=-1)
    q = rotary(q.astype(F32).reshape(b, s, H, DK))
    k = rotary(k.astype(F32).reshape(b, s, H, DK)) * DK ** -0.5
    v = v.astype(F32).reshape(b, s, H, DV)
    qc, kc, vc = to_chunks(q), to_chunks(k), to_chunks(v)
    log_gamma = jnp.log1p(-jnp.exp2(-5.0 - jnp.arange(H, dtype=F32)))
    pos = jnp.arange(CHUNK, dtype=F32)
    dist = jnp.abs(pos[:, None] - pos[None, :])
    decay_intra = jnp.exp(log_gamma[:, None, None] * dist)
    scores = jnp.einsum('bhncd,bhnmd->bhncm', qc, kc) * decay_intra[None, :, None]
    o_intra = jnp.einsum('bhncm,bhnmv->bhncv', scores, vc)
    q_decay = jnp.exp(log_gamma[:, None] * (pos + 1.0))[None, :, :, None]
    k_decay = jnp.exp(log_gamma[:, None] * (CHUNK - 1.0 - pos))[None, :, :, None]
    chunk_decay = jnp.exp(log_gamma * CHUNK)[None, :, None, None]

    def step(state, xs):
        q_n, k_n, v_n = xs
        o = jnp.einsum('bhcd,bhdv->bhcv', q_n * q_decay, state)
        state = state * chunk_decay + jnp.einsum('bhcd,bhcv->bhdv', k_n * k_decay, v_n)
        return state, o

    xs = (jnp.moveaxis(qc, 2, 0), jnp.moveaxis(kc, 2, 0), jnp.moveaxis(vc, 2, 0))
    _, o_inter = lax.scan(step, jnp.zeros((b, H, DK, DV), F32), xs)
    o = from_chunks(o_intra + jnp.moveaxis(o_inter, 0, 2))
    o = head_norm(o, gn_gain, center=True) * jax.nn.silu(g.astype(F32))
    return o.astype(h.dtype) @ w_out


def gated_deltanet_mixer(h, w_in, conv_w, a_log, dt_bias, norm_gain, w_out):
    b, s, _ = h.shape
    H, DK, DV = GDN_HEADS, GDN_DK, GDN_DV
    qkv, z, beta_logit, a_logit = jnp.split(
        h @ w_in, [GDN_QKV, GDN_QKV + H * DV, GDN_QKV + H * DV + H], axis=-1)
    qkv = jax.nn.silu(causal_depthwise_conv(qkv, conv_w)).astype(F32)
    q, k, v = jnp.split(qkv, [H * DK, 2 * H * DK], axis=-1)
    q = l2norm(q.reshape(b, s, H, DK)) * DK ** -0.5
    k = l2norm(k.reshape(b, s, H, DK))
    v = v.reshape(b, s, H, DV)
    beta = jax.nn.sigmoid(beta_logit.astype(F32))
    log_alpha = -jnp.exp(a_log.astype(F32)) * jax.nn.softplus(a_logit.astype(F32) + dt_bias.astype(F32))
    qc, kc, vc = to_chunks(q), to_chunks(k), to_chunks(v)
    beta_c = scalar_chunks(beta)
    cum = jnp.cumsum(scalar_chunks(log_alpha), axis=-1)
    idx = jnp.arange(CHUNK)
    strict = idx[:, None] > idx[None, :]
    rel = jnp.where(strict, jnp.exp(jnp.where(strict, cum[..., :, None] - cum[..., None, :], 0.0)), 0.0)
    a_mat = beta_c[..., :, None] * rel * jnp.einsum('bhncd,bhnmd->bhncm', kc, kc)
    l_mat = a_mat + jnp.eye(CHUNK, dtype=F32)
    rhs = jnp.concatenate([beta_c[..., None] * vc, (beta_c * jnp.exp(cum))[..., None] * kc], axis=-1)
    sol = lax.linalg.triangular_solve(l_mat, rhs, left_side=True, lower=True, unit_diagonal=True)
    u, w = sol[..., :DV], sol[..., DV:]
    k_end = kc * jnp.exp(cum[..., -1:] - cum)[..., None]
    trans = (jnp.exp(cum[..., -1])[..., None, None] * jnp.eye(DK, dtype=F32)
             - jnp.einsum('bhnck,bhncj->bhnkj', k_end, w))
    inject = jnp.einsum('bhnck,bhncv->bhnkv', k_end, u)

    def step(state, xs):
        t, g, q_n = xs
        state = jnp.einsum('bhkj,bhjv->bhkv', t, state) + g
        return state, jnp.einsum('bhck,bhkv->bhcv', q_n, state)

    xs = (jnp.moveaxis(trans, 2, 0), jnp.moveaxis(inject, 2, 0), jnp.moveaxis(qc, 2, 0))
    _, o = lax.scan(step, jnp.zeros((b, H, DK, DV), F32), xs)
    o = from_chunks(jnp.moveaxis(o, 0, 2))
    o = head_norm(o, norm_gain, center=False) * jax.nn.silu(z.astype(F32))
    return o.astype(h.dtype) @ w_out


def gla_mixer(h, w_in, w_gate_up, gate_bias, norm_gain, w_out):
    b, s, _ = h.shape
    H, DK, DV = GLA_HEADS, GLA_DK, GLA_DV
    QK, V = H * DK, H * DV
    q, k, v, r, gate_low = jnp.split(h @ w_in, [QK, 2 * QK, 2 * QK + V, 2 * QK + 2 * V], axis=-1)
    gate_logit = (gate_low @ w_gate_up + gate_bias).astype(F32)
    log_alpha = jax.nn.log_sigmoid(gate_logit) / GLA_TAU
    qc = to_chunks(q.astype(F32).reshape(b, s, H, DK)) * DK ** -0.5
    kc = to_chunks(k.astype(F32).reshape(b, s, H, DK))
    vc = to_chunks(v.astype(F32).reshape(b, s, H, DV))
    cum = jnp.cumsum(to_chunks(log_alpha.reshape(b, s, H, DK)), axis=-2)
    ref = cum[..., CHUNK // 2 - 1:CHUNK // 2, :]
    fwd, bwd = jnp.exp(cum - ref), jnp.exp(ref - cum)
    s_lo = jnp.einsum('bhnck,bhnmk->bhncm', qc * fwd, kc * bwd)
    s_up = jnp.einsum('bhnck,bhnmk->bhncm', qc * bwd, kc * fwd)
    idx = jnp.arange(CHUNK)
    scores = jnp.where(idx[:, None] >= idx[None, :], s_lo, s_up)
    o_intra = jnp.einsum('bhncm,bhnmv->bhncv', scores, vc)
    q_in = qc * jnp.exp(cum)
    k_end = kc * jnp.exp(cum[..., -1:, :] - cum)
    chunk_dec = jnp.exp(cum[..., -1, :])

    def step(state, xs):
        q_n, k_n, v_n, dec = xs
        o = jnp.einsum('bhck,bhkv->bhcv', q_n, state)
        state = state * dec[..., None] + jnp.einsum('bhck,bhcv->bhkv', k_n, v_n)
        return state, o

    xs = tuple(jnp.moveaxis(t, 2, 0) for t in (q_in, k_end, vc, chunk_dec))
    _, o_inter = lax.scan(step, jnp.zeros((b, H, DK, DV), F32), xs)
    o = from_chunks(o_intra + jnp.moveaxis(o_inter, 0, 2))
    o = head_norm(o, norm_gain, center=False) * jax.nn.silu(r.astype(F32))
    return o.astype(h.dtype) @ w_out


def rglru_mixer(h, w_in, conv_w, conv_b, w_rgate, b_rgate, w_igate, b_igate, lam, w_out):
    b, s, _ = h.shape
    xb, yb = jnp.split(h @ w_in, [LRU_WIDTH], axis=-1)
    yb = jax.nn.gelu(yb.astype(F32))
    xb = (causal_depthwise_conv(xb, conv_w) + conv_b).astype(F32)
    xblk = xb.reshape(b, s, LRU_BLOCKS, LRU_BLOCK)
    r = jax.nn.sigmoid(jnp.einsum('bsnd,nde->bsne', xblk, w_rgate.astype(F32)) + b_rgate.astype(F32))
    i = jax.nn.sigmoid(jnp.einsum('bsnd,nde->bsne', xblk, w_igate.astype(F32)) + b_igate.astype(F32))
    r, i = r.reshape(b, s, LRU_WIDTH), i.reshape(b, s, LRU_WIDTH)
    log_a = -LRU_C * jax.nn.softplus(-lam.astype(F32)) * r
    a = jnp.exp(log_a)
    u = jnp.sqrt(-jnp.expm1(2.0 * log_a)) * (i * xb)

    def combine(left, right):
        a_l, b_l = left
        a_r, b_r = right
        return a_l * a_r, a_r * b_l + b_r

    _, hs = lax.associative_scan(combine, (a, u), axis=1)
    return (hs * yb).astype(h.dtype) @ w_out


def squared_relu_mlp(h, w_up, w_down):
    return jnp.square(jax.nn.relu(h @ w_up)) @ w_down


def setup_inputs(seed: int = 0) -> dict:
    key = jax.random.key(seed)
    ks = iter(jax.random.split(key, 40))

    def nrm(shape, scale):
        return scale * jax.random.normal(next(ks), shape, F32)

    def uni(shape, lo, hi):
        return jax.random.uniform(next(ks), shape, F32, lo, hi)

    n_ret, n_gdn, n_gla, n_lru = (_layers_of(m) for m in range(N_MIXERS))
    d_in = D_MODEL ** -0.5
    dt = jnp.exp(uni((n_gdn, GDN_HEADS), float(np.log(1e-3)), float(np.log(1e-1))))
    a0 = uni((n_lru, LRU_WIDTH), 0.9, 0.999)
    s0 = a0 ** (1.0 / LRU_C)
    return {
        "x": nrm((BATCH, SEQ, D_MODEL), 1.0),
        "norm1": 1.0 + nrm((DEPTH, D_MODEL), 0.02),
        "norm2": 1.0 + nrm((DEPTH, D_MODEL), 0.02),
        "final_norm": 1.0 + nrm((D_MODEL,), 0.02),
        "ret_w_in": nrm((n_ret, D_MODEL, RET_IN), d_in),
        "ret_gn_gain": 1.0 + nrm((n_ret, RET_HEADS, RET_DV), 0.02),
        "ret_w_out": nrm((n_ret, RET_HEADS * RET_DV, D_MODEL), (RET_HEADS * RET_DV) ** -0.5),
        "gdn_w_in": nrm((n_gdn, D_MODEL, GDN_IN), d_in),
        "gdn_conv_w": nrm((n_gdn, CONV_WIDTH, GDN_QKV), CONV_WIDTH ** -0.5),
        "gdn_a_log": jnp.log(uni((n_gdn, GDN_HEADS), 1.0, 16.0)),
        "gdn_dt_bias": dt + jnp.log(-jnp.expm1(-dt)),
        "gdn_norm_gain": 1.0 + nrm((n_gdn, GDN_DV), 0.02),
        "gdn_w_out": nrm((n_gdn, GDN_HEADS * GDN_DV, D_MODEL), (GDN_HEADS * GDN_DV) ** -0.5),
        "gla_w_in": nrm((n_gla, D_MODEL, GLA_IN), d_in),
        "gla_w_gate_up": nrm((n_gla, GLA_GATE_RANK, GLA_HEADS * GLA_DK), GLA_GATE_RANK ** -0.5),
        "gla_gate_bias": nrm((n_gla, GLA_HEADS * GLA_DK), 0.1),
        "gla_norm_gain": 1.0 + nrm((n_gla, GLA_HEADS, GLA_DV), 0.02),
        "gla_w_out": nrm((n_gla, GLA_HEADS * GLA_DV, D_MODEL), (GLA_HEADS * GLA_DV) ** -0.5),
        "lru_w_in": nrm((n_lru, D_MODEL, 2 * LRU_WIDTH), d_in),
        "lru_conv_w": nrm((n_lru, CONV_WIDTH, LRU_WIDTH), CONV_WIDTH ** -0.5),
        "lru_conv_b": nrm((n_lru, LRU_WIDTH), 0.02),
        "lru_w_rgate": nrm((n_lru, LRU_BLOCKS, LRU_BLOCK, LRU_BLOCK), LRU_BLOCK ** -0.5),
        "lru_b_rgate": nrm((n_lru, LRU_BLOCKS, LRU_BLOCK), 0.02),
        "lru_w_igate": nrm((n_lru, LRU_BLOCKS, LRU_BLOCK, LRU_BLOCK), LRU_BLOCK ** -0.5),
        "lru_b_igate": nrm((n_lru, LRU_BLOCKS, LRU_BLOCK), 0.02),
        "lru_lambda": jnp.log(s0) - jnp.log1p(-s0),
        "lru_w_out": nrm((n_lru, LRU_WIDTH, D_MODEL), LRU_WIDTH ** -0.5),
        "mlp_w_up": nrm((DEPTH, D_MODEL, D_FF), d_in),
        "mlp_w_down": nrm((DEPTH, D_FF, D_MODEL), D_FF ** -0.5),
    }


def reference(x, norm1, norm2, final_norm,
              ret_w_in, ret_gn_gain, ret_w_out,
              gdn_w_in, gdn_conv_w, gdn_a_log, gdn_dt_bias, gdn_norm_gain, gdn_w_out,
              gla_w_in, gla_w_gate_up, gla_gate_bias, gla_norm_gain, gla_w_out,
              lru_w_in, lru_conv_w, lru_conv_b, lru_w_rgate, lru_b_rgate, lru_w_igate,
              lru_b_igate, lru_lambda, lru_w_out,
              mlp_w_up, mlp_w_down):
    for layer in range(DEPTH):
        m, j = layer % N_MIXERS, layer // N_MIXERS
        hn = rmsnorm(x, norm1[layer])
        if m == 0:
            y = retention_mixer(hn, ret_w_in[j], ret_gn_gain[j], ret_w_out[j])
        elif m == 1:
            y = gated_deltanet_mixer(hn, gdn_w_in[j], gdn_conv_w[j], gdn_a_log[j], gdn_dt_bias[j],
                                     gdn_norm_gain[j], gdn_w_out[j])
        elif m == 2:
            y = gla_mixer(hn, gla_w_in[j], gla_w_gate_up[j], gla_gate_bias[j], gla_norm_gain[j], gla_w_out[j])
        else:
            y = rglru_mixer(hn, lru_w_in[j], lru_conv_w[j], lru_conv_b[j], lru_w_rgate[j], lru_b_rgate[j],
                            lru_w_igate[j], lru_b_igate[j], lru_lambda[j], lru_w_out[j])
        x = x + y
        x = x + squared_relu_mlp(rmsnorm(x, norm2[layer]), mlp_w_up[layer], mlp_w_down[layer])
    return rmsnorm(x, final_norm)
```

```cpp
#include <hip/hip_runtime.h>
#include <hip/hip_cooperative_groups.h>
#include <cstdio>
#include <cstdint>
namespace cg = cooperative_groups;
#ifndef PH_RET
#define PH_RET 1
#endif
#ifndef PH_GDN
#define PH_GDN 1
#endif
#ifndef PH_GDN2
#define PH_GDN2 1
#endif
#ifndef PH_GLA
#define PH_GLA 1
#endif
#ifndef PH_LRU
#define PH_LRU 1
#endif
#ifndef PH_GEMM
#define PH_GEMM 1
#endif
#ifndef HBMAX
#define HBMAX 8
#endif
namespace pg8 {
#define PG8_LAS __attribute__((address_space(3)))
typedef unsigned short bf16_t;
typedef short bf16x8 __attribute__((ext_vector_type(8)));
typedef float f32x4 __attribute__((ext_vector_type(4)));
typedef unsigned u32x4 __attribute__((ext_vector_type(4)));
constexpr int BM = 256, BK = 64, HALF = 128, HTB = HALF * BK * 2  , STAGE_BYTES = 8 * HTB, NXCD = 8, WGM = 8;

__host__ __device__ __forceinline__ int lds_byte(int r, int c) { const int st = (r >> 4) * 2 + (c >> 5), rr = r & 15, cc = c & 31, ob = rr * 64 + cc * 2; return st * 1024 + (ob ^ (((ob >> 9) & 1) << 5)); }
__host__ __device__ __forceinline__ void stage_rc(int b, int& R, int& C) { const int st = b / 1024, sb = b % 1024, swz = sb ^ (((sb >> 9) & 1) << 5); R = (st >> 1) * 16 + swz / 64; C = (st & 1) * 32 + (swz % 64) / 2; }
__host__ __device__ __forceinline__ int perm32(int rho) { const int n = rho >> 4, i = rho & 15; return 8 * (i >> 2) + 4 * n + (i & 3); }

struct Unit { int pm, pn; };
struct Gemm { const bf16_t* A; const bf16_t* Bt; int M, N, K; };

struct StaticOrder {
    int nM, nN, nwg, G, c;
    __host__ __device__ void init(int M, int N, int G_, int c_) { nM = M / BM; nN = N / BM; nwg = nM * nN; G = G_; c = c_; }
    __host__ __device__ bool next(int i, Unit& u) const {
        const long L = (long)i * G + c; if (L >= nwg) return false;
        int wgid = (int)L; { const int q = nwg / NXCD, r = nwg % NXCD, xcd = wgid % NXCD, off = wgid / NXCD; wgid = (xcd < r ? xcd * (q + 1) : r * (q + 1) + (xcd - r) * q) + off; }
        const int nig = WGM * nN, gid = wgid / nig, fm = gid * WGM, gsz = (nM - fm) < WGM ? (nM - fm) : WGM;
        u.pm = fm + ((wgid % nig) % gsz); u.pn = (wgid % nig) / gsz; return true;
    }
    __device__ __forceinline__ void a_ready(const Unit&) const {}
    __device__ __forceinline__ void done(const Unit&) const {}
    __device__ __forceinline__ void a_finish() const {}
};
typedef __bf16 hwbf16x2 __attribute__((ext_vector_type(2)));
typedef float cvtf32x2 __attribute__((ext_vector_type(2)));
__device__ __forceinline__ unsigned cvt_pk_bf16(float lo, float hi) { cvtf32x2 v; v.x = lo; v.y = hi; hwbf16x2 b = __builtin_convertvector(v, hwbf16x2); return __builtin_bit_cast(unsigned, b); }
template <class Epi, class Sched, bool ALIGN_EPI = false, bool SP2 = false>
__device__ __forceinline__ void gemm_phase(PG8_LAS unsigned char* lds, const Gemm g, const Sched& S, const Epi& E) {
    int tid = threadIdx.x; asm volatile("" : "+v"(tid)); const int wid = __builtin_amdgcn_readfirstlane(tid >> 6), lane = tid & 63, wr = wid >> 2, wc = wid & 3, fr = lane & 15, fq = lane >> 4;
    const int K = g.K, nt = K / BK;
    unsigned voffA[2], voffB[2];
#pragma unroll
    for (int i = 0; i < 2; ++i) { int R, C; stage_rc(tid * 16 + i * 8192, R, C); const int Rb = Epi::PERM ? ((R & ~31) + perm32(R & 31)) : R;
        voffA[i] = (unsigned)(R * K + C) * 2u; voffB[i] = (unsigned)(Rb * K + C) * 2u; }
    const size_t kstep = (size_t)(BK * 2);
    const size_t hstep = (size_t)HALF * K * 2;
    const size_t tstep = 2 * hstep;
    const unsigned ldsw = (unsigned)wid * 1024u;
    const int aoff = lds_byte(wr * 64 + fr, fq * 8), boff = lds_byte(wc * 32 + fr, fq * 8);
#define PG8_SA(b, h) (((b) * 2 + (h)) * HTB)
#define PG8_SB(b, h) ((4 + (b) * 2 + (h)) * HTB)
#define PG8_STAGE(bufoff, gbase, voff) do { _Pragma("unroll") for (int _i = 0; _i < 2; ++_i) \
        __builtin_amdgcn_global_load_lds((const unsigned*)((const char*)(gbase) + (voff)[_i]), (PG8_LAS unsigned*)(lds + (bufoff) + ldsw + _i * 8192), 16, 0, 0); } while (0)
#define PG8_LDA(dst, b, h) do { _Pragma("unroll") for (int m = 0; m < 4; ++m) _Pragma("unroll") for (int k = 0; k < 2; ++k) dst[m][k] = *(const PG8_LAS bf16x8*)(lds + PG8_SA(b, h) + aoff + m * 2048 + k * 1024); } while (0)
#define PG8_LDB(dst, b, h) do { _Pragma("unroll") for (int n = 0; n < 2; ++n) _Pragma("unroll") for (int k = 0; k < 2; ++k) dst[n][k] = *(const PG8_LAS bf16x8*)(lds + PG8_SB(b, h) + boff + n * 2048 + k * 1024); } while (0)
#define PG8_MMA(ai, bj, At, Bt) do { __builtin_amdgcn_s_setprio(1); _Pragma("unroll") for (int m = 0; m < 4; ++m) _Pragma("unroll") for (int n = 0; n < 2; ++n) _Pragma("unroll") for (int k = 0; k < 2; ++k) \
        acc[ai][bj][m][n] = __builtin_amdgcn_mfma_f32_16x16x32_bf16(Bt[n][k], At[m][k], acc[ai][bj][m][n], 0, 0, 0); __builtin_amdgcn_s_setprio(0); } while (0)
#define PG8_WAIT_V(n) asm volatile("s_waitcnt vmcnt(" #n ")" ::: "memory")
#define PG8_WAIT_L(n) asm volatile("s_waitcnt lgkmcnt(" #n ")" ::: "memory")
#define PG8_BAR __builtin_amdgcn_s_barrier()
#define PG8_SCHED __builtin_amdgcn_sched_barrier(0)
    Unit cur, nxt; int ui = 0;
    if (!S.next(0, cur)) return;
    f32x4 acc[2][2][4][2];
#pragma unroll
    for (int a = 0; a < 2; ++a)
#pragma unroll
        for (int b = 0; b < 2; ++b)
#pragma unroll
            for (int m = 0; m < 4; ++m)
#pragma unroll
                for (int n = 0; n < 2; ++n) acc[a][b][m][n] = (f32x4){0.f, 0.f, 0.f, 0.f};
    bf16x8 At[4][2], B0[2][2], B1[2][2];
    const char* cA = (const char*)g.A + (size_t)cur.pm * tstep; const char* cB = (const char*)g.Bt + (size_t)cur.pn * tstep;
    S.a_ready(cur); S.a_finish();
    if constexpr (SP2) {
        PG8_STAGE(PG8_SB(0, 0), cB, voffB); PG8_STAGE(PG8_SB(0, 1), cB + hstep, voffB); PG8_STAGE(PG8_SA(0, 0), cA, voffA); PG8_STAGE(PG8_SA(0, 1), cA + hstep, voffA);
        if (wr == 1) PG8_BAR;
        PG8_WAIT_V(2); PG8_BAR;
        PG8_STAGE(PG8_SB(1, 0), cB + kstep, voffB); PG8_STAGE(PG8_SA(1, 0), cA + kstep, voffA); PG8_STAGE(PG8_SB(1, 1), cB + hstep + kstep, voffB);
        PG8_WAIT_V(6); PG8_BAR;
    } else {
        PG8_STAGE(PG8_SB(0, 0), cB, voffB); PG8_STAGE(PG8_SA(0, 0), cA, voffA); PG8_STAGE(PG8_SB(0, 1), cB + hstep, voffB); PG8_STAGE(PG8_SA(0, 1), cA + hstep, voffA);
        if (wr == 1) PG8_BAR;
        PG8_WAIT_V(4); PG8_BAR;
        PG8_STAGE(PG8_SB(1, 0), cB + kstep, voffB); PG8_STAGE(PG8_SA(1, 0), cA + kstep, voffA); PG8_STAGE(PG8_SB(1, 1), cB + hstep + kstep, voffB);
        PG8_WAIT_V(6); PG8_BAR;
    }
    for (;;) {
        const bool has_next = S.next(ui + 1, nxt);
        const char* nA = has_next ? (const char*)g.A + (size_t)nxt.pm * tstep : cA; const char* nB = has_next ? (const char*)g.Bt + (size_t)nxt.pn * tstep : cB;
        for (int t = 0; t < nt; t += 2) {
            const bool last = (t == nt - 2);
            const char* a1 = cA + (size_t)(t + 1) * kstep;
            const char* a2 = last ? nA : cA + (size_t)(t + 2) * kstep; const char* b2 = last ? nB : cB + (size_t)(t + 2) * kstep;
            const char* a3 = a2 + kstep; const char* b3 = b2 + kstep;
            if (last && has_next) S.a_ready(nxt);
            if constexpr (SP2) {
            PG8_LDB(B0, 0, 0); PG8_LDB(B1, 0, 1); PG8_SCHED; PG8_LDA(At, 0, 0); PG8_STAGE(PG8_SA(1, 1), a1 + hstep, voffA);
            PG8_WAIT_V(8); PG8_WAIT_L(0); PG8_BAR; PG8_MMA(0, 0, At, B0); PG8_MMA(0, 1, At, B1); PG8_BAR; PG8_SCHED;
            PG8_LDA(At, 0, 1); PG8_STAGE(PG8_SB(0, 0), b2, voffB); PG8_STAGE(PG8_SB(0, 1), b2 + hstep, voffB); PG8_STAGE(PG8_SA(0, 0), a2, voffA);
            PG8_WAIT_V(8); PG8_WAIT_L(0); PG8_BAR; PG8_MMA(1, 0, At, B0); PG8_MMA(1, 1, At, B1); PG8_BAR; PG8_SCHED;
            PG8_LDB(B0, 1, 0); PG8_LDB(B1, 1, 1); PG8_SCHED; PG8_LDA(At, 1, 0); PG8_STAGE(PG8_SA(0, 1), a2 + hstep, voffA);
            PG8_WAIT_V(8); PG8_WAIT_L(0); PG8_BAR; PG8_MMA(0, 0, At, B0); PG8_MMA(0, 1, At, B1); PG8_BAR; PG8_SCHED;
            PG8_LDA(At, 1, 1); PG8_STAGE(PG8_SB(1, 0), b3, voffB); PG8_STAGE(PG8_SB(1, 1), b3 + hstep, voffB); PG8_STAGE(PG8_SA(1, 0), a3, voffA);
            PG8_WAIT_V(8); PG8_WAIT_L(0); PG8_BAR; PG8_MMA(1, 0, At, B0); PG8_MMA(1, 1, At, B1); PG8_BAR; PG8_SCHED;
            if (last && has_next) S.a_finish();
            } else {
            PG8_LDB(B0, 0, 0); PG8_SCHED; PG8_LDA(At, 0, 0); PG8_STAGE(PG8_SA(1, 1), a1 + hstep, voffA);
            PG8_WAIT_L(8); PG8_BAR; PG8_WAIT_L(0); PG8_MMA(0, 0, At, B0); PG8_BAR; PG8_SCHED;
            PG8_LDB(B1, 0, 1); PG8_STAGE(PG8_SB(0, 0), b2, voffB);
            PG8_BAR; PG8_WAIT_L(0); PG8_MMA(0, 1, At, B1); PG8_BAR;
            PG8_LDA(At, 0, 1); PG8_STAGE(PG8_SA(0, 0), a2, voffA);
            PG8_BAR; PG8_WAIT_L(0); PG8_MMA(1, 0, At, B0); PG8_BAR; PG8_SCHED;
            PG8_STAGE(PG8_SB(0, 1), b2 + hstep, voffB);
            PG8_WAIT_V(6); PG8_BAR; PG8_MMA(1, 1, At, B1); PG8_BAR;
            PG8_LDB(B0, 1, 0); PG8_SCHED; PG8_LDA(At, 1, 0); PG8_STAGE(PG8_SA(0, 1), a2 + hstep, voffA);
            PG8_WAIT_L(8); PG8_BAR; PG8_WAIT_L(0); PG8_MMA(0, 0, At, B0); PG8_BAR; PG8_SCHED;
            PG8_LDB(B1, 1, 1); PG8_STAGE(PG8_SB(1, 0), b3, voffB);
            PG8_BAR; PG8_WAIT_L(0); PG8_MMA(0, 1, At, B1); PG8_BAR;
            PG8_LDA(At, 1, 1); PG8_STAGE(PG8_SA(1, 0), a3, voffA);
            PG8_BAR; PG8_WAIT_L(0); PG8_MMA(1, 0, At, B0); PG8_BAR; PG8_SCHED;
            PG8_STAGE(PG8_SB(1, 1), b3 + hstep, voffB);
            PG8_WAIT_V(6); PG8_BAR; PG8_MMA(1, 1, At, B1); PG8_BAR;
            }
        }
        if constexpr (ALIGN_EPI) { if (wr == 0) PG8_BAR; }
        if constexpr (!Epi::AFTER_DRAIN) { E(acc, cur, wr, wc, fr, fq); S.done(cur); }
        if (!has_next) break;
#pragma unroll
        for (int a = 0; a < 2; ++a)
#pragma unroll
            for (int b = 0; b < 2; ++b)
#pragma unroll
                for (int m = 0; m < 4; ++m)
#pragma unroll
                    for (int n = 0; n < 2; ++n) acc[a][b][m][n] = (f32x4){0.f, 0.f, 0.f, 0.f};
        cur = nxt; cA = nA; cB = nB; ++ui;
        if constexpr (ALIGN_EPI) { if (wr == 1) PG8_BAR; }
    }
    PG8_WAIT_V(0);
    if constexpr (!ALIGN_EPI) { if (wr == 0) PG8_BAR; }
    PG8_BAR;
    if constexpr (Epi::AFTER_DRAIN) { E.fused(acc, cur, wr, wc, fr, fq, lds, wid, lane); S.done(cur); }
#undef PG8_SA
#undef PG8_SB
#undef PG8_STAGE
#undef PG8_LDA
#undef PG8_LDB
#undef PG8_MMA
#undef PG8_WAIT_V
#undef PG8_WAIT_L
#undef PG8_BAR
#undef PG8_SCHED
}

typedef unsigned u32x2 __attribute__((ext_vector_type(2)));
struct EpiBf {
    static constexpr bool PERM = true, AFTER_DRAIN = false;
    bf16_t* O; int ldo; float* SM; int slo, shi, relu2;
    const PG8_LAS float* ldsr; mutable int ne;
    __device__ __forceinline__ void operator()(const f32x4 (&acc)[2][2][4][2], const Unit& u, int wr, int wc, int fr, int fq) const {
        const int row0 = u.pm * BM + wr * 64 + fr, col0 = u.pn * BM + wc * 32 + 8 * fq;
        const PG8_LAS float* rsl = ldsr + (ne & 1) * 256 + wr * 64 + fr; ++ne;
#pragma unroll
        for (int ai = 0; ai < 2; ++ai)
#pragma unroll
            for (int m = 0; m < 4; ++m) { const size_t row = (size_t)(row0 + ai * HALF + m * 16); const float rs = rsl[ai * HALF + m * 16];
#pragma unroll
                for (int bj = 0; bj < 2; ++bj) { const int col = col0 + bj * HALF; f32x4 v0 = acc[ai][bj][m][0] * rs, v1 = acc[ai][bj][m][1] * rs;
                    if (relu2) { v0[0] = fmaxf(v0[0], 0.f); v0[1] = fmaxf(v0[1], 0.f); v0[2] = fmaxf(v0[2], 0.f); v0[3] = fmaxf(v0[3], 0.f); v0 = v0 * v0;
                                 v1[0] = fmaxf(v1[0], 0.f); v1[1] = fmaxf(v1[1], 0.f); v1[2] = fmaxf(v1[2], 0.f); v1[3] = fmaxf(v1[3], 0.f); v1 = v1 * v1; }
                    u32x4 o; o.x = cvt_pk_bf16(v0[0], v0[1]); o.y = cvt_pk_bf16(v0[2], v0[3]); o.z = cvt_pk_bf16(v1[0], v1[1]); o.w = cvt_pk_bf16(v1[2], v1[3]);
                    *(u32x4*)(O + row * ldo + col) = o;
                    if (col >= slo && col < shi) { *(f32x4*)(SM + row * 32 + (col - slo)) = v0; *(f32x4*)(SM + row * 32 + (col - slo) + 4) = v1; } } }
    }
};
struct EpiRes {
    static constexpr bool PERM = true, AFTER_DRAIN = false;
    float* X; int ldx; bf16_t* XG; const float* g; float* RSS;
    __device__ __forceinline__ void operator()(const f32x4 (&acc)[2][2][4][2], const Unit& u, int wr, int wc, int fr, int fq) const {
        const int row0 = u.pm * BM + wr * 64 + fr, col0 = u.pn * BM + wc * 32 + 8 * fq;
        f32x4 gv[2][2];
#pragma unroll
        for (int bj = 0; bj < 2; ++bj)
#pragma unroll
            for (int n = 0; n < 2; ++n) gv[bj][n] = *(const f32x4*)(g + col0 + bj * HALF + 4 * n);
#pragma unroll
        for (int ai = 0; ai < 2; ++ai)
#pragma unroll
            for (int m = 0; m < 4; ++m) { const size_t row = (size_t)(row0 + ai * HALF + m * 16); float* rowp = X + row * ldx + col0; bf16_t* gp = XG + row * ldx + col0; float ss = 0.f;
#pragma unroll
                for (int bj = 0; bj < 2; ++bj) { f32x4* p = (f32x4*)(rowp + bj * HALF);
                    const f32x4 x0 = p[0] + acc[ai][bj][m][0], x1 = p[1] + acc[ai][bj][m][1]; p[0] = x0; p[1] = x1;
                    ss += ((x0[0] * x0[0] + x0[1] * x0[1]) + (x0[2] * x0[2] + x0[3] * x0[3])) + ((x1[0] * x1[0] + x1[1] * x1[1]) + (x1[2] * x1[2] + x1[3] * x1[3]));
                    const f32x4 y0 = x0 * gv[bj][0], y1 = x1 * gv[bj][1];
                    u32x4 o; o.x = cvt_pk_bf16(y0[0], y0[1]); o.y = cvt_pk_bf16(y0[2], y0[3]); o.z = cvt_pk_bf16(y1[0], y1[1]); o.w = cvt_pk_bf16(y1[2], y1[3]); *(u32x4*)(gp + bj * HALF) = o; }
                ss += __shfl_xor(ss, 16); ss += __shfl_xor(ss, 32);
                if (fq == 0) RSS[row * 32 + u.pn * 4 + wc] = ss; }
    }
};
struct RstdOrder : StaticOrder {
    const float* RSS; PG8_LAS float* ldsr; mutable int na; mutable f32x4 ra, rb, rc, rd;
    __device__ __forceinline__ void a_ready(const Unit& u) const {
        int tid = threadIdx.x; asm volatile("" : "+v"(tid));
        const int rowl = (tid >> 6) * 32 + ((tid & 63) >> 1), half = tid & 1;
        const f32x4* p = (const f32x4*)(RSS + (size_t)(u.pm * BM + rowl) * 32 + 16 * half);
        ra = p[0]; rb = p[1]; rc = p[2]; rd = p[3];
    }
    __device__ __forceinline__ void a_finish() const {
        int tid = threadIdx.x; asm volatile("" : "+v"(tid));
        const int rowl = (tid >> 6) * 32 + ((tid & 63) >> 1), half = tid & 1;
        const f32x4 a = ra, b = rb, c = rc, d = rd;
        float s = (((a[0] + a[1]) + (a[2] + a[3])) + ((b[0] + b[1]) + (b[2] + b[3]))) + (((c[0] + c[1]) + (c[2] + c[3])) + ((d[0] + d[1]) + (d[2] + d[3])));
        s += __shfl_xor(s, 1);
        if (half == 0) ldsr[(na & 1) * 256 + rowl] = rsqrtf(s * (1.f / 2048.f) + 1e-6f);
        ++na;
    }
};
}

#define LAS __attribute__((address_space(3)))
typedef unsigned short bf16_t;
typedef short bf16x8 __attribute__((ext_vector_type(8)));
typedef float f32x4 __attribute__((ext_vector_type(4)));
typedef float f32x16 __attribute__((ext_vector_type(16)));
typedef unsigned u32x4 __attribute__((ext_vector_type(4)));
typedef unsigned u32x2 __attribute__((ext_vector_type(2)));

constexpr int T = 8192, D = 2048, FF = 8192, NTHR = 512;
constexpr int LDS_BYTES = 163840;
constexpr int NP_RET = 12288, NP_GDN = 8448, NP_GLA = 6400, NP_LRU = 4096;
constexpr size_t SZ_L = 33554432ull;
constexpr size_t OFF_WT_RET_IN = 0;
constexpr size_t OFF_WT_RET_OUT = OFF_WT_RET_IN + (size_t)NP_RET * D * 2;
constexpr size_t OFF_WT_GDN_IN = OFF_WT_RET_OUT + (size_t)D * 4096 * 2;
constexpr size_t OFF_WT_GDN_OUT = OFF_WT_GDN_IN + (size_t)NP_GDN * D * 2;
constexpr size_t OFF_WT_GLA_IN = OFF_WT_GDN_OUT + (size_t)D * D * 2;
constexpr size_t OFF_WT_GLA_OUT = OFF_WT_GLA_IN + (size_t)NP_GLA * D * 2;
constexpr size_t OFF_WT_LRU_IN = OFF_WT_GLA_OUT + (size_t)D * D * 2;
constexpr size_t OFF_WT_LRU_OUT = OFF_WT_LRU_IN + (size_t)NP_LRU * D * 2;
constexpr size_t OFF_WT_LRU_GR = OFF_WT_LRU_OUT + (size_t)D * D * 2;
constexpr size_t OFF_WT_LRU_GI = OFF_WT_LRU_GR + 16ull * 128 * 128 * 2;
constexpr size_t OFF_WT_UP = OFF_WT_LRU_GI + 16ull * 128 * 128 * 2;
constexpr size_t OFF_WT_DOWN = OFF_WT_UP + 4 * SZ_L;
constexpr size_t OFF_ROPE = OFF_WT_DOWN + 4 * SZ_L;
constexpr size_t OFF_XN = OFF_ROPE + 2ull * 2048 * 128 * 4;
constexpr size_t OFF_PROJ = OFF_XN + SZ_L;
constexpr size_t OFF_SM = OFF_PROJ + (size_t)T * NP_RET * 2;
constexpr size_t OFF_O = OFF_SM + (size_t)T * 32 * 4;
constexpr size_t OFF_ON = OFF_O + (size_t)T * 4096 * 4;
constexpr size_t OFF_GQ = OFF_ON + (size_t)T * 4096 * 2;
constexpr size_t OFF_GKE = OFF_GQ + SZ_L;
constexpr size_t OFF_GU = OFF_GKE + SZ_L;
constexpr size_t OFF_GW = OFF_GU + SZ_L;
constexpr size_t OFF_GG = OFF_GW + SZ_L;
constexpr size_t OFF_BAR = OFF_GG + 2048 * 4;
constexpr size_t OFF_RSS = OFF_BAR + 16384;
constexpr size_t WS_END = OFF_RSS + (size_t)T * 32 * 4;

__constant__ float LOGG[8] = {-0.0317486983145803f, -0.015748356968139168f, -0.007843177461025893f, -0.003913899321136329f,
                              -0.0019550348358033506f, -0.0009770396478266127f, -0.0004884004981088745f, -0.0002441704321739145f};

#define LDS_WAIT() asm volatile("s_waitcnt lgkmcnt(0)" ::: "memory")
__device__ __forceinline__ unsigned pk(float lo, float hi) { return pg8::cvt_pk_bf16(lo, hi); }
__device__ __forceinline__ bf16_t bf1(float v) { return (bf16_t)(pg8::cvt_pk_bf16(v, 0.f) & 0xffffu); }
__device__ __forceinline__ float bflo(unsigned v) { return __uint_as_float(v << 16); }
__device__ __forceinline__ float bfhi(unsigned v) { return __uint_as_float(v & 0xffff0000u); }
__device__ __forceinline__ float bf2f(bf16_t b) { return __uint_as_float(((unsigned)b) << 16); }
__device__ __forceinline__ float wave_sum(float v) {
#pragma unroll
    for (int o = 1; o < 64; o <<= 1) v += __shfl_xor(v, o);
    return v;
}
__device__ __forceinline__ float sigmoidf_(float x) { return __builtin_amdgcn_rcpf(1.f + __expf(-x)); }
__device__ __forceinline__ float siluf_(float x) { return x * __builtin_amdgcn_rcpf(1.f + __expf(-x)); }
#define ROWMAP(reg, hh) (((reg) & 3) + 8 * ((reg) >> 2) + 4 * (hh))

__device__ __forceinline__ void mma32(f32x16& acc, const LAS bf16_t* A, int lda, const LAS bf16_t* B, int ldb, int K, int lane) {
    const int r = lane & 31, h = lane >> 5;
    const LAS bf16_t* pa = A + r * lda + 8 * h; const LAS bf16_t* pb = B + r * ldb + 8 * h;
#pragma unroll 4
    for (int k = 0; k < K; k += 16) {
        const bf16x8 a = *(const LAS bf16x8*)(pa + k), b = *(const LAS bf16x8*)(pb + k);
        acc = __builtin_amdgcn_mfma_f32_32x32x16_bf16(a, b, acc, 0, 0, 0);
    }
}
__device__ __forceinline__ void mma32d(f32x16& acc, const LAS bf16_t* A, int lda, const LAS bf16_t* B, int ldb, int K, int lane) {
    const int r = lane & 31, h = lane >> 5;
    const LAS bf16_t* pa = A + r * lda + 8 * h; const LAS bf16_t* pb = B + r * ldb + 8 * h;
    f32x16 acc1;
#pragma unroll
    for (int i = 0; i < 16; ++i) acc1[i] = 0.f;
#pragma unroll 2
    for (int k = 0; k < K; k += 32) {
        const bf16x8 a0 = *(const LAS bf16x8*)(pa + k), b0 = *(const LAS bf16x8*)(pb + k), a1 = *(const LAS bf16x8*)(pa + k + 16), b1 = *(const LAS bf16x8*)(pb + k + 16);
        acc = __builtin_amdgcn_mfma_f32_32x32x16_bf16(a0, b0, acc, 0, 0, 0);
        acc1 = __builtin_amdgcn_mfma_f32_32x32x16_bf16(a1, b1, acc1, 0, 0, 0);
    }
    acc = acc + acc1;
}
__device__ __forceinline__ f32x16 zero16() { f32x16 z;
#pragma unroll
    for (int i = 0; i < 16; ++i) z[i] = 0.f; return z; }

struct Params { const float* in[29]; float* out; unsigned char* ws; };
template <int I> __device__ __forceinline__ const float* inptr() {
    const unsigned long long ka = (unsigned long long)__builtin_amdgcn_kernarg_segment_ptr();
    unsigned long long v;
    asm volatile("s_load_dwordx2 %0, %1, %2\n\ts_waitcnt lgkmcnt(0)" : "=&s"(v) : "s"(ka), "n"(I * 8) : "memory");
    return (const float*)(const __attribute__((address_space(1))) float*)v;
}

struct TDesc { const float* W; bf16_t* WT; int K, N, nblk, item; };
__device__ __forceinline__ void t_load(const TDesc& d, int lane, f32x4 (&v)[8]) {
    const int kb = d.item / d.nblk, nb = d.item - kb * d.nblk, k0 = 64 * kb, n0 = 32 * nb;
    const int n = n0 + 4 * (lane & 7); const bool ok = n < d.N;
#pragma unroll
    for (int i = 0; i < 8; ++i) { const int kk = 8 * i + (lane >> 3); v[i] = ok ? *(const f32x4*)(d.W + (size_t)(k0 + kk) * d.N + n) : (f32x4){0.f, 0.f, 0.f, 0.f}; }
}
__device__ __forceinline__ void t_store(const TDesc& d, LAS float* scr, int lane, const f32x4 (&v)[8]) {
    const int kb = d.item / d.nblk, nb = d.item - kb * d.nblk, k0 = 64 * kb, n0 = 32 * nb;
#pragma unroll
    for (int i = 0; i < 8; ++i) { const int kk = 8 * i + (lane >> 3); LAS float* q = scr + kk * 33 + 4 * (lane & 7); q[0] = v[i][0]; q[1] = v[i][1]; q[2] = v[i][2]; q[3] = v[i][3]; }
    LDS_WAIT();
    const int c = lane & 7;
#pragma unroll
    for (int j = 0; j < 4; ++j) { const int nn = (lane >> 3) + 8 * j; const LAS float* s = scr + (8 * c) * 33 + nn;
        u32x4 o; o.x = pk(s[0 * 33], s[1 * 33]); o.y = pk(s[2 * 33], s[3 * 33]); o.z = pk(s[4 * 33], s[5 * 33]); o.w = pk(s[6 * 33], s[7 * 33]);
        *(u32x4*)(d.WT + (size_t)(n0 + nn) * d.K + k0 + 8 * c) = o; }
    LDS_WAIT();
}
constexpr int I_RET_IN = (D / 64) * (NP_RET / 32), I_RET_OUT = (4096 / 64) * (D / 32), I_GDN_IN = (D / 64) * (NP_GDN / 32), I_SQ = (D / 64) * (D / 32),
              I_GLA_IN = (D / 64) * (NP_GLA / 32), I_LRU_IN = (D / 64) * (NP_LRU / 32), I_G = 16 * 8, I_UP = (D / 64) * (FF / 32), I_DN = (FF / 64) * (D / 32);
constexpr int NITEMS_A = I_RET_IN;
constexpr int NITEMS_C = I_GDN_IN + I_SQ + 2 * I_UP + 2 * I_DN + I_RET_OUT;
constexpr int NITEMS_B = I_GLA_IN + I_SQ + I_LRU_IN + I_SQ + 2 * I_G + 2 * I_UP + 2 * I_DN;
__device__ __forceinline__ TDesc p0_desc_a(unsigned char* ws, int it) {
    return TDesc{inptr<4>(), (bf16_t*)(ws + OFF_WT_RET_IN), D, 12288, NP_RET / 32, it};
}
__device__ __forceinline__ TDesc p0_desc_c(unsigned char* ws, int it) {
    int r = it;
    if (r < I_RET_OUT) return TDesc{inptr<6>(), (bf16_t*)(ws + OFF_WT_RET_OUT), 4096, D, D / 32, r}; r -= I_RET_OUT;
    if (r < 2 * I_UP) { const int l = r / I_UP; return TDesc{inptr<27>() + (size_t)l * D * FF, (bf16_t*)(ws + OFF_WT_UP + l * SZ_L), D, FF, FF / 32, r - l * I_UP}; } r -= 2 * I_UP;
    if (r < 2 * I_DN) { const int l = r / I_DN; return TDesc{inptr<28>() + (size_t)l * D * FF, (bf16_t*)(ws + OFF_WT_DOWN + l * SZ_L), FF, D, D / 32, r - l * I_DN}; } r -= 2 * I_DN;
    if (r < I_GDN_IN) return TDesc{inptr<7>(), (bf16_t*)(ws + OFF_WT_GDN_IN), D, 8224, NP_GDN / 32, r}; r -= I_GDN_IN;
    return TDesc{inptr<12>(), (bf16_t*)(ws + OFF_WT_GDN_OUT), D, D, D / 32, r};
}
constexpr int NITEMS_B2 = I_GLA_IN + I_SQ + I_UP + I_DN;
constexpr int NITEMS_B3 = I_LRU_IN + I_SQ + 2 * I_G + I_UP + I_DN;
__device__ __forceinline__ TDesc p0_desc_b2(unsigned char* ws, int it) {
    int r = it;
    if (r < I_GLA_IN) return TDesc{inptr<13>(), (bf16_t*)(ws + OFF_WT_GLA_IN), D, 6160, NP_GLA / 32, r}; r -= I_GLA_IN;
    if (r < I_SQ) return TDesc{inptr<17>(), (bf16_t*)(ws + OFF_WT_GLA_OUT), D, D, D / 32, r}; r -= I_SQ;
    if (r < I_UP) return TDesc{inptr<27>() + (size_t)2 * D * FF, (bf16_t*)(ws + OFF_WT_UP + 2 * SZ_L), D, FF, FF / 32, r}; r -= I_UP;
    return TDesc{inptr<28>() + (size_t)2 * D * FF, (bf16_t*)(ws + OFF_WT_DOWN + 2 * SZ_L), FF, D, D / 32, r};
}
__device__ __forceinline__ TDesc p0_desc_b3(unsigned char* ws, int it) {
    int r = it;
    if (r < I_LRU_IN) return TDesc{inptr<18>(), (bf16_t*)(ws + OFF_WT_LRU_IN), D, 4096, NP_LRU / 32, r}; r -= I_LRU_IN;
    if (r < I_SQ) return TDesc{inptr<26>(), (bf16_t*)(ws + OFF_WT_LRU_OUT), D, D, D / 32, r}; r -= I_SQ;
    if (r < I_G) { const int blk = r >> 3; return TDesc{inptr<21>() + blk * 16384, (bf16_t*)(ws + OFF_WT_LRU_GR) + blk * 16384, 128, 128, 4, r & 7}; } r -= I_G;
    if (r < I_G) { const int blk = r >> 3; return TDesc{inptr<23>() + blk * 16384, (bf16_t*)(ws + OFF_WT_LRU_GI) + blk * 16384, 128, 128, 4, r & 7}; } r -= I_G;
    if (r < I_UP) return TDesc{inptr<27>() + (size_t)3 * D * FF, (bf16_t*)(ws + OFF_WT_UP + 3 * SZ_L), D, FF, FF / 32, r}; r -= I_UP;
    return TDesc{inptr<28>() + (size_t)3 * D * FF, (bf16_t*)(ws + OFF_WT_DOWN + 3 * SZ_L), FF, D, D / 32, r};
}
__device__ __forceinline__ void p0_phase(const Params& p, LAS unsigned char* lds, int gw, int NGW, int wave, int lane) {
    LAS float* scr = (LAS float*)(lds + wave * 16384);
    unsigned char* ws = p.ws;
    constexpr int NITEMS = NITEMS_A;
#define p0_desc p0_desc_a
    if (gw < NITEMS) { int it = gw; TDesc d = p0_desc(ws, it); f32x4 v[8]; t_load(d, lane, v);
        for (;;) { const int itn = it + NGW; const bool more = itn < NITEMS; TDesc dn = d; f32x4 vn[8];
            if (more) { dn = p0_desc(ws, itn); t_load(dn, lane, vn); }
            t_store(d, scr, lane, v);
            if (!more) break;
            d = dn; it = itn;
#pragma unroll
            for (int i = 0; i < 8; ++i) v[i] = vn[i]; } }
#undef p0_desc
    { float* rss = (float*)(ws + OFF_RSS); for (int i = gw * 64 + lane; i < T * 32; i += NGW * 64) rss[i] = ((i & 31) == 0) ? 2047.997952f : 0.f; }
    float* rc = (float*)(ws + OFF_ROPE); float* rs = rc + 2048 * 128;
    for (int idx = gw * 64 + lane; idx < 2048 * 128; idx += NGW * 64) {
        const int s = idx >> 7, i = idx & 127;
        double inv = 1.0, bs = 0.9305720409296989792906463164991; int e = i;
#pragma unroll
        for (int b = 0; b < 7; ++b) { if (e & 1) inv *= bs; bs *= bs; e >>= 1; }
        const float angf = (float)s * (float)inv;
        const double a = (double)angf; const double q = __builtin_rint(a * 0.63661977236758134308);
        const double x = (a - q * 1.5707963267948965580) - q * 6.123233995736766e-17;
        const double x2 = x * x;
        const double sn = x * (1.0 + x2 * (-1.0 / 6 + x2 * (1.0 / 120 + x2 * (-1.0 / 5040 + x2 * (1.0 / 362880 + x2 * (-1.0 / 39916800 + x2 * (1.0 / 6227020800.0)))))));
        const double cs = 1.0 + x2 * (-0.5 + x2 * (1.0 / 24 + x2 * (-1.0 / 720 + x2 * (1.0 / 40320 + x2 * (-1.0 / 3628800 + x2 * (1.0 / 479001600.0))))));
        const int qi = ((int)q) & 3;
        const double co = (qi == 0) ? cs : (qi == 1) ? -sn : (qi == 2) ? -cs : sn;
        const double si = (qi == 0) ? sn : (qi == 1) ? cs : (qi == 2) ? -sn : -cs;
        rc[idx] = (float)co; rs[idx] = (float)si;
    }
}
__device__ __forceinline__ void rmsnorm_phase(const float* X, const float* g, bf16_t* XN, float* Xcopy, float* OutF, int gw, int NGW, int lane) {
    f32x4 gg[8];
#pragma unroll
    for (int j = 0; j < 8; ++j) gg[j] = ((const f32x4*)g)[lane + 64 * j];
    for (int m = gw; m < T; m += 2 * NGW) {
        const int m1 = (m + NGW < T) ? m + NGW : m;
        const f32x4* xr0 = (const f32x4*)(X + (size_t)m * D) + lane; const f32x4* xr1 = (const f32x4*)(X + (size_t)m1 * D) + lane;
        f32x4 v0[8], v1[8]; float s0 = 0.f, s1 = 0.f;
#pragma unroll
        for (int j = 0; j < 8; ++j) { v0[j] = xr0[64 * j]; v1[j] = xr1[64 * j]; }
#pragma unroll
        for (int j = 0; j < 8; ++j) { s0 += (v0[j][0] * v0[j][0] + v0[j][1] * v0[j][1]) + (v0[j][2] * v0[j][2] + v0[j][3] * v0[j][3]);
                                      s1 += (v1[j][0] * v1[j][0] + v1[j][1] * v1[j][1]) + (v1[j][2] * v1[j][2] + v1[j][3] * v1[j][3]); }
#pragma unroll
        for (int o = 1; o < 64; o <<= 1) { s0 += __shfl_xor(s0, o); s1 += __shfl_xor(s1, o); }
        const float rs0 = rsqrtf(s0 * (1.f / D) + 1e-6f), rs1 = rsqrtf(s1 * (1.f / D) + 1e-6f);
#pragma unroll
        for (int j = 0; j < 8; ++j) { const f32x4 y0 = v0[j] * rs0 * gg[j], y1 = v1[j] * rs1 * gg[j];
            if (XN) { u32x2 o; o.x = pk(y0[0], y0[1]); o.y = pk(y0[2], y0[3]); *(u32x2*)(XN + (size_t)m * D + 4 * lane + 256 * j) = o;
                      o.x = pk(y1[0], y1[1]); o.y = pk(y1[2], y1[3]); *(u32x2*)(XN + (size_t)m1 * D + 4 * lane + 256 * j) = o; }
            if (Xcopy) { ((f32x4*)(Xcopy + (size_t)m * D))[lane + 64 * j] = v0[j]; ((f32x4*)(Xcopy + (size_t)m1 * D))[lane + 64 * j] = v1[j]; }
            if (OutF) { ((f32x4*)(OutF + (size_t)m * D))[lane + 64 * j] = y0; ((f32x4*)(OutF + (size_t)m1 * D))[lane + 64 * j] = y1; } }
    }
}
#define LBAR() do { asm volatile("s_waitcnt lgkmcnt(0)" ::: "memory"); __builtin_amdgcn_s_barrier(); asm volatile("" ::: "memory"); } while (0)

__device__ __forceinline__ void ret_pre_phase(LAS unsigned char* lds, const bf16_t* __restrict__ PROJ, const float* __restrict__ ropeC, const float* __restrict__ ropeS,
                                              bf16_t* __restrict__ GQR, bf16_t* __restrict__ GKT, bf16_t* __restrict__ GS, int vcu, int G, int tid_in) {
    constexpr int LDP = NP_RET;
    LAS bf16_t* sQ = (LAS bf16_t*)lds;
    LAS bf16_t* sK = sQ + 64 * 264;
    LAS bf16_t* sKT = sK + 64 * 264;
    LAS bf16_t* sS = sKT + 256 * 72;
    for (int u = vcu; u < 1024; u += G) {
        int tid = tid_in; asm volatile("" : "+v"(tid)); const int lane = tid & 63, w = __builtin_amdgcn_readfirstlane(tid >> 6), r = lane & 31, hh = lane >> 5;
        const int bh = u >> 5, n = u & 31, b = bh >> 3, h = bh & 7, t0 = b * 2048 + n * 64, s0 = n * 64;
        const float lg = LOGG[h];
#pragma unroll
        for (int it = 0; it < 2; ++it) {
            const int idx = tid + it * 512, c = idx >> 4, g = idx & 15;
            const bf16_t* qrow = PROJ + (size_t)(t0 + c) * LDP + h * 256 + 8 * g;
            const u32x4 q1 = *(const u32x4*)qrow, q2 = *(const u32x4*)(qrow + 128), k1 = *(const u32x4*)(qrow + 2048), k2 = *(const u32x4*)(qrow + 2048 + 128);
            const float* cp = ropeC + (size_t)(s0 + c) * 128 + 8 * g; const float* sp = ropeS + (size_t)(s0 + c) * 128 + 8 * g;
            const f32x4 c0 = *(const f32x4*)cp, c1 = *(const f32x4*)(cp + 4), n0 = *(const f32x4*)sp, n1 = *(const f32x4*)(sp + 4);
            u32x4 oq1, oq2, ok1, ok2;
#pragma unroll
            for (int e = 0; e < 4; ++e) {
                const float ca = (e < 2) ? c0[2 * e] : c1[2 * e - 4], cb = (e < 2) ? c0[2 * e + 1] : c1[2 * e - 3];
                const float sa = (e < 2) ? n0[2 * e] : n1[2 * e - 4], sb = (e < 2) ? n0[2 * e + 1] : n1[2 * e - 3];
                const float x1a = bflo(q1[e]), x1b = bfhi(q1[e]), x2a = bflo(q2[e]), x2b = bfhi(q2[e]);
                oq1[e] = pk(x1a * ca - x2a * sa, x1b * cb - x2b * sb); oq2[e] = pk(x1a * sa + x2a * ca, x1b * sb + x2b * cb);
                const float y1a = bflo(k1[e]) * 0.0625f, y1b = bfhi(k1[e]) * 0.0625f, y2a = bflo(k2[e]) * 0.0625f, y2b = bfhi(k2[e]) * 0.0625f;
                ok1[e] = pk(y1a * ca - y2a * sa, y1b * cb - y2b * sb); ok2[e] = pk(y1a * sa + y2a * ca, y1b * sb + y2b * cb);
            }
            *(LAS u32x4*)(sQ + c * 264 + 8 * g) = oq1; *(LAS u32x4*)(sQ + c * 264 + 128 + 8 * g) = oq2;
            *(LAS u32x4*)(sK + c * 264 + 8 * g) = ok1; *(LAS u32x4*)(sK + c * 264 + 128 + 8 * g) = ok2;
            *(u32x4*)(GQR + ((size_t)u * 64 + c) * 256 + 8 * g) = oq1; *(u32x4*)(GQR + ((size_t)u * 64 + c) * 256 + 128 + 8 * g) = oq2;
        }
        LBAR();
#pragma unroll
        for (int it = 0; it < 4; ++it) { const int idx = tid + it * 512, d = idx & 255, c0 = (idx >> 8) * 8; u32x4 o;
#pragma unroll
            for (int e = 0; e < 4; ++e) { const float a = bf2f(sK[(c0 + 2 * e) * 264 + d]) * __expf(lg * (float)(63 - (c0 + 2 * e)));
                const float bb = bf2f(sK[(c0 + 2 * e + 1) * 264 + d]) * __expf(lg * (float)(62 - (c0 + 2 * e))); o[e] = pk(a, bb); }
            *(LAS u32x4*)(sKT + d * 72 + c0) = o; }
        if (w < 4) { const int ci = w >> 1, xi = w & 1; f32x16 acc = zero16();
            mma32(acc, sQ + 32 * ci * 264, 264, sK + 32 * xi * 264, 264, 256, lane);
#pragma unroll
            for (int reg = 0; reg < 16; ++reg) { const int c = 32 * ci + ROWMAP(reg, hh), m = 32 * xi + r; const int dd = c > m ? c - m : m - c;
                sS[c * 72 + m] = bf1(acc[reg] * __expf(lg * (float)dd)); } }
        LBAR();
#pragma unroll
        for (int it = 0; it < 4; ++it) { const int idx = tid + it * 512, d = idx >> 3, g = idx & 7; *(u32x4*)(GKT + ((size_t)u * 256 + d) * 64 + 8 * g) = *(const LAS u32x4*)(sKT + d * 72 + 8 * g); }
        *(u32x4*)(GS + ((size_t)u * 64 + (tid >> 3)) * 64 + 8 * (tid & 7)) = *(const LAS u32x4*)(sS + (tid >> 3) * 72 + 8 * (tid & 7));
        LBAR();
    }
}
__device__ __forceinline__ void ret_scan_phase(LAS unsigned char* lds, const bf16_t* __restrict__ PROJ, const bf16_t* __restrict__ GQR, const bf16_t* __restrict__ GKT,
                                               const bf16_t* __restrict__ GS, bf16_t* __restrict__ O, unsigned char* ws, int vcu, int G, int tid_in) {
    constexpr int LDP = NP_RET;
    const int wq = __builtin_amdgcn_readfirstlane(tid_in >> 6);
    int bj = vcu * 4 + wq; const int bstride = G * 4;
    TDesc bd0 = TDesc{nullptr, nullptr, 0, 0, 1, 0}; f32x4 bv0[8]; bool bh0 = false;
    LAS float* bscr = (LAS float*)(lds + 122880 + (wq & 3) * 8704);
#define BG_ISSUE(dd, vv_, hh_) do { if (bj < NITEMS_C) { dd = p0_desc_c(ws, bj); t_load(dd, blane, vv_); hh_ = true; bj += bstride; } else hh_ = false; } while (0)
#define BG_STEP(dd, vv_, hh_) do { if (hh_) { t_store(dd, bscr, blane, vv_); BG_ISSUE(dd, vv_, hh_); } } while (0)
    if (wq < 4) { int blane = tid_in & 63; asm volatile("" : "+v"(blane)); BG_ISSUE(bd0, bv0, bh0); }
    LAS bf16_t* sQ = (LAS bf16_t*)lds;
    LAS bf16_t* sKT = sQ + 64 * 264;
    LAS bf16_t* sVT = sKT + 256 * 72;
    LAS bf16_t* sS = sVT + 64 * 72;
    LAS bf16_t* sST = sS + 64 * 72;
    for (int u = vcu; u < 256; u += G) {
        const int bh = u >> 3, jv = u & 7, b = bh >> 3, h = bh & 7;
        const float lg = LOGG[h], cdec = __expf(lg * 64.f);
        f32x16 S0 = zero16(), S1 = zero16();
        u32x4 rQ[4], rK[4], rS, rvv;
#define RET_PREFETCH(nn) do { const size_t chn = (size_t)bh * 32 + (nn); const int t0p = b * 2048 + (nn) * 64; \
            _Pragma("unroll") for (int it = 0; it < 4; ++it) { const int idx = tidp + it * 512; \
                rQ[it] = *(const u32x4*)(GQR + (chn * 64 + (idx >> 5)) * 256 + 8 * (idx & 31)); rK[it] = *(const u32x4*)(GKT + (chn * 256 + (idx >> 3)) * 64 + 8 * (idx & 7)); } \
            rS = *(const u32x4*)(GS + (chn * 64 + (tidp >> 3)) * 64 + 8 * (tidp & 7)); \
            rvv = *(const u32x4*)(PROJ + (size_t)(t0p + (tidp >> 3)) * LDP + 4096 + h * 512 + jv * 64 + 8 * (tidp & 7)); } while (0)
        { int tidp = tid_in; asm volatile("" : "+v"(tidp)); RET_PREFETCH(0); }
        for (int n = 0; n < 32; ++n) {
            int tid = tid_in; asm volatile("" : "+v"(tid)); const int lane = tid & 63, w = __builtin_amdgcn_readfirstlane(tid >> 6), r = lane & 31, hh = lane >> 5;
            const int t0 = b * 2048 + n * 64;
#pragma unroll
            for (int it = 0; it < 4; ++it) { const int idx = tid + it * 512; *(LAS u32x4*)(sQ + (idx >> 5) * 264 + 8 * (idx & 31)) = rQ[it]; *(LAS u32x4*)(sKT + (idx >> 3) * 72 + 8 * (idx & 7)) = rK[it]; }
            *(LAS u32x4*)(sS + (tid >> 3) * 72 + 8 * (tid & 7)) = rS;
            { const int c = tid >> 3, g = tid & 7;
#pragma unroll
              for (int e = 0; e < 4; ++e) { sVT[(8 * g + 2 * e) * 72 + c] = (bf16_t)(rvv[e] & 0xffffu); sVT[(8 * g + 2 * e + 1) * 72 + c] = (bf16_t)(rvv[e] >> 16); } }
            if (n == 0) {
#pragma unroll
                for (int g4 = 0; g4 < 4; ++g4) { const int dk = 32 * w + 8 * g4 + 4 * hh; u32x2 a; a.x = 0u; a.y = 0u; *(LAS u32x2*)(sST + r * 264 + dk) = a; *(LAS u32x2*)(sST + (32 + r) * 264 + dk) = a; } }
            LBAR();
            if (n < 31) { const int tidp = tid; RET_PREFETCH(n + 1); }
            if (w < 4) { const int blane = lane; BG_STEP(bd0, bv0, bh0); }
            if (w >= 4) { const int ci = (w - 4) >> 1, xi = (w - 4) & 1; f32x16 acc = zero16();
                mma32(acc, sQ + 32 * ci * 264, 264, sST + 32 * xi * 264, 264, 256, lane);
#pragma unroll
                for (int reg = 0; reg < 16; ++reg) { const int c = 32 * ci + ROWMAP(reg, hh); acc[reg] *= __expf(lg * (float)(c + 1)); }
                mma32(acc, sS + 32 * ci * 72, 72, sVT + 32 * xi * 72, 72, 64, lane);
#pragma unroll
                for (int reg = 0; reg < 16; ++reg) { const int c = 32 * ci + ROWMAP(reg, hh); O[(size_t)(t0 + c) * 4096 + h * 512 + jv * 64 + 32 * xi + r] = bf1(acc[reg]); } }
            { f32x16 u0 = S0 * cdec, u1 = S1 * cdec;
              mma32(u0, sKT + 32 * w * 72, 72, sVT, 72, 64, lane); mma32(u1, sKT + 32 * w * 72, 72, sVT + 32 * 72, 72, 64, lane); S0 = u0; S1 = u1; }
            LBAR();
#pragma unroll
            for (int g4 = 0; g4 < 4; ++g4) { const int dk = 32 * w + 8 * g4 + 4 * hh; u32x2 a, c2;
                a.x = pk(S0[4 * g4], S0[4 * g4 + 1]); a.y = pk(S0[4 * g4 + 2], S0[4 * g4 + 3]); c2.x = pk(S1[4 * g4], S1[4 * g4 + 1]); c2.y = pk(S1[4 * g4 + 2], S1[4 * g4 + 3]);
                *(LAS u32x2*)(sST + r * 264 + dk) = a; *(LAS u32x2*)(sST + (32 + r) * 264 + dk) = c2; }
            if (w < 4) { const int blane = lane; BG_STEP(bd0, bv0, bh0); }
        }
#undef RET_PREFETCH
        LBAR();
    }
    if (wq < 4) { int blane = tid_in & 63; asm volatile("" : "+v"(blane)); while (bh0) { BG_STEP(bd0, bv0, bh0); } }
#undef BG_ISSUE
#undef BG_STEP
}
template <bool CENTER>
__device__ __forceinline__ void hn512_phase(const bf16_t* __restrict__ O, int ldo, int H, const float* __restrict__ gain, const bf16_t* __restrict__ PROJ, int ldp, int gcol0,
                                            bf16_t* __restrict__ ON, int gw, int NGW, int lane) {
    const int NI = T * H;
    for (int it0 = gw; it0 < NI; it0 += 4 * NGW) {
        f32x4 v[4][2], gg[4][2]; u32x4 gt[4]; int tt[4], hx[4];
#pragma unroll
        for (int q = 0; q < 4; ++q) { int it = it0 + q * NGW; if (it >= NI) it = it0;
            const int t = it / H, h = it - t * H; tt[q] = t; hx[q] = h; const int col = h * 512 + 8 * lane;
            const u32x4 a = *(const u32x4*)(O + (size_t)t * ldo + col);
            v[q][0] = (f32x4){bflo(a.x), bfhi(a.x), bflo(a.y), bfhi(a.y)}; v[q][1] = (f32x4){bflo(a.z), bfhi(a.z), bflo(a.w), bfhi(a.w)};
            gg[q][0] = *(const f32x4*)(gain + col); gg[q][1] = *(const f32x4*)(gain + col + 4); gt[q] = *(const u32x4*)(PROJ + (size_t)t * ldp + gcol0 + col); }
        float rs[4];
        if (CENTER) { float mean[4];
#pragma unroll
            for (int q = 0; q < 4; ++q) mean[q] = (v[q][0][0] + v[q][0][1]) + (v[q][0][2] + v[q][0][3]) + (v[q][1][0] + v[q][1][1]) + (v[q][1][2] + v[q][1][3]);
#pragma unroll
            for (int o = 1; o < 64; o <<= 1) {
#pragma unroll
                for (int q = 0; q < 4; ++q) mean[q] += __shfl_xor(mean[q], o); }
#pragma unroll
            for (int q = 0; q < 4; ++q) { const float mu = mean[q] * (1.f / 512.f); v[q][0] = v[q][0] - mu; v[q][1] = v[q][1] - mu; } }
#pragma unroll
        for (int q = 0; q < 4; ++q) rs[q] = (v[q][0][0] * v[q][0][0] + v[q][0][1] * v[q][0][1]) + (v[q][0][2] * v[q][0][2] + v[q][0][3] * v[q][0][3]) + (v[q][1][0] * v[q][1][0] + v[q][1][1] * v[q][1][1]) + (v[q][1][2] * v[q][1][2] + v[q][1][3] * v[q][1][3]);
#pragma unroll
        for (int o = 1; o < 64; o <<= 1) {
#pragma unroll
            for (int q = 0; q < 4; ++q) rs[q] += __shfl_xor(rs[q], o); }
#pragma unroll
        for (int q = 0; q < 4; ++q) { const float r1 = rsqrtf(rs[q] * (1.f / 512.f) + 1e-6f); const int col = hx[q] * 512 + 8 * lane; const u32x4 gq = gt[q]; const f32x4 g0 = gg[q][0], g1 = gg[q][1];
            u32x4 o; o.x = pk(v[q][0][0] * r1 * g0[0] * siluf_(bflo(gq.x)), v[q][0][1] * r1 * g0[1] * siluf_(bfhi(gq.x)));
            o.y = pk(v[q][0][2] * r1 * g0[2] * siluf_(bflo(gq.y)), v[q][0][3] * r1 * g0[3] * siluf_(bfhi(gq.y)));
            o.z = pk(v[q][1][0] * r1 * g1[0] * siluf_(bflo(gq.z)), v[q][1][1] * r1 * g1[1] * siluf_(bfhi(gq.z)));
            o.w = pk(v[q][1][2] * r1 * g1[2] * siluf_(bflo(gq.w)), v[q][1][3] * r1 * g1[3] * siluf_(bfhi(gq.w)));
            *(u32x4*)(ON + (size_t)tt[q] * ldo + col) = o; }
    }
}

__device__ __forceinline__ void gdn_prep_phase(LAS unsigned char* lds, const bf16_t* __restrict__ PROJ, const float* __restrict__ SM, const float* __restrict__ conv_w,
                                               const float* __restrict__ a_log, const float* __restrict__ dt_bias, bf16_t* __restrict__ GQ, bf16_t* __restrict__ GKE,
                                               bf16_t* __restrict__ GU, bf16_t* __restrict__ GW, float* __restrict__ GG, int vcu, int G, int tid_in) {
    constexpr int LDP = NP_GDN;
    LAS float* sSol = (LAS float*)lds;
    LAS float* sA = sSol + 64 * 257;
    LAS float* sBeta = sA + 64 * 68;
    LAS float* sCum = sBeta + 64;
    LAS bf16_t* sKb = (LAS bf16_t*)(sCum + 64);
    LAS bf16_t* sRaw = sKb + 64 * 136;
    for (int u = vcu; u < 2048; u += G) {
        int tid = tid_in; asm volatile("" : "+v"(tid)); const int lane = tid & 63, w = __builtin_amdgcn_readfirstlane(tid >> 6), r = lane & 31, hh = lane >> 5;
        const int b = u >> 9, h = (u >> 5) & 15, n = u & 31;
        const int t0 = b * 2048 + n * 64, s0 = n * 64;
        u32x4 raw[3];
#define GDN_PREFETCH(ten) do { _Pragma("unroll") for (int it = 0; it < 3; ++it) { const int idx = tid + it * 512, rr = idx >> 4, g = idx & 15; raw[it] = (u32x4){0u, 0u, 0u, 0u}; \
            if (idx < 67 * 16 && s0 - 3 + rr >= 0) raw[it] = *(const u32x4*)(PROJ + (size_t)(t0 - 3 + rr) * LDP + (ten) * 2048 + h * 128 + 8 * g); } } while (0)
        GDN_PREFETCH(0);
        float cw[3][4][2];
#pragma unroll
        for (int ten = 0; ten < 3; ++ten)
#pragma unroll
            for (int tap = 0; tap < 4; ++tap) { const float* cp = conv_w + tap * 6144 + ten * 2048 + h * 128 + 2 * lane; cw[ten][tap][0] = cp[0]; cw[ten][tap][1] = cp[1]; }
        if (tid < 64) {
            const float bl = SM[(size_t)(t0 + tid) * 32 + h], al = SM[(size_t)(t0 + tid) * 32 + 16 + h];
            const float x = al + dt_bias[h];
            const float sp = (x > 20.f) ? x : log1pf(__expf(x));
            float la = -__expf(a_log[h]) * sp;
#pragma unroll
            for (int o = 1; o < 64; o <<= 1) { const float y = __shfl_up(la, o); if (lane >= o) la += y; }
            sBeta[tid] = sigmoidf_(bl); sCum[tid] = la;
        }
#pragma unroll
        for (int ten = 0; ten < 3; ++ten) {
#pragma unroll
            for (int it = 0; it < 3; ++it) { const int idx = tid + it * 512, rr = idx >> 4, g = idx & 15; if (idx < 67 * 16) *(LAS u32x4*)(sRaw + rr * 136 + 8 * g) = raw[it]; }
            LBAR();
            if (ten == 0) GDN_PREFETCH(1);
            if (ten == 1) GDN_PREFETCH(2);
            const float cumL = sCum[63];
            float a0[8], a1[8], ss[8];
#pragma unroll
            for (int rr = 0; rr < 8; ++rr) { const int c = w + 8 * rr; float x0 = 0.f, x1 = 0.f;
#pragma unroll
                for (int tap = 0; tap < 4; ++tap) { const unsigned xv = *(const LAS unsigned*)(sRaw + (c + tap) * 136 + 2 * lane); x0 += bflo(xv) * cw[ten][tap][0]; x1 += bfhi(xv) * cw[ten][tap][1]; }
                a0[rr] = siluf_(x0); a1[rr] = siluf_(x1); ss[rr] = a0[rr] * a0[rr] + a1[rr] * a1[rr]; }
            if (ten != 2) {
#pragma unroll
                for (int o = 1; o < 64; o <<= 1) {
#pragma unroll
                    for (int rr = 0; rr < 8; ++rr) ss[rr] += __shfl_xor(ss[rr], o); } }
#pragma unroll
            for (int rr = 0; rr < 8; ++rr) { const int c = w + 8 * rr; const float beta = sBeta[c], cum = sCum[c];
                if (ten == 2) { sSol[c * 257 + 2 * lane] = beta * a0[rr]; sSol[c * 257 + 2 * lane + 1] = beta * a1[rr]; }
                else { float rn = rsqrtf(ss[rr] + 1e-6f);
                    if (ten == 0) { rn *= 0.08838834764831845f; *(unsigned*)(GQ + ((size_t)u * 64 + c) * 128 + 2 * lane) = pk(a0[rr] * rn, a1[rr] * rn); }
                    else { const float k0 = a0[rr] * rn, k1 = a1[rr] * rn; *(LAS unsigned*)(sKb + c * 136 + 2 * lane) = pk(k0, k1);
                        const float f = beta * __expf(cum); sSol[c * 257 + 128 + 2 * lane] = f * k0; sSol[c * 257 + 128 + 2 * lane + 1] = f * k1;
                        const float e = __expf(cumL - cum); *(unsigned*)(GKE + ((size_t)u * 64 + c) * 128 + 2 * lane) = pk(k0 * e, k1 * e); } } }
            LBAR();
        }
#undef GDN_PREFETCH
        const float cumL = sCum[63];
        if (w < 4) { const int ci = w >> 1, mi = w & 1; f32x16 acc = zero16();
            mma32(acc, sKb + 32 * ci * 136, 136, sKb + 32 * mi * 136, 136, 128, lane);
#pragma unroll
            for (int reg = 0; reg < 16; ++reg) { const int c = 32 * ci + ROWMAP(reg, hh), m = 32 * mi + r;
                sA[c * 68 + m] = (c > m) ? sBeta[c] * __expf(sCum[c] - sCum[m]) * acc[reg] : 0.f; } }
        LBAR();
        { const int j = tid & 255, pp = tid >> 8;
          for (int kb = 0; kb < 8; ++kb) { const int c0 = 8 * kb + 4 * pp; float a[4];
#pragma unroll
              for (int q = 0; q < 4; ++q) a[q] = sSol[(c0 + q) * 257 + j];
              for (int m = 0; m < 8 * kb; m += 4) { float sv[4];
#pragma unroll
                  for (int q = 0; q < 4; ++q) sv[q] = sSol[(m + q) * 257 + j];
#pragma unroll
                  for (int q = 0; q < 4; ++q) { const f32x4 A = *(const LAS f32x4*)(sA + (c0 + q) * 68 + m); a[q] -= (A[0] * sv[0] + A[1] * sv[1]) + (A[2] * sv[2] + A[3] * sv[3]); } }
              if (pp == 1) LBAR();
              if (pp == 1) { float sv[4];
#pragma unroll
                  for (int q = 0; q < 4; ++q) sv[q] = sSol[(8 * kb + q) * 257 + j];
#pragma unroll
                  for (int q = 0; q < 4; ++q) { const f32x4 A = *(const LAS f32x4*)(sA + (c0 + q) * 68 + 8 * kb); a[q] -= (A[0] * sv[0] + A[1] * sv[1]) + (A[2] * sv[2] + A[3] * sv[3]); } }
              { const f32x4 D1 = *(const LAS f32x4*)(sA + (c0 + 1) * 68 + c0), D2 = *(const LAS f32x4*)(sA + (c0 + 2) * 68 + c0), D3 = *(const LAS f32x4*)(sA + (c0 + 3) * 68 + c0);
                a[1] -= D1[0] * a[0]; a[2] -= D2[0] * a[0] + D2[1] * a[1]; a[3] -= D3[0] * a[0] + D3[1] * a[1] + D3[2] * a[2]; }
#pragma unroll
              for (int q = 0; q < 4; ++q) sSol[(c0 + q) * 257 + j] = a[q];
              if (pp == 0) LBAR();
              LBAR(); } }
#pragma unroll 4
        for (int it = 0; it < 16; ++it) { const int idx = tid + it * 512, c = idx >> 7, p2 = idx & 127; const unsigned o = pk(sSol[c * 257 + 2 * p2], sSol[c * 257 + 2 * p2 + 1]);
            if (p2 < 64) *(unsigned*)(GU + ((size_t)u * 64 + c) * 128 + 2 * p2) = o; else *(unsigned*)(GW + ((size_t)u * 64 + c) * 128 + 2 * p2 - 128) = o; }
        if (tid == 0) GG[u] = __expf(cumL);
        LBAR();
    }
}
__device__ __forceinline__ void gdn_scan_phase(LAS unsigned char* lds, const bf16_t* __restrict__ GQ, const bf16_t* __restrict__ GKE, const bf16_t* __restrict__ GU,
                                               const bf16_t* __restrict__ GW, const float* __restrict__ GG, bf16_t* __restrict__ O, unsigned char* ws, int vcu, int G, int tid_in) {
    const int wq = __builtin_amdgcn_readfirstlane(tid_in >> 6);
    int bj = vcu * 4 + (wq - 4); const int bstride = G * 4;
    TDesc bd0 = TDesc{nullptr, nullptr, 0, 0, 1, 0}, bd1 = bd0; f32x4 bv0[8], bv1[8]; bool bh0 = false, bh1 = false;
    LAS float* bscr = (LAS float*)(lds + 81920 + (wq & 3) * 8704);
#define BG_ISSUE(dd, vv_, hh_) do { if (bj < NITEMS_B2) { dd = p0_desc_b2(ws, bj); t_load(dd, blane, vv_); hh_ = true; bj += bstride; } else hh_ = false; } while (0)
#define BG_STEP(dd, vv_, hh_) do { if (hh_) { t_store(dd, bscr, blane, vv_); BG_ISSUE(dd, vv_, hh_); } } while (0)
    if (wq >= 4) { int blane = tid_in & 63; asm volatile("" : "+v"(blane)); BG_ISSUE(bd0, bv0, bh0); BG_ISSUE(bd1, bv1, bh1); }
    LAS bf16_t* sW = (LAS bf16_t*)lds;
    LAS bf16_t* sQ = sW + 64 * 136;
    LAS bf16_t* sKET = sQ + 64 * 136;
    LAS bf16_t* sST = sKET + 128 * 72;
    LAS bf16_t* sDT = sST + 32 * 136;
    LAS bf16_t* sU = sDT + 32 * 72;
    for (int u = vcu; u < 256; u += G) {
        const int bh = u >> 2, jv = u & 3, b = bh >> 4, h = bh & 15;
        f32x16 S = zero16();
        u32x4 rW[2], rQ[2], rK[2], rU; float rg = 0.f; int zoff = 0; asm volatile("" : "+v"(zoff));
        rU = (u32x4){0u, 0u, 0u, 0u};
#define SCAN_PREFETCH(nn) do { const size_t chn = (size_t)bh * 32 + (nn); \
            _Pragma("unroll") for (int it = 0; it < 2; ++it) { const int idx = tidp + it * 512, c = idx >> 4, g = idx & 15; const size_t go = (chn * 64 + c) * 128 + 8 * g; \
                rW[it] = *(const u32x4*)(GW + go); rQ[it] = *(const u32x4*)(GQ + go); rK[it] = *(const u32x4*)(GKE + go); } \
            if (tidp < 256) rU = *(const u32x4*)(GU + (chn * 64 + (tidp >> 2)) * 128 + jv * 32 + 8 * (tidp & 3)); \
            rg = GG[chn + zoff]; } while (0)
        { int tidp = tid_in; asm volatile("" : "+v"(tidp)); SCAN_PREFETCH(0); }
        for (int n = 0; n < 32; ++n) {
            int tid = tid_in; asm volatile("" : "+v"(tid)); const int lane = tid & 63, w = __builtin_amdgcn_readfirstlane(tid >> 6), r = lane & 31, hh = lane >> 5;
            const int t0 = b * 2048 + n * 64;
#pragma unroll
            for (int it = 0; it < 2; ++it) { const int idx = tid + it * 512, c = idx >> 4, g = idx & 15;
                *(LAS u32x4*)(sW + c * 136 + 8 * g) = rW[it]; *(LAS u32x4*)(sQ + c * 136 + 8 * g) = rQ[it];
#pragma unroll
                for (int e = 0; e < 4; ++e) { sKET[(8 * g + 2 * e) * 72 + c] = (bf16_t)(rK[it][e] & 0xffffu); sKET[(8 * g + 2 * e + 1) * 72 + c] = (bf16_t)(rK[it][e] >> 16); } }
            if (tid < 256) *(LAS u32x4*)(sU + (tid >> 2) * 40 + 8 * (tid & 3)) = rU;
            if (n == 0 && w < 4) {
#pragma unroll
                for (int g4 = 0; g4 < 4; ++g4) { u32x2 a; a.x = 0u; a.y = 0u; *(LAS u32x2*)(sST + r * 136 + 32 * w + 8 * g4 + 4 * hh) = a; } }
            const float cg_ = rg;
            LBAR();
            if (n < 31) { const int tidp = tid; SCAN_PREFETCH(n + 1); }
            if (w >= 4) { const int blane = lane; BG_STEP(bd0, bv0, bh0); }
            if (w < 2) { f32x16 acc = zero16(); mma32(acc, sW + 32 * w * 136, 136, sST, 136, 128, lane);
#pragma unroll
                for (int g4 = 0; g4 < 4; ++g4) { const int c = 32 * w + 8 * g4 + 4 * hh; const LAS bf16_t* up = sU + c * 40 + r;
                    u32x2 a; a.x = pk(bf2f(up[0]) - acc[4 * g4], bf2f(up[40]) - acc[4 * g4 + 1]); a.y = pk(bf2f(up[80]) - acc[4 * g4 + 2], bf2f(up[120]) - acc[4 * g4 + 3]);
                    *(LAS u32x2*)(sDT + r * 72 + c) = a; } }
            LBAR();
            if (w < 4) { f32x16 s2 = S * cg_; mma32(s2, sKET + 32 * w * 72, 72, sDT, 72, 64, lane); S = s2;
#pragma unroll
                for (int g4 = 0; g4 < 4; ++g4) { u32x2 a; a.x = pk(S[4 * g4], S[4 * g4 + 1]); a.y = pk(S[4 * g4 + 2], S[4 * g4 + 3]); *(LAS u32x2*)(sST + r * 136 + 32 * w + 8 * g4 + 4 * hh) = a; } }
            LBAR();
            if (w >= 4) { const int blane = lane; BG_STEP(bd1, bv1, bh1); }
            if (w < 2) { f32x16 acc = zero16(); mma32(acc, sQ + 32 * w * 136, 136, sST, 136, 128, lane);
#pragma unroll
                for (int reg = 0; reg < 16; ++reg) { const int c = 32 * w + ROWMAP(reg, hh); O[(size_t)(t0 + c) * 2048 + h * 128 + jv * 32 + r] = bf1(acc[reg]); } }
            LBAR();
        }
#undef SCAN_PREFETCH
    }
    if (wq >= 4) { int blane = tid_in & 63; asm volatile("" : "+v"(blane)); while (bh0 || bh1) { BG_STEP(bd0, bv0, bh0); BG_STEP(bd1, bv1, bh1); } }
#undef BG_ISSUE
#undef BG_STEP
}
__device__ __forceinline__ void gdn_hn_phase(const bf16_t* __restrict__ O, const float* __restrict__ gain, const bf16_t* __restrict__ PROJ, bf16_t* __restrict__ ON, int gw, int NGW, int lane) {
    for (int t = gw; t < T; t += NGW) {
#pragma unroll
        for (int j = 0; j < 8; ++j) { const int col = 4 * lane + 256 * j;
            const u32x2 ov = *(const u32x2*)(O + (size_t)t * 2048 + col); const f32x4 v = (f32x4){bflo(ov.x), bfhi(ov.x), bflo(ov.y), bfhi(ov.y)};
            float ss = (v[0] * v[0] + v[1] * v[1]) + (v[2] * v[2] + v[3] * v[3]);
#pragma unroll
            for (int o = 1; o < 32; o <<= 1) ss += __shfl_xor(ss, o);
            const float rs = rsqrtf(ss * (1.f / 128.f) + 1e-6f);
            const f32x4 gg = *(const f32x4*)(gain + (col & 127)); const u32x2 zt = *(const u32x2*)(PROJ + (size_t)t * NP_GDN + 6144 + col);
            u32x2 o; o.x = pk(v[0] * rs * gg[0] * siluf_(bflo(zt.x)), v[1] * rs * gg[1] * siluf_(bfhi(zt.x)));
            o.y = pk(v[2] * rs * gg[2] * siluf_(bflo(zt.y)), v[3] * rs * gg[3] * siluf_(bfhi(zt.y)));
            *(u32x2*)(ON + (size_t)t * 2048 + col) = o; }
    }
}

__device__ __forceinline__ void gla_pre_phase(LAS unsigned char* lds, const bf16_t* __restrict__ PROJ, const float* __restrict__ SM, const float* __restrict__ wg,
                                              const float* __restrict__ gbias, bf16_t* __restrict__ GQI, bf16_t* __restrict__ GKBT, bf16_t* __restrict__ GS, float* __restrict__ GE,
                                              int vcu, int G, int tid_in) {
    constexpr int LDP = NP_GLA;
    LAS bf16_t* bufA = (LAS bf16_t*)lds;
    LAS bf16_t* bufB = bufA + 64 * 264;
    LAS bf16_t* sKbT = bufB + 64 * 264;
    LAS bf16_t* sS = sKbT + 256 * 72;
    LAS float* sTot = (LAS float*)(sS + 64 * 72);
    LAS float* sGL = sTot + 512;
    for (int u = vcu; u < 512; u += G) {
        int tid = tid_in; asm volatile("" : "+v"(tid)); const int lane = tid & 63, w = __builtin_amdgcn_readfirstlane(tid >> 6), r = lane & 31, hh = lane >> 5;
        const int dk = tid & 255, half = tid >> 8;
        const int bh = u >> 5, n = u & 31, b = bh >> 2, h = bh & 3, t0 = b * 2048 + n * 64;
        float wgc[16];
#pragma unroll
        for (int q = 0; q < 16; ++q) wgc[q] = wg[q * 1024 + h * 256 + dk];
        const float gb = gbias[h * 256 + dk];
        u32x4 qraw[4], kraw[4];
#pragma unroll
        for (int it = 0; it < 4; ++it) { const int idx = tid + it * 512, c = idx >> 5, g = idx & 31; const bf16_t* pr = PROJ + (size_t)(t0 + c) * LDP + h * 256 + 8 * g;
            qraw[it] = *(const u32x4*)pr; kraw[it] = *(const u32x4*)(pr + 1024); }
        if (tid < 256) *(LAS f32x4*)(sGL + (tid >> 2) * 16 + 4 * (tid & 3)) = *(const f32x4*)(SM + (size_t)(t0 + (tid >> 2)) * 32 + 4 * (tid & 3));
#pragma unroll
        for (int it = 0; it < 4; ++it) { const int idx = tid + it * 512, c = idx >> 5, g = idx & 31; *(LAS u32x4*)(bufA + c * 264 + 8 * g) = qraw[it]; *(LAS u32x4*)(bufB + c * 264 + 8 * g) = kraw[it]; }
        LBAR();
        float cum[32]; float run = 0.f;
#pragma unroll
        for (int i = 0; i < 32; ++i) { const int c = 32 * half + i; float x = gb;
#pragma unroll
            for (int q = 0; q < 16; ++q) x += sGL[c * 16 + q] * wgc[q];
            const float ls = fminf(x, 0.f) - __logf(1.f + __expf(-fabsf(x))); run += ls * 0.0625f; cum[i] = run;
            if ((i & 7) == 7) __builtin_amdgcn_sched_barrier(0); }
        sTot[half * 256 + dk] = run;
        LBAR();
        const float tot0 = sTot[dk], tot1 = sTot[256 + dk], E0 = __expf(tot0);
        if (half == 0) { GE[(size_t)u * 512 + dk] = __expf(tot1); GE[(size_t)u * 512 + 256 + dk] = __expf(tot0 + tot1); }
        const float off = half ? 0.f : -tot0;
        unsigned pkreg[32]; unsigned kbp[16]; unsigned pkq[16];
#pragma unroll
        for (int i = 0; i < 32; ++i) { const int c = 32 * half + i; const float v = cum[i] + off, e = __expf(v), ei = __expf(-v);
            const float q = bf2f(bufA[c * 264 + dk]) * 0.0625f, k = bf2f(bufB[c * 264 + dk]);
            const unsigned a = pk(q * e, k * ei);
            bufA[c * 264 + dk] = (bf16_t)(a & 0xffffu); bufB[c * 264 + dk] = (bf16_t)(a >> 16);
            if (i & 1) kbp[i >> 1] |= (a & 0xffff0000u); else kbp[i >> 1] = a >> 16;
            const unsigned qi = pk(q * e * E0, 0.f);
            if (i & 1) pkq[i >> 1] |= (qi << 16); else pkq[i >> 1] = qi & 0xffffu;
            pkreg[i] = pk(q * ei, k * e);
            if ((i & 7) == 7) __builtin_amdgcn_sched_barrier(0); }
#pragma unroll
        for (int q = 0; q < 4; ++q) { u32x4 o; o.x = kbp[4 * q]; o.y = kbp[4 * q + 1]; o.z = kbp[4 * q + 2]; o.w = kbp[4 * q + 3]; *(LAS u32x4*)(sKbT + dk * 72 + 32 * half + 8 * q) = o; }
        LBAR();
        f32x16 accA = zero16();
        const int ci = (w & 3) >> 1, mi = w & 1;
        if (w < 4) mma32(accA, bufA + 32 * ci * 264, 264, bufB + 32 * mi * 264, 264, 256, lane);
#pragma unroll
        for (int it = 0; it < 4; ++it) { const int idx = tid + it * 512, d = idx >> 3, g = idx & 7; *(u32x4*)(GKBT + ((size_t)u * 256 + d) * 64 + 8 * g) = *(const LAS u32x4*)(sKbT + d * 72 + 8 * g); }
        LBAR();
#pragma unroll
        for (int i = 0; i < 32; ++i) { const int c = 32 * half + i; bufA[c * 264 + dk] = (bf16_t)(pkreg[i] & 0xffffu); bufB[c * 264 + dk] = (bf16_t)(pkreg[i] >> 16); }
        LBAR();
        if (w < 4) { f32x16 accU = zero16(); mma32(accU, bufA + 32 * ci * 264, 264, bufB + 32 * mi * 264, 264, 256, lane);
#pragma unroll
            for (int reg = 0; reg < 16; ++reg) { const int c = 32 * ci + ROWMAP(reg, hh), m = 32 * mi + r; sS[c * 72 + m] = bf1((c >= m) ? accA[reg] : accU[reg]); } }
        LBAR();
#pragma unroll
        for (int i = 0; i < 32; ++i) { const int c = 32 * half + i; bufA[c * 264 + dk] = (bf16_t)((i & 1) ? (pkq[i >> 1] >> 16) : (pkq[i >> 1] & 0xffffu)); }
        *(u32x4*)(GS + ((size_t)u * 64 + (tid >> 3)) * 64 + 8 * (tid & 7)) = *(const LAS u32x4*)(sS + (tid >> 3) * 72 + 8 * (tid & 7));
        LBAR();
#pragma unroll
        for (int it = 0; it < 4; ++it) { const int idx = tid + it * 512, c = idx >> 5, g = idx & 31; *(u32x4*)(GQI + ((size_t)u * 64 + c) * 256 + 8 * g) = *(const LAS u32x4*)(bufA + c * 264 + 8 * g); }
        LBAR();
    }
}
__device__ __forceinline__ void gla_scan_phase(LAS unsigned char* lds, const bf16_t* __restrict__ PROJ, const bf16_t* __restrict__ GQI, const bf16_t* __restrict__ GKBT,
                                               const bf16_t* __restrict__ GS, const float* __restrict__ GE, bf16_t* __restrict__ O, unsigned char* ws, int vcu, int G, int tid_in) {
    constexpr int LDP = NP_GLA;
    const int wq = __builtin_amdgcn_readfirstlane(tid_in >> 6); const bool bgw = (wq < 4) || (wq >= 6); const int bgi = (wq < 4) ? wq : wq - 2;
    int bj = vcu * 6 + bgi; const int bstride = G * 6;
    TDesc bd0 = TDesc{nullptr, nullptr, 0, 0, 1, 0}; f32x4 bv0[8]; bool bh0 = false;
    LAS float* bscr = (LAS float*)(lds + 106496 + bgi * 8704);
#define BG_ISSUE(dd, vv_, hh_) do { if (bj < NITEMS_B3) { dd = p0_desc_b3(ws, bj); t_load(dd, blane, vv_); hh_ = true; bj += bstride; } else hh_ = false; } while (0)
#define BG_STEP(dd, vv_, hh_) do { if (hh_) { t_store(dd, bscr, blane, vv_); BG_ISSUE(dd, vv_, hh_); } } while (0)
    if (bgw) { int blane = tid_in & 63; asm volatile("" : "+v"(blane)); BG_ISSUE(bd0, bv0, bh0); }
    LAS bf16_t* bufA = (LAS bf16_t*)lds;
    LAS bf16_t* sKbT = bufA + 64 * 264;
    LAS bf16_t* sVT = sKbT + 256 * 72;
    LAS bf16_t* sS = sVT + 32 * 72;
    LAS bf16_t* sST = sS + 64 * 72;
    LAS float* sE = (LAS float*)(sST + 32 * 264);
    for (int u = vcu; u < 256; u += G) {
        const int bh = u >> 4, jv = u & 15, b = bh >> 2, h = bh & 3;
        f32x16 S = zero16();
        u32x4 rQ[4], rK[4], rS; f32x4 rE = (f32x4){0.f, 0.f, 0.f, 0.f}; u32x2 vv;
#define GLA_PREFETCH(nn) do { const size_t chn = (size_t)bh * 32 + (nn); const int t0p = b * 2048 + (nn) * 64; \
            _Pragma("unroll") for (int it = 0; it < 4; ++it) { const int idx = tidp + it * 512; \
                rQ[it] = *(const u32x4*)(GQI + (chn * 64 + (idx >> 5)) * 256 + 8 * (idx & 31)); rK[it] = *(const u32x4*)(GKBT + (chn * 256 + (idx >> 3)) * 64 + 8 * (idx & 7)); } \
            rS = *(const u32x4*)(GS + (chn * 64 + (tidp >> 3)) * 64 + 8 * (tidp & 7)); \
            if (tidp < 128) rE = *(const f32x4*)(GE + chn * 512 + 4 * tidp); \
            vv = *(const u32x2*)(PROJ + (size_t)(t0p + (tidp >> 3)) * LDP + 2048 + h * 512 + jv * 32 + 4 * (tidp & 7)); } while (0)
        { int tidp = tid_in; asm volatile("" : "+v"(tidp)); GLA_PREFETCH(0); }
        for (int n = 0; n < 32; ++n) {
            int tid = tid_in; asm volatile("" : "+v"(tid)); const int lane = tid & 63, w = __builtin_amdgcn_readfirstlane(tid >> 6), r = lane & 31, hh = lane >> 5;
            const int t0 = b * 2048 + n * 64;
#pragma unroll
            for (int it = 0; it < 4; ++it) { const int idx = tid + it * 512; *(LAS u32x4*)(bufA + (idx >> 5) * 264 + 8 * (idx & 31)) = rQ[it]; *(LAS u32x4*)(sKbT + (idx >> 3) * 72 + 8 * (idx & 7)) = rK[it]; }
            *(LAS u32x4*)(sS + (tid >> 3) * 72 + 8 * (tid & 7)) = rS;
            if (tid < 128) *(LAS f32x4*)(sE + 4 * tid) = rE;
            { const int c = tid >> 3, g = tid & 7;
              sVT[(4 * g) * 72 + c] = (bf16_t)(vv.x & 0xffffu); sVT[(4 * g + 1) * 72 + c] = (bf16_t)(vv.x >> 16); sVT[(4 * g + 2) * 72 + c] = (bf16_t)(vv.y & 0xffffu); sVT[(4 * g + 3) * 72 + c] = (bf16_t)(vv.y >> 16); }
            if (n == 0) {
#pragma unroll
                for (int g4 = 0; g4 < 4; ++g4) { u32x2 a; a.x = 0u; a.y = 0u; *(LAS u32x2*)(sST + r * 264 + 32 * w + 8 * g4 + 4 * hh) = a; } }
            LBAR();
            if (n < 31) { const int tidp = tid; GLA_PREFETCH(n + 1); }
            if (w < 4 || w >= 6) { const int blane = lane; BG_STEP(bd0, bv0, bh0); }
            if (w == 4 || w == 5) { f32x16 acc = zero16(); mma32(acc, bufA + 32 * (w - 4) * 264, 264, sST, 264, 256, lane); mma32(acc, sS + 32 * (w - 4) * 72, 72, sVT, 72, 64, lane);
#pragma unroll
                for (int reg = 0; reg < 16; ++reg) { const int c = 32 * (w - 4) + ROWMAP(reg, hh); O[(size_t)(t0 + c) * 2048 + h * 512 + jv * 32 + r] = bf1(acc[reg]); } }
            { f32x16 up = zero16(); mma32(up, sKbT + 32 * w * 72, 72, sVT, 72, 64, lane);
#pragma unroll
              for (int reg = 0; reg < 16; ++reg) { const int dkr = 32 * w + ROWMAP(reg, hh); S[reg] = S[reg] * sE[256 + dkr] + sE[dkr] * up[reg]; } }
            LBAR();
#pragma unroll
            for (int g4 = 0; g4 < 4; ++g4) { u32x2 a; a.x = pk(S[4 * g4], S[4 * g4 + 1]); a.y = pk(S[4 * g4 + 2], S[4 * g4 + 3]); *(LAS u32x2*)(sST + r * 264 + 32 * w + 8 * g4 + 4 * hh) = a; }
        }
#undef GLA_PREFETCH
        LBAR();
    }
    if (bgw) { int blane = tid_in & 63; asm volatile("" : "+v"(blane)); while (bh0) { BG_STEP(bd0, bv0, bh0); } }
#undef BG_ISSUE
#undef BG_STEP
}
__device__ __forceinline__ float gelu_tanh_(float y) { const float z = 0.7978845608028654f * (y + 0.044715f * y * y * y); const float th = 1.f - 2.f * __builtin_amdgcn_rcpf(1.f + __expf(2.f * z)); return 0.5f * y * (1.f + th); }
__device__ __forceinline__ void lru_phase(LAS unsigned char* lds, const bf16_t* __restrict__ PROJ, const float* __restrict__ conv_w, const float* __restrict__ conv_b,
                                          const bf16_t* __restrict__ WTr, const bf16_t* __restrict__ WTi, const float* __restrict__ b_r, const float* __restrict__ b_i,
                                          const float* __restrict__ lam, bf16_t* __restrict__ ON, int vcu, int G, int tid_in) {
    constexpr int LDP = NP_LRU;
    LAS bf16_t* sX = (LAS bf16_t*)lds;
    LAS bf16_t* sWr = sX + 128 * 136;
    LAS bf16_t* sWi = sWr + 32 * 136;
    LAS float* sXf = (LAS float*)(sWi + 32 * 136);
    LAS float* sA = sXf + 128 * 33;
    LAS float* sM = sA + 128 * 33;
    LAS float* sU = sM + 128 * 33;
    LAS float* sSeg = sU + 128 * 33;
    LAS float* sCarry = sSeg + 1024;
    for (int u = vcu; u < 256; u += G) {
        const int b = u >> 6, nb = (u >> 2) & 15, es = u & 3, ch0 = nb * 128 + es * 32;
        int tidu = tid_in; asm volatile("" : "+v"(tidu));
        { const int tid = tidu; const int e = tid >> 4, g = tid & 15; const size_t go = ((size_t)nb * 128 + es * 32 + e) * 128 + 8 * g;
          *(LAS u32x4*)(sWr + e * 136 + 8 * g) = *(const u32x4*)(WTr + go); *(LAS u32x4*)(sWi + e * 136 + 8 * g) = *(const u32x4*)(WTi + go); }
        float cw[4][2];
#pragma unroll
        for (int tap = 0; tap < 4; ++tap) { cw[tap][0] = conv_w[tap * 2048 + nb * 128 + 2 * (tidu & 63)]; cw[tap][1] = conv_w[tap * 2048 + nb * 128 + 2 * (tidu & 63) + 1]; }
        const float cb0 = conv_b[nb * 128 + 2 * (tidu & 63)], cb1 = conv_b[nb * 128 + 2 * (tidu & 63) + 1];
        if (tidu < 32) sCarry[tidu] = 0.f;
        const float br = b_r[ch0 + (tidu & 31)], bi = b_i[ch0 + (tidu & 31)], c8 = -8.f * log1pf(__expf(-lam[ch0 + (tidu & 31)]));
        for (int tt = 0; tt < 16; ++tt) {
            int tid = tid_in; asm volatile("" : "+v"(tid)); const int lane = tid & 63, w = __builtin_amdgcn_readfirstlane(tid >> 6), r = lane & 31, hh = lane >> 5; (void)r; (void)hh; (void)w; (void)lane;
            const int s0 = tt * 128; const size_t t0 = (size_t)b * 2048 + s0;
            __syncthreads();
            { const int p2 = tid & 63, rg = tid >> 6, col = nb * 128 + 2 * p2;
              float xa[3], xb[3];
#pragma unroll
              for (int k = 0; k < 3; ++k) { const int s = s0 + 16 * rg - 3 + k; unsigned xv = 0u; if (s >= 0) xv = *(const unsigned*)(PROJ + (t0 + 16 * rg - 3 + k) * LDP + col); xa[k] = bflo(xv); xb[k] = bfhi(xv); }
              const bool mine = ((2 * p2) >> 5) == es;
#pragma unroll
              for (int i = 0; i < 16; ++i) { const int row = 16 * rg + i; const unsigned xv = *(const unsigned*)(PROJ + (t0 + row) * LDP + col); const float ca = bflo(xv), cbv = bfhi(xv);
                  const float o0 = cb0 + cw[0][0] * xa[0] + cw[1][0] * xa[1] + cw[2][0] * xa[2] + cw[3][0] * ca;
                  const float o1 = cb1 + cw[0][1] * xb[0] + cw[1][1] * xb[1] + cw[2][1] * xb[2] + cw[3][1] * cbv;
                  *(LAS unsigned*)(sX + row * 136 + 2 * p2) = pk(o0, o1);
                  if (mine) { sXf[row * 33 + ((2 * p2) & 31)] = o0; sXf[row * 33 + ((2 * p2) & 31) + 1] = o1; }
                  xa[0] = xa[1]; xa[1] = xa[2]; xa[2] = ca; xb[0] = xb[1]; xb[1] = xb[2]; xb[2] = cbv; } }
            __syncthreads();
            { f32x16 acc = zero16(); const int rt = w & 3;
              if (w < 4) { mma32(acc, sX + 32 * rt * 136, 136, sWr, 136, 128, lane);
#pragma unroll
                  for (int reg = 0; reg < 16; ++reg) { const int row = 32 * rt + ROWMAP(reg, hh); const float la = c8 * sigmoidf_(acc[reg] + br); const float av = __expf(la); sA[row * 33 + r] = av; sM[row * 33 + r] = __builtin_amdgcn_sqrtf(fmaxf(1.f - av * av, 0.f)); } }
              else { mma32(acc, sX + 32 * rt * 136, 136, sWi, 136, 128, lane);
#pragma unroll
                  for (int reg = 0; reg < 16; ++reg) { const int row = 32 * rt + ROWMAP(reg, hh); sU[row * 33 + r] = sigmoidf_(acc[reg] + bi) * sXf[row * 33 + r]; } } }
            __syncthreads();
            { const int e = tid & 31, seg = tid >> 5; float A = 1.f, H = 0.f; float av[8], uv[8];
#pragma unroll
              for (int i = 0; i < 8; ++i) { const int t = seg * 8 + i; av[i] = sA[t * 33 + e]; uv[i] = sM[t * 33 + e] * sU[t * 33 + e]; H = av[i] * H + uv[i]; A *= av[i]; }
              sSeg[(seg * 32 + e) * 2] = A; sSeg[(seg * 32 + e) * 2 + 1] = H;
              __syncthreads();
              float hin = sCarry[e]; float sa_[15], sh_[15];
#pragma unroll
              for (int s2 = 0; s2 < 15; ++s2) { sa_[s2] = sSeg[(s2 * 32 + e) * 2]; sh_[s2] = sSeg[(s2 * 32 + e) * 2 + 1]; }
#pragma unroll
              for (int s2 = 0; s2 < 15; ++s2) hin = (s2 < seg) ? sa_[s2] * hin + sh_[s2] : hin;
#pragma unroll
              for (int i = 0; i < 8; ++i) { hin = av[i] * hin + uv[i]; const size_t t = t0 + seg * 8 + i;
                  const float y = bf2f(PROJ[t * LDP + 2048 + ch0 + e]); ON[t * 2048 + ch0 + e] = bf1(hin * gelu_tanh_(y)); }
              __syncthreads();
              if (seg == 15) sCarry[e] = hin; }
        }
        __syncthreads();
    }
}

#define XB_TMO      128
#define XB_XCNT(j)  (256  + 64 * (j))
#define XB_XSUB(j)  (1280 + 64 * (j))
#define XB_XGEN(j)  (2304 + 64 * (j))
#define XB_TOP      3328
#define XB_TOPGEN   3392
#define XCD_BAR_WORDS 3456
#define XB_SPIN_CAP (1u << 18)

__device__ __forceinline__ unsigned xb_ld(unsigned* p)              { return __hip_atomic_load(p, __ATOMIC_RELAXED, __HIP_MEMORY_SCOPE_AGENT); }
__device__ __forceinline__ unsigned xb_add(unsigned* p, unsigned v) { return __hip_atomic_fetch_add(p, v, __ATOMIC_RELAXED, __HIP_MEMORY_SCOPE_AGENT); }
__device__ __forceinline__ unsigned xb_xcc_id() { return (unsigned)__builtin_amdgcn_s_getreg((3 << 11) | 20) & 0xFu; }
#define XB_SPIN(cond, bar) do { unsigned _sp = 0; while (cond) { __builtin_amdgcn_s_sleep(1); \
    if ((++_sp & 255u) == 0u) { if (xb_ld(&(bar)[XB_TMO])) break; if (_sp > XB_SPIN_CAP) { atomicAdd(&(bar)[XB_TMO], 1u); break; } } } } while (0)

struct XcdBarrier {
    unsigned* bar; unsigned x;
    volatile LAS unsigned* st;
};

__device__ __forceinline__ XcdBarrier xcd_barrier_post(unsigned* bar, volatile LAS unsigned* st) {
    XcdBarrier b; b.bar = bar; b.x = xb_xcc_id(); b.st = st;
    if (threadIdx.x == 0) (void)xb_add(&bar[XB_XCNT(b.x)], 1u);
    return b;
}
__device__ __forceinline__ void xcd_barrier_complete(unsigned* bar, unsigned x, unsigned& nloc, unsigned& nx) {
    const unsigned G = gridDim.x * gridDim.y * gridDim.z;
    unsigned sum, cnt, mine, sp = 0u;
    for (;;) {
        sum = 0u; cnt = 0u; mine = 0u;
#pragma unroll
        for (unsigned j = 0; j < 16; ++j) { const unsigned c = xb_ld(&bar[XB_XCNT(j)]); sum += c; cnt += (c > 0u) ? 1u : 0u; mine = (j == x) ? c : mine; }
        if (sum == G) break;
        __builtin_amdgcn_s_sleep(1);
        if ((++sp & 255u) == 0u) { if (xb_ld(&bar[XB_TMO])) break; if (sp > XB_SPIN_CAP) { atomicAdd(&bar[XB_TMO], 1u); break; } }
    }
    nloc = mine > 0u ? mine : 1u; nx = cnt > 0u ? cnt : 1u;
}

__device__ __forceinline__ void xcd_barrier(const XcdBarrier& b) {
    asm volatile("s_waitcnt vmcnt(0)" ::: "memory");
    __syncthreads();
    if (threadIdx.x == 0) {
        unsigned* bar = b.bar;
        __builtin_amdgcn_s_waitcnt(0);
        unsigned nloc = b.st[0], nx = b.st[1];
        if (nloc == 0u) { xcd_barrier_complete(bar, b.x, nloc, nx); b.st[0] = nloc; b.st[1] = nx; }
        const unsigned old = xb_add(&bar[XB_XSUB(b.x)], 1u);
        const unsigned gen = old / nloc;
        if (old + 1u == (gen + 1u) * nloc) {
            __builtin_amdgcn_fence(__ATOMIC_RELEASE, "agent");
            asm volatile("s_waitcnt vmcnt(0)" ::: "memory");
            const unsigned og = xb_add(&bar[XB_TOP], 1u);
            const unsigned tg = og / nx;
            if (og + 1u == (tg + 1u) * nx) xb_add(&bar[XB_TOPGEN], 1u);
            else XB_SPIN(xb_ld(&bar[XB_TOPGEN]) == tg, bar);
            __builtin_amdgcn_fence(__ATOMIC_ACQUIRE, "agent");
            xb_add(&bar[XB_XGEN(b.x)], 1u);
            asm volatile("s_waitcnt vmcnt(0)" ::: "memory");
        } else {
            XB_SPIN(xb_ld(&bar[XB_XGEN(b.x)]) == gen, bar);
            __builtin_amdgcn_fence(__ATOMIC_ACQUIRE, "agent");
            asm volatile("s_waitcnt vmcnt(0)" ::: "memory");
        }
    }
    __syncthreads();
}

template <class Epi> __device__ __forceinline__ void run_gemm(LAS unsigned char* lds, const bf16_t* A, const bf16_t* Bt, int N, int K, const Epi& E) {
    pg8::Gemm g{A, Bt, T, N, K}; pg8::StaticOrder S; S.init(T, N, (int)gridDim.x, (int)blockIdx.x);
    pg8::gemm_phase<Epi, pg8::StaticOrder, true, true>(lds, g, S, E);
}
template <class Epi> __device__ __forceinline__ void run_gemm_rstd(LAS unsigned char* lds, const bf16_t* A, const bf16_t* Bt, int N, int K, const Epi& E, const float* RSS, LAS float* ldsr) {
    pg8::Gemm g{A, Bt, T, N, K}; pg8::RstdOrder S; S.init(T, N, (int)gridDim.x, (int)blockIdx.x); S.RSS = RSS; S.ldsr = ldsr; S.na = 0;
    pg8::gemm_phase<Epi, pg8::RstdOrder, true, true>(lds, g, S, E);
}
#define GRID_SYNC_CG() do { asm volatile("s_waitcnt vmcnt(0) lgkmcnt(0)" ::: "memory"); grid.sync(); \
    if (wave == 0) { __builtin_amdgcn_fence(__ATOMIC_ACQUIRE, "agent"); asm volatile("s_waitcnt vmcnt(0)" ::: "memory"); } \
    asm volatile("" ::: "memory"); __builtin_amdgcn_s_barrier(); asm volatile("" ::: "memory"); } while (0)
#define GRID_SYNC() xcd_barrier(xbar)
__global__ void __launch_bounds__(NTHR, 2) fwd_kernel(Params p) {
    extern __shared__ __attribute__((aligned(16))) unsigned char lds_raw[];
    LAS unsigned char* lds = (LAS unsigned char*)lds_raw;
    cg::grid_group grid = cg::this_grid();
    const int tid = threadIdx.x, lane = tid & 63, wave = __builtin_amdgcn_readfirstlane(tid >> 6);
    const int G = gridDim.x, bx = blockIdx.x, vcu = (G % 8 == 0) ? (bx % 8) * (G / 8) + bx / 8 : bx;
    const int gw = vcu * 8 + wave, NGW = G * 8;
    unsigned char* ws = p.ws;
    float* X = p.out;
    bf16_t* XN = (bf16_t*)(ws + OFF_XN); bf16_t* PROJ = (bf16_t*)(ws + OFF_PROJ); float* SM = (float*)(ws + OFF_SM);
    bf16_t* O = (bf16_t*)(ws + OFF_O); bf16_t* ON = (bf16_t*)(ws + OFF_ON);
    volatile LAS unsigned* xst = (volatile LAS unsigned*)(lds + LDS_BYTES - 64);
    if (tid == 0) { xst[0] = 0u; xst[1] = 0u; }
    __syncthreads();
    const XcdBarrier xbar = xcd_barrier_post((unsigned*)(ws + OFF_BAR), xst);

#define STAMP(id) do { } while (0)
    p0_phase(p, lds, gw, NGW, wave, lane);
    rmsnorm_phase(inptr<0>(), inptr<1>(), XN, X, nullptr, gw, NGW, lane);
    GRID_SYNC_CG(); STAMP(0);
    for (int hb = 0; hb < HBMAX; ++hb) {
        const int L = hb >> 1, half = hb & 1;
        int tq = tid; asm volatile("" : "+v"(tq)); const int lane = tq & 63;
        {
            const bf16_t* Bt; int N; pg8::EpiBf E; E.O = PROJ; E.SM = SM; E.slo = 0; E.shi = 0; E.relu2 = half;
            if (half) { Bt = (const bf16_t*)(ws + OFF_WT_UP + L * SZ_L); N = FF; }
            else if (L == 0) { Bt = (const bf16_t*)(ws + OFF_WT_RET_IN); N = NP_RET; }
            else if (L == 1) { Bt = (const bf16_t*)(ws + OFF_WT_GDN_IN); N = NP_GDN; E.slo = 8192; E.shi = 8224; }
            else if (L == 2) { Bt = (const bf16_t*)(ws + OFF_WT_GLA_IN); N = NP_GLA; E.slo = 6144; E.shi = 6160; }
            else { Bt = (const bf16_t*)(ws + OFF_WT_LRU_IN); N = NP_LRU; }
            E.ldo = N; E.ldsr = (const LAS float*)(lds + 131072); E.ne = 0;
#if PH_GEMM
            run_gemm_rstd(lds, XN, Bt, N, D, E, (const float*)(ws + OFF_RSS), (LAS float*)(lds + 131072));
#endif
        }
        GRID_SYNC(); STAMP(1);
        int K2 = FF;
        if (!half) {
            K2 = D;
            if (L == 0) {
#if PH_RET
                ret_pre_phase(lds, PROJ, (const float*)(ws + OFF_ROPE), (const float*)(ws + OFF_ROPE) + 2048 * 128, (bf16_t*)(ws + OFF_GQ), (bf16_t*)(ws + OFF_GKE), (bf16_t*)(ws + OFF_GU), vcu, G, tid);
                GRID_SYNC(); STAMP(13);
                ret_scan_phase(lds, PROJ, (const bf16_t*)(ws + OFF_GQ), (const bf16_t*)(ws + OFF_GKE), (const bf16_t*)(ws + OFF_GU), O, ws, vcu, G, tid);
#endif
                GRID_SYNC(); STAMP(2);
                hn512_phase<true>(O, 4096, 8, inptr<5>(), PROJ, NP_RET, 8192, ON, gw, NGW, lane);
                K2 = 4096;
            } else if (L == 1) {
#if PH_GDN
                gdn_prep_phase(lds, PROJ, SM, inptr<8>(), inptr<9>(), inptr<10>(), (bf16_t*)(ws + OFF_GQ), (bf16_t*)(ws + OFF_GKE), (bf16_t*)(ws + OFF_GU), (bf16_t*)(ws + OFF_GW), (float*)(ws + OFF_GG), vcu, G, tid);
#endif
                GRID_SYNC(); STAMP(4);
#if PH_GDN2
                gdn_scan_phase(lds, (const bf16_t*)(ws + OFF_GQ), (const bf16_t*)(ws + OFF_GKE), (const bf16_t*)(ws + OFF_GU), (const bf16_t*)(ws + OFF_GW), (const float*)(ws + OFF_GG), O, ws, vcu, G, tid);
#endif
                GRID_SYNC(); STAMP(5);
                gdn_hn_phase(O, inptr<11>(), PROJ, ON, gw, NGW, lane);
            } else if (L == 2) {
#if PH_GLA
                gla_pre_phase(lds, PROJ, SM, inptr<14>(), inptr<15>(), (bf16_t*)(ws + OFF_GQ), (bf16_t*)(ws + OFF_GKE), (bf16_t*)(ws + OFF_GU), (float*)(ws + OFF_GW), vcu, G, tid);
                GRID_SYNC(); STAMP(12);
                gla_scan_phase(lds, PROJ, (const bf16_t*)(ws + OFF_GQ), (const bf16_t*)(ws + OFF_GKE), (const bf16_t*)(ws + OFF_GU), (const float*)(ws + OFF_GW), O, ws, vcu, G, tid);
#endif
                GRID_SYNC(); STAMP(7);
                hn512_phase<false>(O, 2048, 4, inptr<16>(), PROJ, NP_GLA, 4096, ON, gw, NGW, lane);
            } else {
#if PH_LRU
                lru_phase(lds, PROJ, inptr<19>(), inptr<20>(), (const bf16_t*)(ws + OFF_WT_LRU_GR), (const bf16_t*)(ws + OFF_WT_LRU_GI), inptr<22>(), inptr<24>(), inptr<25>(), ON, vcu, G, tid);
#endif
            }
            GRID_SYNC(); STAMP((L == 0 ? 3 : L == 1 ? 6 : L == 2 ? 8 : 9));
        }
        {
            const bf16_t* A2 = half ? PROJ : ON; const bf16_t* Bt;
            if (half) Bt = (const bf16_t*)(ws + OFF_WT_DOWN + L * SZ_L);
            else Bt = (const bf16_t*)(ws + (L == 0 ? OFF_WT_RET_OUT : L == 1 ? OFF_WT_GDN_OUT : L == 2 ? OFF_WT_GLA_OUT : OFF_WT_LRU_OUT));
            pg8::EpiRes E; E.X = X; E.ldx = D; E.XG = XN; E.RSS = (float*)(ws + OFF_RSS);
            E.g = (hb == HBMAX - 1) ? inptr<3>() : (half ? inptr<1>() + (L + 1) * D : inptr<2>() + L * D);
#if PH_GEMM
            run_gemm(lds, A2, Bt, D, K2, E);
#endif
        }
        GRID_SYNC(); STAMP(10);
        if (hb == HBMAX - 1) { rmsnorm_phase(X, inptr<3>(), nullptr, nullptr, X, gw, NGW, lane); GRID_SYNC(); STAMP(11); }
    }

}

extern "C" void kernel_launch(void* const* d_in, const int* in_sizes, int n_in, void* d_out, int out_size, void* d_ws, size_t ws_size, hipStream_t stream) {
    static int grid_blocks = 0;
    if (!grid_blocks) {
        int dev = 0, cus = 0, per_cu = 0;
        hipGetDevice(&dev);
        hipDeviceGetAttribute(&cus, hipDeviceAttributeMultiprocessorCount, dev);
        hipFuncSetAttribute((const void*)fwd_kernel, hipFuncAttributeMaxDynamicSharedMemorySize, LDS_BYTES);
        hipOccupancyMaxActiveBlocksPerMultiprocessor(&per_cu, (const void*)fwd_kernel, NTHR, LDS_BYTES);
        if (per_cu < 1) { fprintf(stderr, "kernel_launch: occupancy query says %d blocks/CU\n", per_cu); per_cu = 1; }
        grid_blocks = cus * 1;
        if (ws_size < WS_END) fprintf(stderr, "kernel_launch: workspace too small: %zu < %zu\n", ws_size, (size_t)WS_END);
        if (n_in != 29) fprintf(stderr, "kernel_launch: expected 29 inputs, got %d\n", n_in);
    }
    Params p{};
    for (int i = 0; i < 29; ++i) p.in[i] = (const float*)d_in[i];
    p.out = (float*)d_out; p.ws = (unsigned char*)d_ws;
    (void)hipMemsetAsync((unsigned char*)d_ws + OFF_BAR, 0, XCD_BAR_WORDS * 4, stream);
    void* args[] = {&p};
    hipError_t e = hipLaunchCooperativeKernel((const void*)fwd_kernel, dim3(grid_blocks), dim3(NTHR), args, LDS_BYTES, stream);
    if (e != hipSuccess) fprintf(stderr, "cooperative launch failed: %s (grid %d)\n", hipGetErrorString(e), grid_blocks);
}
```

```cpp
#include <hip/hip_runtime.h>
#include <hip/hip_cooperative_groups.h>
#include <cstdio>
#include <cstdint>
namespace cg = cooperative_groups;
#ifndef PH_RET
#define PH_RET 1
#endif
#ifndef PH_GDN
#define PH_GDN 1
#endif
#ifndef PH_GDN2
#define PH_GDN2 1
#endif
#ifndef PH_GLA
#define PH_GLA 1
#endif
#ifndef PH_LRU
#define PH_LRU 1
#endif
#ifndef PH_GEMM
#define PH_GEMM 1
#endif
#ifndef HBMAX
#define HBMAX 8
#endif
namespace pg8 {
#define PG8_LAS __attribute__((address_space(3)))
typedef unsigned short bf16_t;
typedef short bf16x8 __attribute__((ext_vector_type(8)));
typedef float f32x4 __attribute__((ext_vector_type(4)));
typedef unsigned u32x4 __attribute__((ext_vector_type(4)));
constexpr int BM = 256, BK = 64, HALF = 128, HTB = HALF * BK * 2  , STAGE_BYTES = 8 * HTB, NXCD = 8, WGM = 4;

__host__ __device__ __forceinline__ int lds_byte(int r, int c) { const int st = (r >> 4) * 2 + (c >> 5), rr = r & 15, cc = c & 31, ob = rr * 64 + cc * 2; return st * 1024 + (ob ^ (((ob >> 9) & 1) << 5)); }
__host__ __device__ __forceinline__ void stage_rc(int b, int& R, int& C) { const int st = b / 1024, sb = b % 1024, swz = sb ^ (((sb >> 9) & 1) << 5); R = (st >> 1) * 16 + swz / 64; C = (st & 1) * 32 + (swz % 64) / 2; }
__host__ __device__ __forceinline__ int perm32(int rho) { const int n = rho >> 4, i = rho & 15; return 8 * (i >> 2) + 4 * n + (i & 3); }

struct Unit { int pm, pn; };
struct Gemm { const bf16_t* A; const bf16_t* Bt; int M, N, K; };

struct StaticOrder {
    int nM, nN, nwg, G, c;
    __host__ __device__ void init(int M, int N, int G_, int c_) { nM = M / BM; nN = N / BM; nwg = nM * nN; G = G_; c = c_; }
    __host__ __device__ bool next(int i, Unit& u) const {
        const long L = (long)i * G + c; if (L >= nwg) return false;
        int wgid = (int)L; { const int q = nwg / NXCD, r = nwg % NXCD, xcd = wgid % NXCD, off = wgid / NXCD; wgid = (xcd < r ? xcd * (q + 1) : r * (q + 1) + (xcd - r) * q) + off; }
        const int nig = WGM * nN, gid = wgid / nig, fm = gid * WGM, gsz = (nM - fm) < WGM ? (nM - fm) : WGM;
        u.pm = fm + ((wgid % nig) % gsz); u.pn = (wgid % nig) / gsz; return true;
    }
    __device__ __forceinline__ void a_ready(const Unit&) const {}
    __device__ __forceinline__ void done(const Unit&) const {}
    __device__ __forceinline__ void a_finish() const {}
};
typedef __bf16 hwbf16x2 __attribute__((ext_vector_type(2)));
typedef float cvtf32x2 __attribute__((ext_vector_type(2)));
__device__ __forceinline__ unsigned cvt_pk_bf16(float lo, float hi) { cvtf32x2 v; v.x = lo; v.y = hi; hwbf16x2 b = __builtin_convertvector(v, hwbf16x2); return __builtin_bit_cast(unsigned, b); }
template <class Epi, class Sched, bool ALIGN_EPI = false, bool SP2 = false>
__device__ __forceinline__ void gemm_phase(PG8_LAS unsigned char* lds, const Gemm g, const Sched& S, const Epi& E) {
    int tid = threadIdx.x; asm volatile("" : "+v"(tid)); const int wid = __builtin_amdgcn_readfirstlane(tid >> 6), lane = tid & 63, wr = wid >> 2, wc = wid & 3, fr = lane & 15, fq = lane >> 4;
    const int K = g.K, nt = K / BK;
    unsigned voffA[2], voffB[2];
#pragma unroll
    for (int i = 0; i < 2; ++i) { int R, C; stage_rc(tid * 16 + i * 8192, R, C); const int Rb = Epi::PERM ? ((R & ~31) + perm32(R & 31)) : R;
        voffA[i] = (unsigned)(R * K + C) * 2u; voffB[i] = (unsigned)(Rb * K + C) * 2u; }
    const size_t kstep = (size_t)(BK * 2);
    const size_t hstep = (size_t)HALF * K * 2;
    const size_t tstep = 2 * hstep;
    const unsigned ldsw = (unsigned)wid * 1024u;
    const int aoff = lds_byte(wr * 64 + fr, fq * 8), boff = lds_byte(wc * 32 + fr, fq * 8);
#define PG8_SA(b, h) (((b) * 2 + (h)) * HTB)
#define PG8_SB(b, h) ((4 + (b) * 2 + (h)) * HTB)
#define PG8_STAGE(bufoff, gbase, voff) do { _Pragma("unroll") for (int _i = 0; _i < 2; ++_i) \
        __builtin_amdgcn_global_load_lds((const unsigned*)((const char*)(gbase) + (voff)[_i]), (PG8_LAS unsigned*)(lds + (bufoff) + ldsw + _i * 8192), 16, 0, 0); } while (0)
#define PG8_LDA(dst, b, h) do { _Pragma("unroll") for (int m = 0; m < 4; ++m) _Pragma("unroll") for (int k = 0; k < 2; ++k) dst[m][k] = *(const PG8_LAS bf16x8*)(lds + PG8_SA(b, h) + aoff + m * 2048 + k * 1024); } while (0)
#define PG8_LDB(dst, b, h) do { _Pragma("unroll") for (int n = 0; n < 2; ++n) _Pragma("unroll") for (int k = 0; k < 2; ++k) dst[n][k] = *(const PG8_LAS bf16x8*)(lds + PG8_SB(b, h) + boff + n * 2048 + k * 1024); } while (0)
#define PG8_MMA(ai, bj, At, Bt) do { __builtin_amdgcn_s_setprio(1); _Pragma("unroll") for (int m = 0; m < 4; ++m) _Pragma("unroll") for (int n = 0; n < 2; ++n) _Pragma("unroll") for (int k = 0; k < 2; ++k) \
        acc[ai][bj][m][n] = __builtin_amdgcn_mfma_f32_16x16x32_bf16(Bt[n][k], At[m][k], acc[ai][bj][m][n], 0, 0, 0); __builtin_amdgcn_s_setprio(0); } while (0)
#define PG8_WAIT_V(n) asm volatile("s_waitcnt vmcnt(" #n ")" ::: "memory")
#define PG8_WAIT_L(n) asm volatile("s_waitcnt lgkmcnt(" #n ")" ::: "memory")
#define PG8_BAR __builtin_amdgcn_s_barrier()
#define PG8_SCHED __builtin_amdgcn_sched_barrier(0)
    Unit cur, nxt; int ui = 0;
    if (!S.next(0, cur)) return;
    f32x4 acc[2][2][4][2];
#pragma unroll
    for (int a = 0; a < 2; ++a)
#pragma unroll
        for (int b = 0; b < 2; ++b)
#pragma unroll
            for (int m = 0; m < 4; ++m)
#pragma unroll
                for (int n = 0; n < 2; ++n) acc[a][b][m][n] = (f32x4){0.f, 0.f, 0.f, 0.f};
    bf16x8 At[4][2], B0[2][2], B1[2][2];
    const char* cA = (const char*)g.A + (size_t)cur.pm * tstep; const char* cB = (const char*)g.Bt + (size_t)cur.pn * tstep;
    S.a_ready(cur); S.a_finish();
    if constexpr (SP2) {
        PG8_STAGE(PG8_SB(0, 0), cB, voffB); PG8_STAGE(PG8_SB(0, 1), cB + hstep, voffB); PG8_STAGE(PG8_SA(0, 0), cA, voffA); PG8_STAGE(PG8_SA(0, 1), cA + hstep, voffA);
        if (wr == 1) PG8_BAR;
        PG8_WAIT_V(2); PG8_BAR;
        PG8_STAGE(PG8_SB(1, 0), cB + kstep, voffB); PG8_STAGE(PG8_SA(1, 0), cA + kstep, voffA); PG8_STAGE(PG8_SB(1, 1), cB + hstep + kstep, voffB);
        PG8_WAIT_V(6); PG8_BAR;
    } else {
        PG8_STAGE(PG8_SB(0, 0), cB, voffB); PG8_STAGE(PG8_SA(0, 0), cA, voffA); PG8_STAGE(PG8_SB(0, 1), cB + hstep, voffB); PG8_STAGE(PG8_SA(0, 1), cA + hstep, voffA);
        if (wr == 1) PG8_BAR;
        PG8_WAIT_V(4); PG8_BAR;
        PG8_STAGE(PG8_SB(1, 0), cB + kstep, voffB); PG8_STAGE(PG8_SA(1, 0), cA + kstep, voffA); PG8_STAGE(PG8_SB(1, 1), cB + hstep + kstep, voffB);
        PG8_WAIT_V(6); PG8_BAR;
    }
    for (;;) {
        const bool has_next = S.next(ui + 1, nxt);
        const char* nA = has_next ? (const char*)g.A + (size_t)nxt.pm * tstep : cA; const char* nB = has_next ? (const char*)g.Bt + (size_t)nxt.pn * tstep : cB;
        for (int t = 0; t < nt; t += 2) {
            const bool last = (t == nt - 2);
            const char* a1 = cA + (size_t)(t + 1) * kstep;
            const char* a2 = last ? nA : cA + (size_t)(t + 2) * kstep; const char* b2 = last ? nB : cB + (size_t)(t + 2) * kstep;
            const char* a3 = a2 + kstep; const char* b3 = b2 + kstep;
            if (last && has_next) S.a_ready(nxt);
            if constexpr (SP2) {
            PG8_LDB(B0, 0, 0); PG8_LDB(B1, 0, 1); PG8_SCHED; PG8_LDA(At, 0, 0); PG8_STAGE(PG8_SA(1, 1), a1 + hstep, voffA);
            PG8_WAIT_V(8); PG8_WAIT_L(0); PG8_BAR; PG8_MMA(0, 0, At, B0); PG8_MMA(0, 1, At, B1); PG8_BAR; PG8_SCHED;
            PG8_LDA(At, 0, 1); PG8_STAGE(PG8_SB(0, 0), b2, voffB); PG8_STAGE(PG8_SB(0, 1), b2 + hstep, voffB); PG8_STAGE(PG8_SA(0, 0), a2, voffA);
            PG8_WAIT_V(8); PG8_WAIT_L(0); PG8_BAR; PG8_MMA(1, 0, At, B0); PG8_MMA(1, 1, At, B1); PG8_BAR; PG8_SCHED;
            PG8_LDB(B0, 1, 0); PG8_LDB(B1, 1, 1); PG8_SCHED; PG8_LDA(At, 1, 0); PG8_STAGE(PG8_SA(0, 1), a2 + hstep, voffA);
            PG8_WAIT_V(8); PG8_WAIT_L(0); PG8_BAR; PG8_MMA(0, 0, At, B0); PG8_MMA(0, 1, At, B1); PG8_BAR; PG8_SCHED;
            PG8_LDA(At, 1, 1); PG8_STAGE(PG8_SB(1, 0), b3, voffB); PG8_STAGE(PG8_SB(1, 1), b3 + hstep, voffB); PG8_STAGE(PG8_SA(1, 0), a3, voffA);
            PG8_WAIT_V(8); PG8_WAIT_L(0); PG8_BAR; PG8_MMA(1, 0, At, B0); PG8_MMA(1, 1, At, B1); PG8_BAR; PG8_SCHED;
            if (last && has_next) S.a_finish();
            } else {
            PG8_LDB(B0, 0, 0); PG8_SCHED; PG8_LDA(At, 0, 0); PG8_STAGE(PG8_SA(1, 1), a1 + hstep, voffA);
            PG8_WAIT_L(8); PG8_BAR; PG8_WAIT_L(0); PG8_MMA(0, 0, At, B0); PG8_BAR; PG8_SCHED;
            PG8_LDB(B1, 0, 1); PG8_STAGE(PG8_SB(0, 0), b2, voffB);
            PG8_BAR; PG8_WAIT_L(0); PG8_MMA(0, 1, At, B1); PG8_BAR;
            PG8_LDA(At, 0, 1); PG8_STAGE(PG8_SA(0, 0), a2, voffA);
            PG8_BAR; PG8_WAIT_L(0); PG8_MMA(1, 0, At, B0); PG8_BAR; PG8_SCHED;
            PG8_STAGE(PG8_SB(0, 1), b2 + hstep, voffB);
            PG8_WAIT_V(6); PG8_BAR; PG8_MMA(1, 1, At, B1); PG8_BAR;
            PG8_LDB(B0, 1, 0); PG8_SCHED; PG8_LDA(At, 1, 0); PG8_STAGE(PG8_SA(0, 1), a2 + hstep, voffA);
            PG8_WAIT_L(8); PG8_BAR; PG8_WAIT_L(0); PG8_MMA(0, 0, At, B0); PG8_BAR; PG8_SCHED;
            PG8_LDB(B1, 1, 1); PG8_STAGE(PG8_SB(1, 0), b3, voffB);
            PG8_BAR; PG8_WAIT_L(0); PG8_MMA(0, 1, At, B1); PG8_BAR;
            PG8_LDA(At, 1, 1); PG8_STAGE(PG8_SA(1, 0), a3, voffA);
            PG8_BAR; PG8_WAIT_L(0); PG8_MMA(1, 0, At, B0); PG8_BAR; PG8_SCHED;
            PG8_STAGE(PG8_SB(1, 1), b3 + hstep, voffB);
            PG8_WAIT_V(6); PG8_BAR; PG8_MMA(1, 1, At, B1); PG8_BAR;
            }
        }
        if constexpr (ALIGN_EPI) { if (wr == 0) PG8_BAR; }
        if constexpr (!Epi::AFTER_DRAIN) { E(acc, cur, wr, wc, fr, fq); S.done(cur); }
        if (!has_next) break;
#pragma unroll
        for (int a = 0; a < 2; ++a)
#pragma unroll
            for (int b = 0; b < 2; ++b)
#pragma unroll
                for (int m = 0; m < 4; ++m)
#pragma unroll
                    for (int n = 0; n < 2; ++n) acc[a][b][m][n] = (f32x4){0.f, 0.f, 0.f, 0.f};
        cur = nxt; cA = nA; cB = nB; ++ui;
        if constexpr (ALIGN_EPI) { if (wr == 1) PG8_BAR; }
    }
    PG8_WAIT_V(0);
    if constexpr (!ALIGN_EPI) { if (wr == 0) PG8_BAR; }
    PG8_BAR;
    if constexpr (Epi::AFTER_DRAIN) { E.fused(acc, cur, wr, wc, fr, fq, lds, wid, lane); S.done(cur); }
#undef PG8_SA
#undef PG8_SB
#undef PG8_STAGE
#undef PG8_LDA
#undef PG8_LDB
#undef PG8_MMA
#undef PG8_WAIT_V
#undef PG8_WAIT_L
#undef PG8_BAR
#undef PG8_SCHED
}

typedef unsigned u32x2 __attribute__((ext_vector_type(2)));
struct EpiBf {
    static constexpr bool PERM = true, AFTER_DRAIN = false;
    bf16_t* O; int ldo; float* SM; int slo, shi, relu2;
    const PG8_LAS float* ldsr; mutable int ne;
    __device__ __forceinline__ void operator()(const f32x4 (&acc)[2][2][4][2], const Unit& u, int wr, int wc, int fr, int fq) const {
        const int row0 = u.pm * BM + wr * 64 + fr, col0 = u.pn * BM + wc * 32 + 8 * fq;
        const PG8_LAS float* rsl = ldsr + (ne & 1) * 256 + wr * 64 + fr; ++ne;
#pragma unroll
        for (int ai = 0; ai < 2; ++ai)
#pragma unroll
            for (int m = 0; m < 4; ++m) { const size_t row = (size_t)(row0 + ai * HALF + m * 16); const float rs = rsl[ai * HALF + m * 16];
#pragma unroll
                for (int bj = 0; bj < 2; ++bj) { const int col = col0 + bj * HALF; f32x4 v0 = acc[ai][bj][m][0] * rs, v1 = acc[ai][bj][m][1] * rs;
                    if (relu2) { v0[0] = fmaxf(v0[0], 0.f); v0[1] = fmaxf(v0[1], 0.f); v0[2] = fmaxf(v0[2], 0.f); v0[3] = fmaxf(v0[3], 0.f); v0 = v0 * v0;
                                 v1[0] = fmaxf(v1[0], 0.f); v1[1] = fmaxf(v1[1], 0.f); v1[2] = fmaxf(v1[2], 0.f); v1[3] = fmaxf(v1[3], 0.f); v1 = v1 * v1; }
                    u32x4 o; o.x = cvt_pk_bf16(v0[0], v0[1]); o.y = cvt_pk_bf16(v0[2], v0[3]); o.z = cvt_pk_bf16(v1[0], v1[1]); o.w = cvt_pk_bf16(v1[2], v1[3]);
                    *(u32x4*)(O + row * ldo + col) = o;
                    if (col >= slo && col < shi) { *(f32x4*)(SM + row * 32 + (col - slo)) = v0; *(f32x4*)(SM + row * 32 + (col - slo) + 4) = v1; } } }
    }
};
struct EpiRes {
    static constexpr bool PERM = true, AFTER_DRAIN = false;
    float* X; int ldx; bf16_t* XG; const float* g; float* RSS;
    __device__ __forceinline__ void operator()(const f32x4 (&acc)[2][2][4][2], const Unit& u, int wr, int wc, int fr, int fq) const {
        const int row0 = u.pm * BM + wr * 64 + fr, col0 = u.pn * BM + wc * 32 + 8 * fq;
        f32x4 gv[2][2];
#pragma unroll
        for (int bj = 0; bj < 2; ++bj)
#pragma unroll
            for (int n = 0; n < 2; ++n) gv[bj][n] = *(const f32x4*)(g + col0 + bj * HALF + 4 * n);
#pragma unroll
        for (int ai = 0; ai < 2; ++ai)
#pragma unroll
            for (int m = 0; m < 4; ++m) { const size_t row = (size_t)(row0 + ai * HALF + m * 16); float* rowp = X + row * ldx + col0; bf16_t* gp = XG + row * ldx + col0; float ss = 0.f;
#pragma unroll
                for (int bj = 0; bj < 2; ++bj) { f32x4* p = (f32x4*)(rowp + bj * HALF);
                    const f32x4 x0 = p[0] + acc[ai][bj][m][0], x1 = p[1] + acc[ai][bj][m][1]; p[0] = x0; p[1] = x1;
                    ss += ((x0[0] * x0[0] + x0[1] * x0[1]) + (x0[2] * x0[2] + x0[3] * x0[3])) + ((x1[0] * x1[0] + x1[1] * x1[1]) + (x1[2] * x1[2] + x1[3] * x1[3]));
                    const f32x4 y0 = x0 * gv[bj][0], y1 = x1 * gv[bj][1];
                    u32x4 o; o.x = cvt_pk_bf16(y0[0], y0[1]); o.y = cvt_pk_bf16(y0[2], y0[3]); o.z = cvt_pk_bf16(y1[0], y1[1]); o.w = cvt_pk_bf16(y1[2], y1[3]); *(u32x4*)(gp + bj * HALF) = o; }
                ss += __shfl_xor(ss, 16); ss += __shfl_xor(ss, 32);
                if (fq == 0) RSS[row * 32 + u.pn * 4 + wc] = ss; }
    }
};
struct RstdOrder : StaticOrder {
    const float* RSS; PG8_LAS float* ldsr; mutable int na; mutable f32x4 ra, rb, rc, rd;
    __device__ __forceinline__ void a_ready(const Unit& u) const {
        int tid = threadIdx.x; asm volatile("" : "+v"(tid));
        const int rowl = (tid >> 6) * 32 + ((tid & 63) >> 1), half = tid & 1;
        const f32x4* p = (const f32x4*)(RSS + (size_t)(u.pm * BM + rowl) * 32 + 16 * half);
        ra = p[0]; rb = p[1]; rc = p[2]; rd = p[3];
    }
    __device__ __forceinline__ void a_finish() const {
        int tid = threadIdx.x; asm volatile("" : "+v"(tid));
        const int rowl = (tid >> 6) * 32 + ((tid & 63) >> 1), half = tid & 1;
        const f32x4 a = ra, b = rb, c = rc, d = rd;
        float s = (((a[0] + a[1]) + (a[2] + a[3])) + ((b[0] + b[1]) + (b[2] + b[3]))) + (((c[0] + c[1]) + (c[2] + c[3])) + ((d[0] + d[1]) + (d[2] + d[3])));
        s += __shfl_xor(s, 1);
        if (half == 0) ldsr[(na & 1) * 256 + rowl] = rsqrtf(s * (1.f / 2048.f) + 1e-6f);
        ++na;
    }
};
}

#define LAS __attribute__((address_space(3)))
typedef unsigned short bf16_t;
typedef short bf16x8 __attribute__((ext_vector_type(8)));
typedef float f32x4 __attribute__((ext_vector_type(4)));
typedef float f32x16 __attribute__((ext_vector_type(16)));
typedef unsigned u32x4 __attribute__((ext_vector_type(4)));
typedef unsigned u32x2 __attribute__((ext_vector_type(2)));

constexpr int T = 8192, D = 2048, FF = 8192, NTHR = 512;
constexpr int LDS_BYTES = 163840;
constexpr int NP_RET = 12288, NP_GDN = 8448, NP_GLA = 6400, NP_LRU = 4096;
constexpr size_t SZ_L = 33554432ull;
constexpr size_t OFF_WT_RET_IN = 0;
constexpr size_t OFF_WT_RET_OUT = OFF_WT_RET_IN + (size_t)NP_RET * D * 2;
constexpr size_t OFF_WT_GDN_IN = OFF_WT_RET_OUT + (size_t)D * 4096 * 2;
constexpr size_t OFF_WT_GDN_OUT = OFF_WT_GDN_IN + (size_t)NP_GDN * D * 2;
constexpr size_t OFF_WT_GLA_IN = OFF_WT_GDN_OUT + (size_t)D * D * 2;
constexpr size_t OFF_WT_GLA_OUT = OFF_WT_GLA_IN + (size_t)NP_GLA * D * 2;
constexpr size_t OFF_WT_LRU_IN = OFF_WT_GLA_OUT + (size_t)D * D * 2;
constexpr size_t OFF_WT_LRU_OUT = OFF_WT_LRU_IN + (size_t)NP_LRU * D * 2;
constexpr size_t OFF_WT_LRU_GR = OFF_WT_LRU_OUT + (size_t)D * D * 2;
constexpr size_t OFF_WT_LRU_GI = OFF_WT_LRU_GR + 16ull * 128 * 128 * 2;
constexpr size_t OFF_WT_UP = OFF_WT_LRU_GI + 16ull * 128 * 128 * 2;
constexpr size_t OFF_WT_DOWN = OFF_WT_UP + 4 * SZ_L;
constexpr size_t OFF_ROPE = OFF_WT_DOWN + 4 * SZ_L;
constexpr size_t OFF_XN = OFF_ROPE + 2ull * 2048 * 128 * 4;
constexpr size_t OFF_PROJ = OFF_XN + SZ_L;
constexpr size_t OFF_SM = OFF_PROJ + (size_t)T * NP_RET * 2;
constexpr size_t OFF_O = OFF_SM + (size_t)T * 32 * 4;
constexpr size_t OFF_ON = OFF_O + (size_t)T * 4096 * 4;
constexpr size_t OFF_GQ = OFF_ON + (size_t)T * 4096 * 2;
constexpr size_t OFF_GKE = OFF_GQ + SZ_L;
constexpr size_t OFF_GU = OFF_GKE + SZ_L;
constexpr size_t OFF_GW = OFF_GU + SZ_L;
constexpr size_t OFF_GG = OFF_GW + SZ_L;
constexpr size_t OFF_BAR = OFF_GG + 2048 * 4;
constexpr size_t OFF_RSS = OFF_BAR + 16384;
constexpr size_t WS_END = OFF_RSS + (size_t)T * 32 * 4;

__constant__ float LOGG[8] = {-0.0317486983145803f, -0.015748356968139168f, -0.007843177461025893f, -0.003913899321136329f,
                              -0.0019550348358033506f, -0.0009770396478266127f, -0.0004884004981088745f, -0.0002441704321739145f};

#define LDS_WAIT() asm volatile("s_waitcnt lgkmcnt(0)" ::: "memory")
__device__ __forceinline__ unsigned pk(float lo, float hi) { return pg8::cvt_pk_bf16(lo, hi); }
__device__ __forceinline__ bf16_t bf1(float v) { return (bf16_t)(pg8::cvt_pk_bf16(v, 0.f) & 0xffffu); }
__device__ __forceinline__ float bflo(unsigned v) { return __uint_as_float(v << 16); }
__device__ __forceinline__ float bfhi(unsigned v) { return __uint_as_float(v & 0xffff0000u); }
__device__ __forceinline__ float bf2f(bf16_t b) { return __uint_as_float(((unsigned)b) << 16); }
__device__ __forceinline__ float wave_sum(float v) {
#pragma unroll
    for (int o = 1; o < 64; o <<= 1) v += __shfl_xor(v, o);
    return v;
}
__device__ __forceinline__ float sigmoidf_(float x) { return __builtin_amdgcn_rcpf(1.f + __expf(-x)); }
__device__ __forceinline__ float siluf_(float x) { return x * __builtin_amdgcn_rcpf(1.f + __expf(-x)); }
#define ROWMAP(reg, hh) (((reg) & 3) + 8 * ((reg) >> 2) + 4 * (hh))

__device__ __forceinline__ void mma32(f32x16& acc, const LAS bf16_t* A, int lda, const LAS bf16_t* B, int ldb, int K, int lane) {
    const int r = lane & 31, h = lane >> 5;
    const LAS bf16_t* pa = A + r * lda + 8 * h; const LAS bf16_t* pb = B + r * ldb + 8 * h;
#pragma unroll 4
    for (int k = 0; k < K; k += 16) {
        const bf16x8 a = *(const LAS bf16x8*)(pa + k), b = *(const LAS bf16x8*)(pb + k);
        acc = __builtin_amdgcn_mfma_f32_32x32x16_bf16(a, b, acc, 0, 0, 0);
    }
}
__device__ __forceinline__ void mma32d(f32x16& acc, const LAS bf16_t* A, int lda, const LAS bf16_t* B, int ldb, int K, int lane) {
    const int r = lane & 31, h = lane >> 5;
    const LAS bf16_t* pa = A + r * lda + 8 * h; const LAS bf16_t* pb = B + r * ldb + 8 * h;
    f32x16 acc1;
#pragma unroll
    for (int i = 0; i < 16; ++i) acc1[i] = 0.f;
#pragma unroll 2
    for (int k = 0; k < K; k += 32) {
        const bf16x8 a0 = *(const LAS bf16x8*)(pa + k), b0 = *(const LAS bf16x8*)(pb + k), a1 = *(const LAS bf16x8*)(pa + k + 16), b1 = *(const LAS bf16x8*)(pb + k + 16);
        acc = __builtin_amdgcn_mfma_f32_32x32x16_bf16(a0, b0, acc, 0, 0, 0);
        acc1 = __builtin_amdgcn_mfma_f32_32x32x16_bf16(a1, b1, acc1, 0, 0, 0);
    }
    acc = acc + acc1;
}
__device__ __forceinline__ f32x16 zero16() { f32x16 z;
#pragma unroll
    for (int i = 0; i < 16; ++i) z[i] = 0.f; return z; }

struct Params { const float* in[29]; float* out; unsigned char* ws; };
template <int I> __device__ __forceinline__ const float* inptr() {
    const unsigned long long ka = (unsigned long long)__builtin_amdgcn_kernarg_segment_ptr();
    unsigned long long v;
    asm volatile("s_load_dwordx2 %0, %1, %2\n\ts_waitcnt lgkmcnt(0)" : "=&s"(v) : "s"(ka), "n"(I * 8) : "memory");
    return (const float*)(const __attribute__((address_space(1))) float*)v;
}

struct TDesc { const float* W; bf16_t* WT; int K, N, nblk, item; };
__device__ __forceinline__ void t_load(const TDesc& d, int lane, f32x4 (&v)[8]) {
    const int kb = d.item / d.nblk, nb = d.item - kb * d.nblk, k0 = 64 * kb, n0 = 32 * nb;
    const int n = n0 + 4 * (lane & 7); const bool ok = n < d.N;
#pragma unroll
    for (int i = 0; i < 8; ++i) { const int kk = 8 * i + (lane >> 3); v[i] = ok ? *(const f32x4*)(d.W + (size_t)(k0 + kk) * d.N + n) : (f32x4){0.f, 0.f, 0.f, 0.f}; }
}
__device__ __forceinline__ void t_store(const TDesc& d, LAS float* scr, int lane, const f32x4 (&v)[8]) {
    const int kb = d.item / d.nblk, nb = d.item - kb * d.nblk, k0 = 64 * kb, n0 = 32 * nb;
#pragma unroll
    for (int i = 0; i < 8; ++i) { const int kk = 8 * i + (lane >> 3); LAS float* q = scr + kk * 33 + 4 * (lane & 7); q[0] = v[i][0]; q[1] = v[i][1]; q[2] = v[i][2]; q[3] = v[i][3]; }
    LDS_WAIT();
    const int c = lane & 7;
#pragma unroll
    for (int j = 0; j < 4; ++j) { const int nn = (lane >> 3) + 8 * j; const LAS float* s = scr + (8 * c) * 33 + nn;
        u32x4 o; o.x = pk(s[0 * 33], s[1 * 33]); o.y = pk(s[2 * 33], s[3 * 33]); o.z = pk(s[4 * 33], s[5 * 33]); o.w = pk(s[6 * 33], s[7 * 33]);
        *(u32x4*)(d.WT + (size_t)(n0 + nn) * d.K + k0 + 8 * c) = o; }
    LDS_WAIT();
}
constexpr int I_RET_IN = (D / 64) * (NP_RET / 32), I_RET_OUT = (4096 / 64) * (D / 32), I_GDN_IN = (D / 64) * (NP_GDN / 32), I_SQ = (D / 64) * (D / 32),
              I_GLA_IN = (D / 64) * (NP_GLA / 32), I_LRU_IN = (D / 64) * (NP_LRU / 32), I_G = 16 * 8, I_UP = (D / 64) * (FF / 32), I_DN = (FF / 64) * (D / 32);
constexpr int NITEMS_A = I_RET_IN;
constexpr int NITEMS_C = I_GDN_IN + I_SQ + 2 * I_UP + 2 * I_DN + I_RET_OUT;
constexpr int NITEMS_B = I_GLA_IN + I_SQ + I_LRU_IN + I_SQ + 2 * I_G + 2 * I_UP + 2 * I_DN;
__device__ __forceinline__ TDesc p0_desc_a(unsigned char* ws, int it) {
    return TDesc{inptr<4>(), (bf16_t*)(ws + OFF_WT_RET_IN), D, 12288, NP_RET / 32, it};
}
__device__ __forceinline__ TDesc p0_desc_c(unsigned char* ws, int it) {
    int r = it;
    if (r < I_RET_OUT) return TDesc{inptr<6>(), (bf16_t*)(ws + OFF_WT_RET_OUT), 4096, D, D / 32, r}; r -= I_RET_OUT;
    if (r < 2 * I_UP) { const int l = r / I_UP; return TDesc{inptr<27>() + (size_t)l * D * FF, (bf16_t*)(ws + OFF_WT_UP + l * SZ_L), D, FF, FF / 32, r - l * I_UP}; } r -= 2 * I_UP;
    if (r < 2 * I_DN) { const int l = r / I_DN; return TDesc{inptr<28>() + (size_t)l * D * FF, (bf16_t*)(ws + OFF_WT_DOWN + l * SZ_L), FF, D, D / 32, r - l * I_DN}; } r -= 2 * I_DN;
    if (r < I_GDN_IN) return TDesc{inptr<7>(), (bf16_t*)(ws + OFF_WT_GDN_IN), D, 8224, NP_GDN / 32, r}; r -= I_GDN_IN;
    return TDesc{inptr<12>(), (bf16_t*)(ws + OFF_WT_GDN_OUT), D, D, D / 32, r};
}
__device__ __forceinline__ TDesc p0_desc_b(unsigned char* ws, int it) {
    int r = it;
    if (r < I_GLA_IN) return TDesc{inptr<13>(), (bf16_t*)(ws + OFF_WT_GLA_IN), D, 6160, NP_GLA / 32, r}; r -= I_GLA_IN;
    if (r < I_SQ) return TDesc{inptr<17>(), (bf16_t*)(ws + OFF_WT_GLA_OUT), D, D, D / 32, r}; r -= I_SQ;
    if (r < I_LRU_IN) return TDesc{inptr<18>(), (bf16_t*)(ws + OFF_WT_LRU_IN), D, 4096, NP_LRU / 32, r}; r -= I_LRU_IN;
    if (r < I_SQ) return TDesc{inptr<26>(), (bf16_t*)(ws + OFF_WT_LRU_OUT), D, D, D / 32, r}; r -= I_SQ;
    if (r < I_G) { const int blk = r >> 3; return TDesc{inptr<21>() + blk * 16384, (bf16_t*)(ws + OFF_WT_LRU_GR) + blk * 16384, 128, 128, 4, r & 7}; } r -= I_G;
    if (r < I_G) { const int blk = r >> 3; return TDesc{inptr<23>() + blk * 16384, (bf16_t*)(ws + OFF_WT_LRU_GI) + blk * 16384, 128, 128, 4, r & 7}; } r -= I_G;
    if (r < 2 * I_UP) { const int l = 2 + r / I_UP; return TDesc{inptr<27>() + (size_t)l * D * FF, (bf16_t*)(ws + OFF_WT_UP + l * SZ_L), D, FF, FF / 32, r - (l - 2) * I_UP}; } r -= 2 * I_UP;
    { const int l = 2 + r / I_DN; return TDesc{inptr<28>() + (size_t)l * D * FF, (bf16_t*)(ws + OFF_WT_DOWN + l * SZ_L), FF, D, D / 32, r - (l - 2) * I_DN}; }
}
__device__ __forceinline__ void p0_phase(const Params& p, LAS unsigned char* lds, int gw, int NGW, int wave, int lane) {
    LAS float* scr = (LAS float*)(lds + wave * 16384);
    unsigned char* ws = p.ws;
    constexpr int NITEMS = NITEMS_A;
#define p0_desc p0_desc_a
    if (gw < NITEMS) { int it = gw; TDesc d = p0_desc(ws, it); f32x4 v[8]; t_load(d, lane, v);
        for (;;) { const int itn = it + NGW; const bool more = itn < NITEMS; TDesc dn = d; f32x4 vn[8];
            if (more) { dn = p0_desc(ws, itn); t_load(dn, lane, vn); }
            t_store(d, scr, lane, v);
            if (!more) break;
            d = dn; it = itn;
#pragma unroll
            for (int i = 0; i < 8; ++i) v[i] = vn[i]; } }
#undef p0_desc
    { float* rss = (float*)(ws + OFF_RSS); for (int i = gw * 64 + lane; i < T * 32; i += NGW * 64) rss[i] = ((i & 31) == 0) ? 2047.997952f : 0.f; }
    float* rc = (float*)(ws + OFF_ROPE); float* rs = rc + 2048 * 128;
    for (int idx = gw * 64 + lane; idx < 2048 * 128; idx += NGW * 64) {
        const int s = idx >> 7, i = idx & 127;
        double inv = 1.0, bs = 0.9305720409296989792906463164991; int e = i;
#pragma unroll
        for (int b = 0; b < 7; ++b) { if (e & 1) inv *= bs; bs *= bs; e >>= 1; }
        const float angf = (float)s * (float)inv;
        const double a = (double)angf; const double q = __builtin_rint(a * 0.63661977236758134308);
        const double x = (a - q * 1.5707963267948965580) - q * 6.123233995736766e-17;
        const double x2 = x * x;
        const double sn = x * (1.0 + x2 * (-1.0 / 6 + x2 * (1.0 / 120 + x2 * (-1.0 / 5040 + x2 * (1.0 / 362880 + x2 * (-1.0 / 39916800 + x2 * (1.0 / 6227020800.0)))))));
        const double cs = 1.0 + x2 * (-0.5 + x2 * (1.0 / 24 + x2 * (-1.0 / 720 + x2 * (1.0 / 40320 + x2 * (-1.0 / 3628800 + x2 * (1.0 / 479001600.0))))));
        const int qi = ((int)q) & 3;
        const double co = (qi == 0) ? cs : (qi == 1) ? -sn : (qi == 2) ? -cs : sn;
        const double si = (qi == 0) ? sn : (qi == 1) ? cs : (qi == 2) ? -sn : -cs;
        rc[idx] = (float)co; rs[idx] = (float)si;
    }
}
__device__ __forceinline__ void rmsnorm_phase(const float* X, const float* g, bf16_t* XN, float* Xcopy, float* OutF, int gw, int NGW, int lane) {
    f32x4 gg[8];
#pragma unroll
    for (int j = 0; j < 8; ++j) gg[j] = ((const f32x4*)g)[lane + 64 * j];
    for (int m = gw; m < T; m += 2 * NGW) {
        const int m1 = (m + NGW < T) ? m + NGW : m;
        const f32x4* xr0 = (const f32x4*)(X + (size_t)m * D) + lane; const f32x4* xr1 = (const f32x4*)(X + (size_t)m1 * D) + lane;
        f32x4 v0[8], v1[8]; float s0 = 0.f, s1 = 0.f;
#pragma unroll
        for (int j = 0; j < 8; ++j) { v0[j] = xr0[64 * j]; v1[j] = xr1[64 * j]; }
#pragma unroll
        for (int j = 0; j < 8; ++j) { s0 += (v0[j][0] * v0[j][0] + v0[j][1] * v0[j][1]) + (v0[j][2] * v0[j][2] + v0[j][3] * v0[j][3]);
                                      s1 += (v1[j][0] * v1[j][0] + v1[j][1] * v1[j][1]) + (v1[j][2] * v1[j][2] + v1[j][3] * v1[j][3]); }
#pragma unroll
        for (int o = 1; o < 64; o <<= 1) { s0 += __shfl_xor(s0, o); s1 += __shfl_xor(s1, o); }
        const float rs0 = rsqrtf(s0 * (1.f / D) + 1e-6f), rs1 = rsqrtf(s1 * (1.f / D) + 1e-6f);
#pragma unroll
        for (int j = 0; j < 8; ++j) { const f32x4 y0 = v0[j] * rs0 * gg[j], y1 = v1[j] * rs1 * gg[j];
            if (XN) { u32x2 o; o.x = pk(y0[0], y0[1]); o.y = pk(y0[2], y0[3]); *(u32x2*)(XN + (size_t)m * D + 4 * lane + 256 * j) = o;
                      o.x = pk(y1[0], y1[1]); o.y = pk(y1[2], y1[3]); *(u32x2*)(XN + (size_t)m1 * D + 4 * lane + 256 * j) = o; }
            if (Xcopy) { ((f32x4*)(Xcopy + (size_t)m * D))[lane + 64 * j] = v0[j]; ((f32x4*)(Xcopy + (size_t)m1 * D))[lane + 64 * j] = v1[j]; }
            if (OutF) { ((f32x4*)(OutF + (size_t)m * D))[lane + 64 * j] = y0; ((f32x4*)(OutF + (size_t)m1 * D))[lane + 64 * j] = y1; } }
    }
}
#define LBAR() do { asm volatile("s_waitcnt lgkmcnt(0)" ::: "memory"); __builtin_amdgcn_s_barrier(); asm volatile("" ::: "memory"); } while (0)

__device__ __forceinline__ void ret_pre_phase(LAS unsigned char* lds, const bf16_t* __restrict__ PROJ, const float* __restrict__ ropeC, const float* __restrict__ ropeS,
                                              bf16_t* __restrict__ GQR, bf16_t* __restrict__ GKT, bf16_t* __restrict__ GS, int vcu, int G, int tid_in) {
    constexpr int LDP = NP_RET;
    LAS bf16_t* sQ = (LAS bf16_t*)lds;
    LAS bf16_t* sK = sQ + 64 * 264;
    LAS bf16_t* sKT = sK + 64 * 264;
    LAS bf16_t* sS = sKT + 256 * 72;
    for (int u = vcu; u < 1024; u += G) {
        int tid = tid_in; asm volatile("" : "+v"(tid)); const int lane = tid & 63, w = __builtin_amdgcn_readfirstlane(tid >> 6), r = lane & 31, hh = lane >> 5;
        const int bh = u >> 5, n = u & 31, b = bh >> 3, h = bh & 7, t0 = b * 2048 + n * 64, s0 = n * 64;
        const float lg = LOGG[h];
#pragma unroll
        for (int it = 0; it < 2; ++it) {
            const int idx = tid + it * 512, c = idx >> 4, g = idx & 15;
            const bf16_t* qrow = PROJ + (size_t)(t0 + c) * LDP + h * 256 + 8 * g;
            const u32x4 q1 = *(const u32x4*)qrow, q2 = *(const u32x4*)(qrow + 128), k1 = *(const u32x4*)(qrow + 2048), k2 = *(const u32x4*)(qrow + 2048 + 128);
            const float* cp = ropeC + (size_t)(s0 + c) * 128 + 8 * g; const float* sp = ropeS + (size_t)(s0 + c) * 128 + 8 * g;
            const f32x4 c0 = *(const f32x4*)cp, c1 = *(const f32x4*)(cp + 4), n0 = *(const f32x4*)sp, n1 = *(const f32x4*)(sp + 4);
            u32x4 oq1, oq2, ok1, ok2;
#pragma unroll
            for (int e = 0; e < 4; ++e) {
                const float ca = (e < 2) ? c0[2 * e] : c1[2 * e - 4], cb = (e < 2) ? c0[2 * e + 1] : c1[2 * e - 3];
                const float sa = (e < 2) ? n0[2 * e] : n1[2 * e - 4], sb = (e < 2) ? n0[2 * e + 1] : n1[2 * e - 3];
                const float x1a = bflo(q1[e]), x1b = bfhi(q1[e]), x2a = bflo(q2[e]), x2b = bfhi(q2[e]);
                oq1[e] = pk(x1a * ca - x2a * sa, x1b * cb - x2b * sb); oq2[e] = pk(x1a * sa + x2a * ca, x1b * sb + x2b * cb);
                const float y1a = bflo(k1[e]) * 0.0625f, y1b = bfhi(k1[e]) * 0.0625f, y2a = bflo(k2[e]) * 0.0625f, y2b = bfhi(k2[e]) * 0.0625f;
                ok1[e] = pk(y1a * ca - y2a * sa, y1b * cb - y2b * sb); ok2[e] = pk(y1a * sa + y2a * ca, y1b * sb + y2b * cb);
            }
            *(LAS u32x4*)(sQ + c * 264 + 8 * g) = oq1; *(LAS u32x4*)(sQ + c * 264 + 128 + 8 * g) = oq2;
            *(LAS u32x4*)(sK + c * 264 + 8 * g) = ok1; *(LAS u32x4*)(sK + c * 264 + 128 + 8 * g) = ok2;
            *(u32x4*)(GQR + ((size_t)u * 64 + c) * 256 + 8 * g) = oq1; *(u32x4*)(GQR + ((size_t)u * 64 + c) * 256 + 128 + 8 * g) = oq2;
        }
        LBAR();
#pragma unroll
        for (int it = 0; it < 4; ++it) { const int idx = tid + it * 512, d = idx & 255, c0 = (idx >> 8) * 8; u32x4 o;
#pragma unroll
            for (int e = 0; e < 4; ++e) { const float a = bf2f(sK[(c0 + 2 * e) * 264 + d]) * __expf(lg * (float)(63 - (c0 + 2 * e)));
                const float bb = bf2f(sK[(c0 + 2 * e + 1) * 264 + d]) * __expf(lg * (float)(62 - (c0 + 2 * e))); o[e] = pk(a, bb); }
            *(LAS u32x4*)(sKT + d * 72 + c0) = o; }
        if (w < 4) { const int ci = w >> 1, xi = w & 1; f32x16 acc = zero16();
            mma32(acc, sQ + 32 * ci * 264, 264, sK + 32 * xi * 264, 264, 256, lane);
#pragma unroll
            for (int reg = 0; reg < 16; ++reg) { const int c = 32 * ci + ROWMAP(reg, hh), m = 32 * xi + r; const int dd = c > m ? c - m : m - c;
                sS[c * 72 + m] = bf1(acc[reg] * __expf(lg * (float)dd)); } }
        LBAR();
#pragma unroll
        for (int it = 0; it < 4; ++it) { const int idx = tid + it * 512, d = idx >> 3, g = idx & 7; *(u32x4*)(GKT + ((size_t)u * 256 + d) * 64 + 8 * g) = *(const LAS u32x4*)(sKT + d * 72 + 8 * g); }
        *(u32x4*)(GS + ((size_t)u * 64 + (tid >> 3)) * 64 + 8 * (tid & 7)) = *(const LAS u32x4*)(sS + (tid >> 3) * 72 + 8 * (tid & 7));
        LBAR();
    }
}
__device__ __forceinline__ void ret_scan_phase(LAS unsigned char* lds, const bf16_t* __restrict__ PROJ, const bf16_t* __restrict__ GQR, const bf16_t* __restrict__ GKT,
                                               const bf16_t* __restrict__ GS, bf16_t* __restrict__ O, unsigned char* ws, int vcu, int G, int tid_in) {
    constexpr int LDP = NP_RET;
    const int wq = __builtin_amdgcn_readfirstlane(tid_in >> 6);
    int bj = vcu * 4 + wq; const int bstride = G * 4;
    TDesc bd0 = TDesc{nullptr, nullptr, 0, 0, 1, 0}; f32x4 bv0[8]; bool bh0 = false;
    LAS float* bscr = (LAS float*)(lds + 122880 + (wq & 3) * 8704);
#define BG_ISSUE(dd, vv_, hh_) do { if (bj < NITEMS_C) { dd = p0_desc_c(ws, bj); t_load(dd, blane, vv_); hh_ = true; bj += bstride; } else hh_ = false; } while (0)
#define BG_STEP(dd, vv_, hh_) do { if (hh_) { t_store(dd, bscr, blane, vv_); BG_ISSUE(dd, vv_, hh_); } } while (0)
    if (wq < 4) { int blane = tid_in & 63; asm volatile("" : "+v"(blane)); BG_ISSUE(bd0, bv0, bh0); }
    LAS bf16_t* sQ = (LAS bf16_t*)lds;
    LAS bf16_t* sKT = sQ + 64 * 264;
    LAS bf16_t* sVT = sKT + 256 * 72;
    LAS bf16_t* sS = sVT + 64 * 72;
    LAS bf16_t* sST = sS + 64 * 72;
    for (int u = vcu; u < 256; u += G) {
        const int bh = u >> 3, jv = u & 7, b = bh >> 3, h = bh & 7;
        const float lg = LOGG[h], cdec = __expf(lg * 64.f);
        f32x16 S0 = zero16(), S1 = zero16();
        u32x4 rQ[4], rK[4], rS, rvv;
#define RET_PREFETCH(nn) do { const size_t chn = (size_t)bh * 32 + (nn); const int t0p = b * 2048 + (nn) * 64; \
            _Pragma("unroll") for (int it = 0; it < 4; ++it) { const int idx = tidp + it * 512; \
                rQ[it] = *(const u32x4*)(GQR + (chn * 64 + (idx >> 5)) * 256 + 8 * (idx & 31)); rK[it] = *(const u32x4*)(GKT + (chn * 256 + (idx >> 3)) * 64 + 8 * (idx & 7)); } \
            rS = *(const u32x4*)(GS + (chn * 64 + (tidp >> 3)) * 64 + 8 * (tidp & 7)); \
            rvv = *(const u32x4*)(PROJ + (size_t)(t0p + (tidp >> 3)) * LDP + 4096 + h * 512 + jv * 64 + 8 * (tidp & 7)); } while (0)
        { int tidp = tid_in; asm volatile("" : "+v"(tidp)); RET_PREFETCH(0); }
        for (int n = 0; n < 32; ++n) {
            int tid = tid_in; asm volatile("" : "+v"(tid)); const int lane = tid & 63, w = __builtin_amdgcn_readfirstlane(tid >> 6), r = lane & 31, hh = lane >> 5;
            const int t0 = b * 2048 + n * 64;
#pragma unroll
            for (int it = 0; it < 4; ++it) { const int idx = tid + it * 512; *(LAS u32x4*)(sQ + (idx >> 5) * 264 + 8 * (idx & 31)) = rQ[it]; *(LAS u32x4*)(sKT + (idx >> 3) * 72 + 8 * (idx & 7)) = rK[it]; }
            *(LAS u32x4*)(sS + (tid >> 3) * 72 + 8 * (tid & 7)) = rS;
            { const int c = tid >> 3, g = tid & 7;
#pragma unroll
              for (int e = 0; e < 4; ++e) { sVT[(8 * g + 2 * e) * 72 + c] = (bf16_t)(rvv[e] & 0xffffu); sVT[(8 * g + 2 * e + 1) * 72 + c] = (bf16_t)(rvv[e] >> 16); } }
            if (n == 0) {
#pragma unroll
                for (int g4 = 0; g4 < 4; ++g4) { const int dk = 32 * w + 8 * g4 + 4 * hh; u32x2 a; a.x = 0u; a.y = 0u; *(LAS u32x2*)(sST + r * 264 + dk) = a; *(LAS u32x2*)(sST + (32 + r) * 264 + dk) = a; } }
            LBAR();
            if (n < 31) { const int tidp = tid; RET_PREFETCH(n + 1); }
            if (w < 4) { const int blane = lane; BG_STEP(bd0, bv0, bh0); }
            if (w >= 4) { const int ci = (w - 4) >> 1, xi = (w - 4) & 1; f32x16 acc = zero16();
                mma32(acc, sQ + 32 * ci * 264, 264, sST + 32 * xi * 264, 264, 256, lane);
#pragma unroll
                for (int reg = 0; reg < 16; ++reg) { const int c = 32 * ci + ROWMAP(reg, hh); acc[reg] *= __expf(lg * (float)(c + 1)); }
                mma32(acc, sS + 32 * ci * 72, 72, sVT + 32 * xi * 72, 72, 64, lane);
#pragma unroll
                for (int reg = 0; reg < 16; ++reg) { const int c = 32 * ci + ROWMAP(reg, hh); O[(size_t)(t0 + c) * 4096 + h * 512 + jv * 64 + 32 * xi + r] = bf1(acc[reg]); } }
            { f32x16 u0 = S0 * cdec, u1 = S1 * cdec;
              mma32(u0, sKT + 32 * w * 72, 72, sVT, 72, 64, lane); mma32(u1, sKT + 32 * w * 72, 72, sVT + 32 * 72, 72, 64, lane); S0 = u0; S1 = u1; }
            LBAR();
#pragma unroll
            for (int g4 = 0; g4 < 4; ++g4) { const int dk = 32 * w + 8 * g4 + 4 * hh; u32x2 a, c2;
                a.x = pk(S0[4 * g4], S0[4 * g4 + 1]); a.y = pk(S0[4 * g4 + 2], S0[4 * g4 + 3]); c2.x = pk(S1[4 * g4], S1[4 * g4 + 1]); c2.y = pk(S1[4 * g4 + 2], S1[4 * g4 + 3]);
                *(LAS u32x2*)(sST + r * 264 + dk) = a; *(LAS u32x2*)(sST + (32 + r) * 264 + dk) = c2; }
            if (w < 4) { const int blane = lane; BG_STEP(bd0, bv0, bh0); }
        }
#undef RET_PREFETCH
        LBAR();
    }
    if (wq < 4) { int blane = tid_in & 63; asm volatile("" : "+v"(blane)); while (bh0) { BG_STEP(bd0, bv0, bh0); } }
#undef BG_ISSUE
#undef BG_STEP
}
template <bool CENTER>
__device__ __forceinline__ void hn512_phase(const bf16_t* __restrict__ O, int ldo, int H, const float* __restrict__ gain, const bf16_t* __restrict__ PROJ, int ldp, int gcol0,
                                            bf16_t* __restrict__ ON, int gw, int NGW, int lane) {
    const int NI = T * H;
    for (int it0 = gw; it0 < NI; it0 += 4 * NGW) {
        f32x4 v[4][2], gg[4][2]; u32x4 gt[4]; int tt[4], hx[4];
#pragma unroll
        for (int q = 0; q < 4; ++q) { int it = it0 + q * NGW; if (it >= NI) it = it0;
            const int t = it / H, h = it - t * H; tt[q] = t; hx[q] = h; const int col = h * 512 + 8 * lane;
            const u32x4 a = *(const u32x4*)(O + (size_t)t * ldo + col);
            v[q][0] = (f32x4){bflo(a.x), bfhi(a.x), bflo(a.y), bfhi(a.y)}; v[q][1] = (f32x4){bflo(a.z), bfhi(a.z), bflo(a.w), bfhi(a.w)};
            gg[q][0] = *(const f32x4*)(gain + col); gg[q][1] = *(const f32x4*)(gain + col + 4); gt[q] = *(const u32x4*)(PROJ + (size_t)t * ldp + gcol0 + col); }
        float rs[4];
        if (CENTER) { float mean[4];
#pragma unroll
            for (int q = 0; q < 4; ++q) mean[q] = (v[q][0][0] + v[q][0][1]) + (v[q][0][2] + v[q][0][3]) + (v[q][1][0] + v[q][1][1]) + (v[q][1][2] + v[q][1][3]);
#pragma unroll
            for (int o = 1; o < 64; o <<= 1) {
#pragma unroll
                for (int q = 0; q < 4; ++q) mean[q] += __shfl_xor(mean[q], o); }
#pragma unroll
            for (int q = 0; q < 4; ++q) { const float mu = mean[q] * (1.f / 512.f); v[q][0] = v[q][0] - mu; v[q][1] = v[q][1] - mu; } }
#pragma unroll
        for (int q = 0; q < 4; ++q) rs[q] = (v[q][0][0] * v[q][0][0] + v[q][0][1] * v[q][0][1]) + (v[q][0][2] * v[q][0][2] + v[q][0][3] * v[q][0][3]) + (v[q][1][0] * v[q][1][0] + v[q][1][1] * v[q][1][1]) + (v[q][1][2] * v[q][1][2] + v[q][1][3] * v[q][1][3]);
#pragma unroll
        for (int o = 1; o < 64; o <<= 1) {
#pragma unroll
            for (int q = 0; q < 4; ++q) rs[q] += __shfl_xor(rs[q], o); }
#pragma unroll
        for (int q = 0; q < 4; ++q) { const float r1 = rsqrtf(rs[q] * (1.f / 512.f) + 1e-6f); const int col = hx[q] * 512 + 8 * lane; const u32x4 gq = gt[q]; const f32x4 g0 = gg[q][0], g1 = gg[q][1];
            u32x4 o; o.x = pk(v[q][0][0] * r1 * g0[0] * siluf_(bflo(gq.x)), v[q][0][1] * r1 * g0[1] * siluf_(bfhi(gq.x)));
            o.y = pk(v[q][0][2] * r1 * g0[2] * siluf_(bflo(gq.y)), v[q][0][3] * r1 * g0[3] * siluf_(bfhi(gq.y)));
            o.z = pk(v[q][1][0] * r1 * g1[0] * siluf_(bflo(gq.z)), v[q][1][1] * r1 * g1[1] * siluf_(bfhi(gq.z)));
            o.w = pk(v[q][1][2] * r1 * g1[2] * siluf_(bflo(gq.w)), v[q][1][3] * r1 * g1[3] * siluf_(bfhi(gq.w)));
            *(u32x4*)(ON + (size_t)tt[q] * ldo + col) = o; }
    }
}

__device__ __forceinline__ void gdn_prep_phase(LAS unsigned char* lds, const bf16_t* __restrict__ PROJ, const float* __restrict__ SM, const float* __restrict__ conv_w,
                                               const float* __restrict__ a_log, const float* __restrict__ dt_bias, bf16_t* __restrict__ GQ, bf16_t* __restrict__ GKE,
                                               bf16_t* __restrict__ GU, bf16_t* __restrict__ GW, float* __restrict__ GG, int vcu, int G, int tid_in) {
    constexpr int LDP = NP_GDN;
    LAS float* sSol = (LAS float*)lds;
    LAS float* sA = sSol + 64 * 257;
    LAS float* sBeta = sA + 64 * 68;
    LAS float* sCum = sBeta + 64;
    LAS bf16_t* sKb = (LAS bf16_t*)(sCum + 64);
    LAS bf16_t* sRaw = sKb + 64 * 136;
    for (int u = vcu; u < 2048; u += G) {
        int tid = tid_in; asm volatile("" : "+v"(tid)); const int lane = tid & 63, w = __builtin_amdgcn_readfirstlane(tid >> 6), r = lane & 31, hh = lane >> 5;
        const int b = u >> 9, h = (u >> 5) & 15, n = u & 31;
        const int t0 = b * 2048 + n * 64, s0 = n * 64;
        u32x4 raw[3];
#define GDN_PREFETCH(ten) do { _Pragma("unroll") for (int it = 0; it < 3; ++it) { const int idx = tid + it * 512, rr = idx >> 4, g = idx & 15; raw[it] = (u32x4){0u, 0u, 0u, 0u}; \
            if (idx < 67 * 16 && s0 - 3 + rr >= 0) raw[it] = *(const u32x4*)(PROJ + (size_t)(t0 - 3 + rr) * LDP + (ten) * 2048 + h * 128 + 8 * g); } } while (0)
        GDN_PREFETCH(0);
        float cw[3][4][2];
#pragma unroll
        for (int ten = 0; ten < 3; ++ten)
#pragma unroll
            for (int tap = 0; tap < 4; ++tap) { const float* cp = conv_w + tap * 6144 + ten * 2048 + h * 128 + 2 * lane; cw[ten][tap][0] = cp[0]; cw[ten][tap][1] = cp[1]; }
        if (tid < 64) {
            const float bl = SM[(size_t)(t0 + tid) * 32 + h], al = SM[(size_t)(t0 + tid) * 32 + 16 + h];
            const float x = al + dt_bias[h];
            const float sp = (x > 20.f) ? x : log1pf(__expf(x));
            float la = -__expf(a_log[h]) * sp;
#pragma unroll
            for (int o = 1; o < 64; o <<= 1) { const float y = __shfl_up(la, o); if (lane >= o) la += y; }
            sBeta[tid] = sigmoidf_(bl); sCum[tid] = la;
        }
#pragma unroll
        for (int ten = 0; ten < 3; ++ten) {
#pragma unroll
            for (int it = 0; it < 3; ++it) { const int idx = tid + it * 512, rr = idx >> 4, g = idx & 15; if (idx < 67 * 16) *(LAS u32x4*)(sRaw + rr * 136 + 8 * g) = raw[it]; }
            LBAR();
            if (ten == 0) GDN_PREFETCH(1);
            if (ten == 1) GDN_PREFETCH(2);
            const float cumL = sCum[63];
            float a0[8], a1[8], ss[8];
#pragma unroll
            for (int rr = 0; rr < 8; ++rr) { const int c = w + 8 * rr; float x0 = 0.f, x1 = 0.f;
#pragma unroll
                for (int tap = 0; tap < 4; ++tap) { const unsigned xv = *(const LAS unsigned*)(sRaw + (c + tap) * 136 + 2 * lane); x0 += bflo(xv) * cw[ten][tap][0]; x1 += bfhi(xv) * cw[ten][tap][1]; }
                a0[rr] = siluf_(x0); a1[rr] = siluf_(x1); ss[rr] = a0[rr] * a0[rr] + a1[rr] * a1[rr]; }
            if (ten != 2) {
#pragma unroll
                for (int o = 1; o < 64; o <<= 1) {
#pragma unroll
                    for (int rr = 0; rr < 8; ++rr) ss[rr] += __shfl_xor(ss[rr], o); } }
#pragma unroll
            for (int rr = 0; rr < 8; ++rr) { const int c = w + 8 * rr; const float beta = sBeta[c], cum = sCum[c];
                if (ten == 2) { sSol[c * 257 + 2 * lane] = beta * a0[rr]; sSol[c * 257 + 2 * lane + 1] = beta * a1[rr]; }
                else { float rn = rsqrtf(ss[rr] + 1e-6f);
                    if (ten == 0) { rn *= 0.08838834764831845f; *(unsigned*)(GQ + ((size_t)u * 64 + c) * 128 + 2 * lane) = pk(a0[rr] * rn, a1[rr] * rn); }
                    else { const float k0 = a0[rr] * rn, k1 = a1[rr] * rn; *(LAS unsigned*)(sKb + c * 136 + 2 * lane) = pk(k0, k1);
                        const float f = beta * __expf(cum); sSol[c * 257 + 128 + 2 * lane] = f * k0; sSol[c * 257 + 128 + 2 * lane + 1] = f * k1;
                        const float e = __expf(cumL - cum); *(unsigned*)(GKE + ((size_t)u * 64 + c) * 128 + 2 * lane) = pk(k0 * e, k1 * e); } } }
            LBAR();
        }
#undef GDN_PREFETCH
        const float cumL = sCum[63];
        if (w < 4) { const int ci = w >> 1, mi = w & 1; f32x16 acc = zero16();
            mma32(acc, sKb + 32 * ci * 136, 136, sKb + 32 * mi * 136, 136, 128, lane);
#pragma unroll
            for (int reg = 0; reg < 16; ++reg) { const int c = 32 * ci + ROWMAP(reg, hh), m = 32 * mi + r;
                sA[c * 68 + m] = (c > m) ? sBeta[c] * __expf(sCum[c] - sCum[m]) * acc[reg] : 0.f; } }
        LBAR();
        { const int j = tid & 255, pp = tid >> 8;
          for (int kb = 0; kb < 8; ++kb) { const int c0 = 8 * kb + 4 * pp; float a[4];
#pragma unroll
              for (int q = 0; q < 4; ++q) a[q] = sSol[(c0 + q) * 257 + j];
              for (int m = 0; m < 8 * kb; m += 4) { float sv[4];
#pragma unroll
                  for (int q = 0; q < 4; ++q) sv[q] = sSol[(m + q) * 257 + j];
#pragma unroll
                  for (int q = 0; q < 4; ++q) { const f32x4 A = *(const LAS f32x4*)(sA + (c0 + q) * 68 + m); a[q] -= (A[0] * sv[0] + A[1] * sv[1]) + (A[2] * sv[2] + A[3] * sv[3]); } }
              if (pp == 1) LBAR();
              if (pp == 1) { float sv[4];
#pragma unroll
                  for (int q = 0; q < 4; ++q) sv[q] = sSol[(8 * kb + q) * 257 + j];
#pragma unroll
                  for (int q = 0; q < 4; ++q) { const f32x4 A = *(const LAS f32x4*)(sA + (c0 + q) * 68 + 8 * kb); a[q] -= (A[0] * sv[0] + A[1] * sv[1]) + (A[2] * sv[2] + A[3] * sv[3]); } }
              { const f32x4 D1 = *(const LAS f32x4*)(sA + (c0 + 1) * 68 + c0), D2 = *(const LAS f32x4*)(sA + (c0 + 2) * 68 + c0), D3 = *(const LAS f32x4*)(sA + (c0 + 3) * 68 + c0);
                a[1] -= D1[0] * a[0]; a[2] -= D2[0] * a[0] + D2[1] * a[1]; a[3] -= D3[0] * a[0] + D3[1] * a[1] + D3[2] * a[2]; }
#pragma unroll
              for (int q = 0; q < 4; ++q) sSol[(c0 + q) * 257 + j] = a[q];
              if (pp == 0) LBAR();
              LBAR(); } }
#pragma unroll 4
        for (int it = 0; it < 16; ++it) { const int idx = tid + it * 512, c = idx >> 7, p2 = idx & 127; const unsigned o = pk(sSol[c * 257 + 2 * p2], sSol[c * 257 + 2 * p2 + 1]);
            if (p2 < 64) *(unsigned*)(GU + ((size_t)u * 64 + c) * 128 + 2 * p2) = o; else *(unsigned*)(GW + ((size_t)u * 64 + c) * 128 + 2 * p2 - 128) = o; }
        if (tid == 0) GG[u] = __expf(cumL);
        LBAR();
    }
}
__device__ __forceinline__ void gdn_scan_phase(LAS unsigned char* lds, const bf16_t* __restrict__ GQ, const bf16_t* __restrict__ GKE, const bf16_t* __restrict__ GU,
                                               const bf16_t* __restrict__ GW, const float* __restrict__ GG, bf16_t* __restrict__ O, unsigned char* ws, int vcu, int G, int tid_in) {
    const int wq = __builtin_amdgcn_readfirstlane(tid_in >> 6);
    int bj = vcu * 4 + (wq - 4); const int bstride = G * 4;
    TDesc bd0 = TDesc{nullptr, nullptr, 0, 0, 1, 0}, bd1 = bd0; f32x4 bv0[8], bv1[8]; bool bh0 = false, bh1 = false;
    LAS float* bscr = (LAS float*)(lds + 81920 + (wq & 3) * 8704);
#define BG_ISSUE(dd, vv_, hh_) do { if (bj < NITEMS_B) { dd = p0_desc_b(ws, bj); t_load(dd, blane, vv_); hh_ = true; bj += bstride; } else hh_ = false; } while (0)
#define BG_STEP(dd, vv_, hh_) do { if (hh_) { t_store(dd, bscr, blane, vv_); BG_ISSUE(dd, vv_, hh_); } } while (0)
    if (wq >= 4) { int blane = tid_in & 63; asm volatile("" : "+v"(blane)); BG_ISSUE(bd0, bv0, bh0); BG_ISSUE(bd1, bv1, bh1); }
    LAS bf16_t* sW = (LAS bf16_t*)lds;
    LAS bf16_t* sQ = sW + 64 * 136;
    LAS bf16_t* sKET = sQ + 64 * 136;
    LAS bf16_t* sST = sKET + 128 * 72;
    LAS bf16_t* sDT = sST + 32 * 136;
    LAS bf16_t* sU = sDT + 32 * 72;
    for (int u = vcu; u < 256; u += G) {
        const int bh = u >> 2, jv = u & 3, b = bh >> 4, h = bh & 15;
        f32x16 S = zero16();
        u32x4 rW[2], rQ[2], rK[2], rU; float rg = 0.f; int zoff = 0; asm volatile("" : "+v"(zoff));
        rU = (u32x4){0u, 0u, 0u, 0u};
#define SCAN_PREFETCH(nn) do { const size_t chn = (size_t)bh * 32 + (nn); \
            _Pragma("unroll") for (int it = 0; it < 2; ++it) { const int idx = tidp + it * 512, c = idx >> 4, g = idx & 15; const size_t go = (chn * 64 + c) * 128 + 8 * g; \
                rW[it] = *(const u32x4*)(GW + go); rQ[it] = *(const u32x4*)(GQ + go); rK[it] = *(const u32x4*)(GKE + go); } \
            if (tidp < 256) rU = *(const u32x4*)(GU + (chn * 64 + (tidp >> 2)) * 128 + jv * 32 + 8 * (tidp & 3)); \
            rg = GG[chn + zoff]; } while (0)
        { int tidp = tid_in; asm volatile("" : "+v"(tidp)); SCAN_PREFETCH(0); }
        for (int n = 0; n < 32; ++n) {
            int tid = tid_in; asm volatile("" : "+v"(tid)); const int lane = tid & 63, w = __builtin_amdgcn_readfirstlane(tid >> 6), r = lane & 31, hh = lane >> 5;
            const int t0 = b * 2048 + n * 64;
#pragma unroll
            for (int it = 0; it < 2; ++it) { const int idx = tid + it * 512, c = idx >> 4, g = idx & 15;
                *(LAS u32x4*)(sW + c * 136 + 8 * g) = rW[it]; *(LAS u32x4*)(sQ + c * 136 + 8 * g) = rQ[it];
#pragma unroll
                for (int e = 0; e < 4; ++e) { sKET[(8 * g + 2 * e) * 72 + c] = (bf16_t)(rK[it][e] & 0xffffu); sKET[(8 * g + 2 * e + 1) * 72 + c] = (bf16_t)(rK[it][e] >> 16); } }
            if (tid < 256) *(LAS u32x4*)(sU + (tid >> 2) * 40 + 8 * (tid & 3)) = rU;
            if (n == 0 && w < 4) {
#pragma unroll
                for (int g4 = 0; g4 < 4; ++g4) { u32x2 a; a.x = 0u; a.y = 0u; *(LAS u32x2*)(sST + r * 136 + 32 * w + 8 * g4 + 4 * hh) = a; } }
            const float cg_ = rg;
            LBAR();
            if (n < 31) { const int tidp = tid; SCAN_PREFETCH(n + 1); }
            if (w >= 4) { const int blane = lane; BG_STEP(bd0, bv0, bh0); }
            if (w < 2) { f32x16 acc = zero16(); mma32(acc, sW + 32 * w * 136, 136, sST, 136, 128, lane);
#pragma unroll
                for (int g4 = 0; g4 < 4; ++g4) { const int c = 32 * w + 8 * g4 + 4 * hh; const LAS bf16_t* up = sU + c * 40 + r;
                    u32x2 a; a.x = pk(bf2f(up[0]) - acc[4 * g4], bf2f(up[40]) - acc[4 * g4 + 1]); a.y = pk(bf2f(up[80]) - acc[4 * g4 + 2], bf2f(up[120]) - acc[4 * g4 + 3]);
                    *(LAS u32x2*)(sDT + r * 72 + c) = a; } }
            LBAR();
            if (w < 4) { f32x16 s2 = S * cg_; mma32(s2, sKET + 32 * w * 72, 72, sDT, 72, 64, lane); S = s2;
#pragma unroll
                for (int g4 = 0; g4 < 4; ++g4) { u32x2 a; a.x = pk(S[4 * g4], S[4 * g4 + 1]); a.y = pk(S[4 * g4 + 2], S[4 * g4 + 3]); *(LAS u32x2*)(sST + r * 136 + 32 * w + 8 * g4 + 4 * hh) = a; } }
            LBAR();
            if (w >= 4) { const int blane = lane; BG_STEP(bd1, bv1, bh1); }
            if (w < 2) { f32x16 acc = zero16(); mma32(acc, sQ + 32 * w * 136, 136, sST, 136, 128, lane);
#pragma unroll
                for (int reg = 0; reg < 16; ++reg) { const int c = 32 * w + ROWMAP(reg, hh); O[(size_t)(t0 + c) * 2048 + h * 128 + jv * 32 + r] = bf1(acc[reg]); } }
            LBAR();
        }
#undef SCAN_PREFETCH
    }
    if (wq >= 4) { int blane = tid_in & 63; asm volatile("" : "+v"(blane)); while (bh0 || bh1) { BG_STEP(bd0, bv0, bh0); BG_STEP(bd1, bv1, bh1); } }
#undef BG_ISSUE
#undef BG_STEP
}
__device__ __forceinline__ void gdn_hn_phase(const bf16_t* __restrict__ O, const float* __restrict__ gain, const bf16_t* __restrict__ PROJ, bf16_t* __restrict__ ON, int gw, int NGW, int lane) {
    for (int t = gw; t < T; t += NGW) {
#pragma unroll
        for (int j = 0; j < 8; ++j) { const int col = 4 * lane + 256 * j;
            const u32x2 ov = *(const u32x2*)(O + (size_t)t * 2048 + col); const f32x4 v = (f32x4){bflo(ov.x), bfhi(ov.x), bflo(ov.y), bfhi(ov.y)};
            float ss = (v[0] * v[0] + v[1] * v[1]) + (v[2] * v[2] + v[3] * v[3]);
#pragma unroll
            for (int o = 1; o < 32; o <<= 1) ss += __shfl_xor(ss, o);
            const float rs = rsqrtf(ss * (1.f / 128.f) + 1e-6f);
            const f32x4 gg = *(const f32x4*)(gain + (col & 127)); const u32x2 zt = *(const u32x2*)(PROJ + (size_t)t * NP_GDN + 6144 + col);
            u32x2 o; o.x = pk(v[0] * rs * gg[0] * siluf_(bflo(zt.x)), v[1] * rs * gg[1] * siluf_(bfhi(zt.x)));
            o.y = pk(v[2] * rs * gg[2] * siluf_(bflo(zt.y)), v[3] * rs * gg[3] * siluf_(bfhi(zt.y)));
            *(u32x2*)(ON + (size_t)t * 2048 + col) = o; }
    }
}

__device__ __forceinline__ void gla_pre_phase(LAS unsigned char* lds, const bf16_t* __restrict__ PROJ, const float* __restrict__ SM, const float* __restrict__ wg,
                                              const float* __restrict__ gbias, bf16_t* __restrict__ GQI, bf16_t* __restrict__ GKBT, bf16_t* __restrict__ GS, float* __restrict__ GE,
                                              int vcu, int G, int tid_in) {
    constexpr int LDP = NP_GLA;
    LAS bf16_t* bufA = (LAS bf16_t*)lds;
    LAS bf16_t* bufB = bufA + 64 * 264;
    LAS bf16_t* sKbT = bufB + 64 * 264;
    LAS bf16_t* sS = sKbT + 256 * 72;
    LAS float* sTot = (LAS float*)(sS + 64 * 72);
    LAS float* sGL = sTot + 512;
    for (int u = vcu; u < 512; u += G) {
        int tid = tid_in; asm volatile("" : "+v"(tid)); const int lane = tid & 63, w = __builtin_amdgcn_readfirstlane(tid >> 6), r = lane & 31, hh = lane >> 5;
        const int dk = tid & 255, half = tid >> 8;
        const int bh = u >> 5, n = u & 31, b = bh >> 2, h = bh & 3, t0 = b * 2048 + n * 64;
        float wgc[16];
#pragma unroll
        for (int q = 0; q < 16; ++q) wgc[q] = wg[q * 1024 + h * 256 + dk];
        const float gb = gbias[h * 256 + dk];
        u32x4 qraw[4], kraw[4];
#pragma unroll
        for (int it = 0; it < 4; ++it) { const int idx = tid + it * 512, c = idx >> 5, g = idx & 31; const bf16_t* pr = PROJ + (size_t)(t0 + c) * LDP + h * 256 + 8 * g;
            qraw[it] = *(const u32x4*)pr; kraw[it] = *(const u32x4*)(pr + 1024); }
        if (tid < 256) *(LAS f32x4*)(sGL + (tid >> 2) * 16 + 4 * (tid & 3)) = *(const f32x4*)(SM + (size_t)(t0 + (tid >> 2)) * 32 + 4 * (tid & 3));
#pragma unroll
        for (int it = 0; it < 4; ++it) { const int idx = tid + it * 512, c = idx >> 5, g = idx & 31; *(LAS u32x4*)(bufA + c * 264 + 8 * g) = qraw[it]; *(LAS u32x4*)(bufB + c * 264 + 8 * g) = kraw[it]; }
        LBAR();
        float cum[32]; float run = 0.f;
#pragma unroll
        for (int i = 0; i < 32; ++i) { const int c = 32 * half + i; float x = gb;
#pragma unroll
            for (int q = 0; q < 16; ++q) x += sGL[c * 16 + q] * wgc[q];
            const float ls = fminf(x, 0.f) - __logf(1.f + __expf(-fabsf(x))); run += ls * 0.0625f; cum[i] = run;
            if ((i & 7) == 7) __builtin_amdgcn_sched_barrier(0); }
        sTot[half * 256 + dk] = run;
        LBAR();
        const float tot0 = sTot[dk], tot1 = sTot[256 + dk], E0 = __expf(tot0);
        if (half == 0) { GE[(size_t)u * 512 + dk] = __expf(tot1); GE[(size_t)u * 512 + 256 + dk] = __expf(tot0 + tot1); }
        const float off = half ? 0.f : -tot0;
        unsigned pkreg[32]; unsigned kbp[16]; unsigned pkq[16];
#pragma unroll
        for (int i = 0; i < 32; ++i) { const int c = 32 * half + i; const float v = cum[i] + off, e = __expf(v), ei = __expf(-v);
            const float q = bf2f(bufA[c * 264 + dk]) * 0.0625f, k = bf2f(bufB[c * 264 + dk]);
            const unsigned a = pk(q * e, k * ei);
            bufA[c * 264 + dk] = (bf16_t)(a & 0xffffu); bufB[c * 264 + dk] = (bf16_t)(a >> 16);
            if (i & 1) kbp[i >> 1] |= (a & 0xffff0000u); else kbp[i >> 1] = a >> 16;
            const unsigned qi = pk(q * e * E0, 0.f);
            if (i & 1) pkq[i >> 1] |= (qi << 16); else pkq[i >> 1] = qi & 0xffffu;
            pkreg[i] = pk(q * ei, k * e);
            if ((i & 7) == 7) __builtin_amdgcn_sched_barrier(0); }
#pragma unroll
        for (int q = 0; q < 4; ++q) { u32x4 o; o.x = kbp[4 * q]; o.y = kbp[4 * q + 1]; o.z = kbp[4 * q + 2]; o.w = kbp[4 * q + 3]; *(LAS u32x4*)(sKbT + dk * 72 + 32 * half + 8 * q) = o; }
        LBAR();
        f32x16 accA = zero16();
        const int ci = (w & 3) >> 1, mi = w & 1;
        if (w < 4) mma32(accA, bufA + 32 * ci * 264, 264, bufB + 32 * mi * 264, 264, 256, lane);
#pragma unroll
        for (int it = 0; it < 4; ++it) { const int idx = tid + it * 512, d = idx >> 3, g = idx & 7; *(u32x4*)(GKBT + ((size_t)u * 256 + d) * 64 + 8 * g) = *(const LAS u32x4*)(sKbT + d * 72 + 8 * g); }
        LBAR();
#pragma unroll
        for (int i = 0; i < 32; ++i) { const int c = 32 * half + i; bufA[c * 264 + dk] = (bf16_t)(pkreg[i] & 0xffffu); bufB[c * 264 + dk] = (bf16_t)(pkreg[i] >> 16); }
        LBAR();
        if (w < 4) { f32x16 accU = zero16(); mma32(accU, bufA + 32 * ci * 264, 264, bufB + 32 * mi * 264, 264, 256, lane);
#pragma unroll
            for (int reg = 0; reg < 16; ++reg) { const int c = 32 * ci + ROWMAP(reg, hh), m = 32 * mi + r; sS[c * 72 + m] = bf1((c >= m) ? accA[reg] : accU[reg]); } }
        LBAR();
#pragma unroll
        for (int i = 0; i < 32; ++i) { const int c = 32 * half + i; bufA[c * 264 + dk] = (bf16_t)((i & 1) ? (pkq[i >> 1] >> 16) : (pkq[i >> 1] & 0xffffu)); }
        *(u32x4*)(GS + ((size_t)u * 64 + (tid >> 3)) * 64 + 8 * (tid & 7)) = *(const LAS u32x4*)(sS + (tid >> 3) * 72 + 8 * (tid & 7));
        LBAR();
#pragma unroll
        for (int it = 0; it < 4; ++it) { const int idx = tid + it * 512, c = idx >> 5, g = idx & 31; *(u32x4*)(GQI + ((size_t)u * 64 + c) * 256 + 8 * g) = *(const LAS u32x4*)(bufA + c * 264 + 8 * g); }
        LBAR();
    }
}
__device__ __forceinline__ void gla_scan_phase(LAS unsigned char* lds, const bf16_t* __restrict__ PROJ, const bf16_t* __restrict__ GQI, const bf16_t* __restrict__ GKBT,
                                               const bf16_t* __restrict__ GS, const float* __restrict__ GE, bf16_t* __restrict__ O, int vcu, int G, int tid_in) {
    constexpr int LDP = NP_GLA;
    LAS bf16_t* bufA = (LAS bf16_t*)lds;
    LAS bf16_t* sKbT = bufA + 64 * 264;
    LAS bf16_t* sVT = sKbT + 256 * 72;
    LAS bf16_t* sS = sVT + 32 * 72;
    LAS bf16_t* sST = sS + 64 * 72;
    LAS float* sE = (LAS float*)(sST + 32 * 264);
    for (int u = vcu; u < 256; u += G) {
        const int bh = u >> 4, jv = u & 15, b = bh >> 2, h = bh & 3;
        f32x16 S = zero16();
        u32x4 rQ[4], rK[4], rS; f32x4 rE = (f32x4){0.f, 0.f, 0.f, 0.f}; u32x2 vv;
#define GLA_PREFETCH(nn) do { const size_t chn = (size_t)bh * 32 + (nn); const int t0p = b * 2048 + (nn) * 64; \
            _Pragma("unroll") for (int it = 0; it < 4; ++it) { const int idx = tidp + it * 512; \
                rQ[it] = *(const u32x4*)(GQI + (chn * 64 + (idx >> 5)) * 256 + 8 * (idx & 31)); rK[it] = *(const u32x4*)(GKBT + (chn * 256 + (idx >> 3)) * 64 + 8 * (idx & 7)); } \
            rS = *(const u32x4*)(GS + (chn * 64 + (tidp >> 3)) * 64 + 8 * (tidp & 7)); \
            if (tidp < 128) rE = *(const f32x4*)(GE + chn * 512 + 4 * tidp); \
            vv = *(const u32x2*)(PROJ + (size_t)(t0p + (tidp >> 3)) * LDP + 2048 + h * 512 + jv * 32 + 4 * (tidp & 7)); } while (0)
        { int tidp = tid_in; asm volatile("" : "+v"(tidp)); GLA_PREFETCH(0); }
        for (int n = 0; n < 32; ++n) {
            int tid = tid_in; asm volatile("" : "+v"(tid)); const int lane = tid & 63, w = __builtin_amdgcn_readfirstlane(tid >> 6), r = lane & 31, hh = lane >> 5;
            const int t0 = b * 2048 + n * 64;
#pragma unroll
            for (int it = 0; it < 4; ++it) { const int idx = tid + it * 512; *(LAS u32x4*)(bufA + (idx >> 5) * 264 + 8 * (idx & 31)) = rQ[it]; *(LAS u32x4*)(sKbT + (idx >> 3) * 72 + 8 * (idx & 7)) = rK[it]; }
            *(LAS u32x4*)(sS + (tid >> 3) * 72 + 8 * (tid & 7)) = rS;
            if (tid < 128) *(LAS f32x4*)(sE + 4 * tid) = rE;
            { const int c = tid >> 3, g = tid & 7;
              sVT[(4 * g) * 72 + c] = (bf16_t)(vv.x & 0xffffu); sVT[(4 * g + 1) * 72 + c] = (bf16_t)(vv.x >> 16); sVT[(4 * g + 2) * 72 + c] = (bf16_t)(vv.y & 0xffffu); sVT[(4 * g + 3) * 72 + c] = (bf16_t)(vv.y >> 16); }
            if (n == 0) {
#pragma unroll
                for (int g4 = 0; g4 < 4; ++g4) { u32x2 a; a.x = 0u; a.y = 0u; *(LAS u32x2*)(sST + r * 264 + 32 * w + 8 * g4 + 4 * hh) = a; } }
            LBAR();
            if (n < 31) { const int tidp = tid; GLA_PREFETCH(n + 1); }
            if (w == 4 || w == 5) { f32x16 acc = zero16(); mma32(acc, bufA + 32 * (w - 4) * 264, 264, sST, 264, 256, lane); mma32(acc, sS + 32 * (w - 4) * 72, 72, sVT, 72, 64, lane);
#pragma unroll
                for (int reg = 0; reg < 16; ++reg) { const int c = 32 * (w - 4) + ROWMAP(reg, hh); O[(size_t)(t0 + c) * 2048 + h * 512 + jv * 32 + r] = bf1(acc[reg]); } }
            { f32x16 up = zero16(); mma32(up, sKbT + 32 * w * 72, 72, sVT, 72, 64, lane);
#pragma unroll
              for (int reg = 0; reg < 16; ++reg) { const int dkr = 32 * w + ROWMAP(reg, hh); S[reg] = S[reg] * sE[256 + dkr] + sE[dkr] * up[reg]; } }
            LBAR();
#pragma unroll
            for (int g4 = 0; g4 < 4; ++g4) { u32x2 a; a.x = pk(S[4 * g4], S[4 * g4 + 1]); a.y = pk(S[4 * g4 + 2], S[4 * g4 + 3]); *(LAS u32x2*)(sST + r * 264 + 32 * w + 8 * g4 + 4 * hh) = a; }
        }
#undef GLA_PREFETCH
        LBAR();
    }
}
__device__ __forceinline__ float gelu_tanh_(float y) { const float z = 0.7978845608028654f * (y + 0.044715f * y * y * y); const float th = 1.f - 2.f * __builtin_amdgcn_rcpf(1.f + __expf(2.f * z)); return 0.5f * y * (1.f + th); }
__device__ __forceinline__ void lru_phase(LAS unsigned char* lds, const bf16_t* __restrict__ PROJ, const float* __restrict__ conv_w, const float* __restrict__ conv_b,
                                          const bf16_t* __restrict__ WTr, const bf16_t* __restrict__ WTi, const float* __restrict__ b_r, const float* __restrict__ b_i,
                                          const float* __restrict__ lam, bf16_t* __restrict__ ON, int vcu, int G, int tid_in) {
    constexpr int LDP = NP_LRU;
    LAS bf16_t* sX = (LAS bf16_t*)lds;
    LAS bf16_t* sWr = sX + 128 * 136;
    LAS bf16_t* sWi = sWr + 32 * 136;
    LAS float* sXf = (LAS float*)(sWi + 32 * 136);
    LAS float* sA = sXf + 128 * 33;
    LAS float* sM = sA + 128 * 33;
    LAS float* sU = sM + 128 * 33;
    LAS float* sSeg = sU + 128 * 33;
    LAS float* sCarry = sSeg + 1024;
    for (int u = vcu; u < 256; u += G) {
        const int b = u >> 6, nb = (u >> 2) & 15, es = u & 3, ch0 = nb * 128 + es * 32;
        int tidu = tid_in; asm volatile("" : "+v"(tidu));
        { const int tid = tidu; const int e = tid >> 4, g = tid & 15; const size_t go = ((size_t)nb * 128 + es * 32 + e) * 128 + 8 * g;
          *(LAS u32x4*)(sWr + e * 136 + 8 * g) = *(const u32x4*)(WTr + go); *(LAS u32x4*)(sWi + e * 136 + 8 * g) = *(const u32x4*)(WTi + go); }
        float cw[4][2];
#pragma unroll
        for (int tap = 0; tap < 4; ++tap) { cw[tap][0] = conv_w[tap * 2048 + nb * 128 + 2 * (tidu & 63)]; cw[tap][1] = conv_w[tap * 2048 + nb * 128 + 2 * (tidu & 63) + 1]; }
        const float cb0 = conv_b[nb * 128 + 2 * (tidu & 63)], cb1 = conv_b[nb * 128 + 2 * (tidu & 63) + 1];
        if (tidu < 32) sCarry[tidu] = 0.f;
        const float br = b_r[ch0 + (tidu & 31)], bi = b_i[ch0 + (tidu & 31)], c8 = -8.f * log1pf(__expf(-lam[ch0 + (tidu & 31)]));
        for (int tt = 0; tt < 16; ++tt) {
            int tid = tid_in; asm volatile("" : "+v"(tid)); const int lane = tid & 63, w = __builtin_amdgcn_readfirstlane(tid >> 6), r = lane & 31, hh = lane >> 5; (void)r; (void)hh; (void)w; (void)lane;
            const int s0 = tt * 128; const size_t t0 = (size_t)b * 2048 + s0;
            __syncthreads();
            { const int p2 = tid & 63, rg = tid >> 6, col = nb * 128 + 2 * p2;
              float xa[3], xb[3];
#pragma unroll
              for (int k = 0; k < 3; ++k) { const int s = s0 + 16 * rg - 3 + k; unsigned xv = 0u; if (s >= 0) xv = *(const unsigned*)(PROJ + (t0 + 16 * rg - 3 + k) * LDP + col); xa[k] = bflo(xv); xb[k] = bfhi(xv); }
              const bool mine = ((2 * p2) >> 5) == es;
#pragma unroll
              for (int i = 0; i < 16; ++i) { const int row = 16 * rg + i; const unsigned xv = *(const unsigned*)(PROJ + (t0 + row) * LDP + col); const float ca = bflo(xv), cbv = bfhi(xv);
                  const float o0 = cb0 + cw[0][0] * xa[0] + cw[1][0] * xa[1] + cw[2][0] * xa[2] + cw[3][0] * ca;
                  const float o1 = cb1 + cw[0][1] * xb[0] + cw[1][1] * xb[1] + cw[2][1] * xb[2] + cw[3][1] * cbv;
                  *(LAS unsigned*)(sX + row * 136 + 2 * p2) = pk(o0, o1);
                  if (mine) { sXf[row * 33 + ((2 * p2) & 31)] = o0; sXf[row * 33 + ((2 * p2) & 31) + 1] = o1; }
                  xa[0] = xa[1]; xa[1] = xa[2]; xa[2] = ca; xb[0] = xb[1]; xb[1] = xb[2]; xb[2] = cbv; } }
            __syncthreads();
            { f32x16 acc = zero16(); const int rt = w & 3;
              if (w < 4) { mma32(acc, sX + 32 * rt * 136, 136, sWr, 136, 128, lane);
#pragma unroll
                  for (int reg = 0; reg < 16; ++reg) { const int row = 32 * rt + ROWMAP(reg, hh); const float la = c8 * sigmoidf_(acc[reg] + br); const float av = __expf(la); sA[row * 33 + r] = av; sM[row * 33 + r] = __builtin_amdgcn_sqrtf(fmaxf(1.f - av * av, 0.f)); } }
              else { mma32(acc, sX + 32 * rt * 136, 136, sWi, 136, 128, lane);
#pragma unroll
                  for (int reg = 0; reg < 16; ++reg) { const int row = 32 * rt + ROWMAP(reg, hh); sU[row * 33 + r] = sigmoidf_(acc[reg] + bi) * sXf[row * 33 + r]; } } }
            __syncthreads();
            { const int e = tid & 31, seg = tid >> 5; float A = 1.f, H = 0.f; float av[8], uv[8];
#pragma unroll
              for (int i = 0; i < 8; ++i) { const int t = seg * 8 + i; av[i] = sA[t * 33 + e]; uv[i] = sM[t * 33 + e] * sU[t * 33 + e]; H = av[i] * H + uv[i]; A *= av[i]; }
              sSeg[(seg * 32 + e) * 2] = A; sSeg[(seg * 32 + e) * 2 + 1] = H;
              __syncthreads();
              float hin = sCarry[e]; float sa_[15], sh_[15];
#pragma unroll
              for (int s2 = 0; s2 < 15; ++s2) { sa_[s2] = sSeg[(s2 * 32 + e) * 2]; sh_[s2] = sSeg[(s2 * 32 + e) * 2 + 1]; }
#pragma unroll
              for (int s2 = 0; s2 < 15; ++s2) hin = (s2 < seg) ? sa_[s2] * hin + sh_[s2] : hin;
#pragma unroll
              for (int i = 0; i < 8; ++i) { hin = av[i] * hin + uv[i]; const size_t t = t0 + seg * 8 + i;
                  const float y = bf2f(PROJ[t * LDP + 2048 + ch0 + e]); ON[t * 2048 + ch0 + e] = bf1(hin * gelu_tanh_(y)); }
              __syncthreads();
              if (seg == 15) sCarry[e] = hin; }
        }
        __syncthreads();
    }
}

#define XB_TMO      128
#define XB_XCNT(j)  (256  + 64 * (j))
#define XB_XSUB(j)  (1280 + 64 * (j))
#define XB_XGEN(j)  (2304 + 64 * (j))
#define XB_TOP      3328
#define XB_TOPGEN   3392
#define XCD_BAR_WORDS 3456
#define XB_SPIN_CAP (1u << 18)

__device__ __forceinline__ unsigned xb_ld(unsigned* p)              { return __hip_atomic_load(p, __ATOMIC_RELAXED, __HIP_MEMORY_SCOPE_AGENT); }
__device__ __forceinline__ unsigned xb_add(unsigned* p, unsigned v) { return __hip_atomic_fetch_add(p, v, __ATOMIC_RELAXED, __HIP_MEMORY_SCOPE_AGENT); }
__device__ __forceinline__ unsigned xb_xcc_id() { return (unsigned)__builtin_amdgcn_s_getreg((3 << 11) | 20) & 0xFu; }
#define XB_SPIN(cond, bar) do { unsigned _sp = 0; while (cond) { __builtin_amdgcn_s_sleep(1); \
    if ((++_sp & 255u) == 0u) { if (xb_ld(&(bar)[XB_TMO])) break; if (_sp > XB_SPIN_CAP) { atomicAdd(&(bar)[XB_TMO], 1u); break; } } } } while (0)

struct XcdBarrier {
    unsigned* bar; unsigned x;
    volatile LAS unsigned* st;
};

__device__ __forceinline__ XcdBarrier xcd_barrier_post(unsigned* bar, volatile LAS unsigned* st) {
    XcdBarrier b; b.bar = bar; b.x = xb_xcc_id(); b.st = st;
    if (threadIdx.x == 0) (void)xb_add(&bar[XB_XCNT(b.x)], 1u);
    return b;
}
__device__ __forceinline__ void xcd_barrier_complete(unsigned* bar, unsigned x, unsigned& nloc, unsigned& nx) {
    const unsigned G = gridDim.x * gridDim.y * gridDim.z;
    unsigned sum, cnt, mine, sp = 0u;
    for (;;) {
        sum = 0u; cnt = 0u; mine = 0u;
#pragma unroll
        for (unsigned j = 0; j < 16; ++j) { const unsigned c = xb_ld(&bar[XB_XCNT(j)]); sum += c; cnt += (c > 0u) ? 1u : 0u; mine = (j == x) ? c : mine; }
        if (sum == G) break;
        __builtin_amdgcn_s_sleep(1);
        if ((++sp & 255u) == 0u) { if (xb_ld(&bar[XB_TMO])) break; if (sp > XB_SPIN_CAP) { atomicAdd(&bar[XB_TMO], 1u); break; } }
    }
    nloc = mine > 0u ? mine : 1u; nx = cnt > 0u ? cnt : 1u;
}

__device__ __forceinline__ void xcd_barrier(const XcdBarrier& b) {
    asm volatile("s_waitcnt vmcnt(0)" ::: "memory");
    __syncthreads();
    if (threadIdx.x == 0) {
        unsigned* bar = b.bar;
        __builtin_amdgcn_s_waitcnt(0);
        unsigned nloc = b.st[0], nx = b.st[1];
        if (nloc == 0u) { xcd_barrier_complete(bar, b.x, nloc, nx); b.st[0] = nloc; b.st[1] = nx; }
        const unsigned old = xb_add(&bar[XB_XSUB(b.x)], 1u);
        const unsigned gen = old / nloc;
        if (old + 1u == (gen + 1u) * nloc) {
            __builtin_amdgcn_fence(__ATOMIC_RELEASE, "agent");
            asm volatile("s_waitcnt vmcnt(0)" ::: "memory");
            const unsigned og = xb_add(&bar[XB_TOP], 1u);
            const unsigned tg = og / nx;
            if (og + 1u == (tg + 1u) * nx) xb_add(&bar[XB_TOPGEN], 1u);
            else XB_SPIN(xb_ld(&bar[XB_TOPGEN]) == tg, bar);
            __builtin_amdgcn_fence(__ATOMIC_ACQUIRE, "agent");
            xb_add(&bar[XB_XGEN(b.x)], 1u);
            asm volatile("s_waitcnt vmcnt(0)" ::: "memory");
        } else {
            XB_SPIN(xb_ld(&bar[XB_XGEN(b.x)]) == gen, bar);
            __builtin_amdgcn_fence(__ATOMIC_ACQUIRE, "agent");
            asm volatile("s_waitcnt vmcnt(0)" ::: "memory");
        }
    }
    __syncthreads();
}

template <class Epi> __device__ __forceinline__ void run_gemm(LAS unsigned char* lds, const bf16_t* A, const bf16_t* Bt, int N, int K, const Epi& E) {
    pg8::Gemm g{A, Bt, T, N, K}; pg8::StaticOrder S; S.init(T, N, (int)gridDim.x, (int)blockIdx.x);
    pg8::gemm_phase<Epi, pg8::StaticOrder, true, true>(lds, g, S, E);
}
template <class Epi> __device__ __forceinline__ void run_gemm_rstd(LAS unsigned char* lds, const bf16_t* A, const bf16_t* Bt, int N, int K, const Epi& E, const float* RSS, LAS float* ldsr) {
    pg8::Gemm g{A, Bt, T, N, K}; pg8::RstdOrder S; S.init(T, N, (int)gridDim.x, (int)blockIdx.x); S.RSS = RSS; S.ldsr = ldsr; S.na = 0;
    pg8::gemm_phase<Epi, pg8::RstdOrder, true, true>(lds, g, S, E);
}
#define GRID_SYNC_CG() do { asm volatile("s_waitcnt vmcnt(0) lgkmcnt(0)" ::: "memory"); grid.sync(); \
    if (wave == 0) { __builtin_amdgcn_fence(__ATOMIC_ACQUIRE, "agent"); asm volatile("s_waitcnt vmcnt(0)" ::: "memory"); } \
    asm volatile("" ::: "memory"); __builtin_amdgcn_s_barrier(); asm volatile("" ::: "memory"); } while (0)
#define GRID_SYNC() xcd_barrier(xbar)
__global__ void __launch_bounds__(NTHR, 2) fwd_kernel(Params p) {
    extern __shared__ __attribute__((aligned(16))) unsigned char lds_raw[];
    LAS unsigned char* lds = (LAS unsigned char*)lds_raw;
    cg::grid_group grid = cg::this_grid();
    const int tid = threadIdx.x, lane = tid & 63, wave = __builtin_amdgcn_readfirstlane(tid >> 6);
    const int G = gridDim.x, bx = blockIdx.x, vcu = (G % 8 == 0) ? (bx % 8) * (G / 8) + bx / 8 : bx;
    const int gw = vcu * 8 + wave, NGW = G * 8;
    unsigned char* ws = p.ws;
    float* X = p.out;
    bf16_t* XN = (bf16_t*)(ws + OFF_XN); bf16_t* PROJ = (bf16_t*)(ws + OFF_PROJ); float* SM = (float*)(ws + OFF_SM);
    bf16_t* O = (bf16_t*)(ws + OFF_O); bf16_t* ON = (bf16_t*)(ws + OFF_ON);
    volatile LAS unsigned* xst = (volatile LAS unsigned*)(lds + LDS_BYTES - 64);
    if (tid == 0) { xst[0] = 0u; xst[1] = 0u; }
    __syncthreads();
    const XcdBarrier xbar = xcd_barrier_post((unsigned*)(ws + OFF_BAR), xst);

#define STAMP(id) do { } while (0)
    p0_phase(p, lds, gw, NGW, wave, lane);
    rmsnorm_phase(inptr<0>(), inptr<1>(), XN, X, nullptr, gw, NGW, lane);
    GRID_SYNC_CG(); STAMP(0);
    for (int hb = 0; hb < HBMAX; ++hb) {
        const int L = hb >> 1, half = hb & 1;
        int tq = tid; asm volatile("" : "+v"(tq)); const int lane = tq & 63;
        {
            const bf16_t* Bt; int N; pg8::EpiBf E; E.O = PROJ; E.SM = SM; E.slo = 0; E.shi = 0; E.relu2 = half;
            if (half) { Bt = (const bf16_t*)(ws + OFF_WT_UP + L * SZ_L); N = FF; }
            else if (L == 0) { Bt = (const bf16_t*)(ws + OFF_WT_RET_IN); N = NP_RET; }
            else if (L == 1) { Bt = (const bf16_t*)(ws + OFF_WT_GDN_IN); N = NP_GDN; E.slo = 8192; E.shi = 8224; }
            else if (L == 2) { Bt = (const bf16_t*)(ws + OFF_WT_GLA_IN); N = NP_GLA; E.slo = 6144; E.shi = 6160; }
            else { Bt = (const bf16_t*)(ws + OFF_WT_LRU_IN); N = NP_LRU; }
            E.ldo = N; E.ldsr = (const LAS float*)(lds + 131072); E.ne = 0;
#if PH_GEMM
            run_gemm_rstd(lds, XN, Bt, N, D, E, (const float*)(ws + OFF_RSS), (LAS float*)(lds + 131072));
#endif
        }
        GRID_SYNC(); STAMP(1);
        int K2 = FF;
        if (!half) {
            K2 = D;
            if (L == 0) {
#if PH_RET
                ret_pre_phase(lds, PROJ, (const float*)(ws + OFF_ROPE), (const float*)(ws + OFF_ROPE) + 2048 * 128, (bf16_t*)(ws + OFF_GQ), (bf16_t*)(ws + OFF_GKE), (bf16_t*)(ws + OFF_GU), vcu, G, tid);
                GRID_SYNC(); STAMP(13);
                ret_scan_phase(lds, PROJ, (const bf16_t*)(ws + OFF_GQ), (const bf16_t*)(ws + OFF_GKE), (const bf16_t*)(ws + OFF_GU), O, ws, vcu, G, tid);
#endif
                GRID_SYNC(); STAMP(2);
                hn512_phase<true>(O, 4096, 8, inptr<5>(), PROJ, NP_RET, 8192, ON, gw, NGW, lane);
                K2 = 4096;
            } else if (L == 1) {
#if PH_GDN
                gdn_prep_phase(lds, PROJ, SM, inptr<8>(), inptr<9>(), inptr<10>(), (bf16_t*)(ws + OFF_GQ), (bf16_t*)(ws + OFF_GKE), (bf16_t*)(ws + OFF_GU), (bf16_t*)(ws + OFF_GW), (float*)(ws + OFF_GG), vcu, G, tid);
#endif
                GRID_SYNC(); STAMP(4);
#if PH_GDN2
                gdn_scan_phase(lds, (const bf16_t*)(ws + OFF_GQ), (const bf16_t*)(ws + OFF_GKE), (const bf16_t*)(ws + OFF_GU), (const bf16_t*)(ws + OFF_GW), (const float*)(ws + OFF_GG), O, ws, vcu, G, tid);
#endif
                GRID_SYNC(); STAMP(5);
                gdn_hn_phase(O, inptr<11>(), PROJ, ON, gw, NGW, lane);
            } else if (L == 2) {
#if PH_GLA
                gla_pre_phase(lds, PROJ, SM, inptr<14>(), inptr<15>(), (bf16_t*)(ws + OFF_GQ), (bf16_t*)(ws + OFF_GKE), (bf16_t*)(ws + OFF_GU), (float*)(ws + OFF_GW), vcu, G, tid);
                GRID_SYNC(); STAMP(12);
                gla_scan_phase(lds, PROJ, (const bf16_t*)(ws + OFF_GQ), (const bf16_t*)(ws + OFF_GKE), (const bf16_t*)(ws + OFF_GU), (const float*)(ws + OFF_GW), O, vcu, G, tid);
#endif
                GRID_SYNC(); STAMP(7);
                hn512_phase<false>(O, 2048, 4, inptr<16>(), PROJ, NP_GLA, 4096, ON, gw, NGW, lane);
            } else {
#if PH_LRU
                lru_phase(lds, PROJ, inptr<19>(), inptr<20>(), (const bf16_t*)(ws + OFF_WT_LRU_GR), (const bf16_t*)(ws + OFF_WT_LRU_GI), inptr<22>(), inptr<24>(), inptr<25>(), ON, vcu, G, tid);
#endif
            }
            GRID_SYNC(); STAMP((L == 0 ? 3 : L == 1 ? 6 : L == 2 ? 8 : 9));
        }
        {
            const bf16_t* A2 = half ? PROJ : ON; const bf16_t* Bt;
            if (half) Bt = (const bf16_t*)(ws + OFF_WT_DOWN + L * SZ_L);
            else Bt = (const bf16_t*)(ws + (L == 0 ? OFF_WT_RET_OUT : L == 1 ? OFF_WT_GDN_OUT : L == 2 ? OFF_WT_GLA_OUT : OFF_WT_LRU_OUT));
            pg8::EpiRes E; E.X = X; E.ldx = D; E.XG = XN; E.RSS = (float*)(ws + OFF_RSS);
            E.g = (hb == HBMAX - 1) ? inptr<3>() : (half ? inptr<1>() + (L + 1) * D : inptr<2>() + L * D);
#if PH_GEMM
            run_gemm(lds, A2, Bt, D, K2, E);
#endif
        }
        GRID_SYNC(); STAMP(10);
        if (hb == HBMAX - 1) { rmsnorm_phase(X, inptr<3>(), nullptr, nullptr, X, gw, NGW, lane); GRID_SYNC(); STAMP(11); }
    }

}

extern "C" void kernel_launch(void* const* d_in, const int* in_sizes, int n_in, void* d_out, int out_size, void* d_ws, size_t ws_size, hipStream_t stream) {
    static int grid_blocks = 0;
    if (!grid_blocks) {
        int dev = 0, cus = 0, per_cu = 0;
        hipGetDevice(&dev);
        hipDeviceGetAttribute(&cus, hipDeviceAttributeMultiprocessorCount, dev);
        hipFuncSetAttribute((const void*)fwd_kernel, hipFuncAttributeMaxDynamicSharedMemorySize, LDS_BYTES);
        hipOccupancyMaxActiveBlocksPerMultiprocessor(&per_cu, (const void*)fwd_kernel, NTHR, LDS_BYTES);
        if (per_cu < 1) { fprintf(stderr, "kernel_launch: occupancy query says %d blocks/CU\n", per_cu); per_cu = 1; }
        grid_blocks = cus * 1;
        if (ws_size < WS_END) fprintf(stderr, "kernel_launch: workspace too small: %zu < %zu\n", ws_size, (size_t)WS_END);
        if (n_in != 29) fprintf(stderr, "kernel_launch: expected 29 inputs, got %d\n", n_in);
    }
    Params p{};
    for (int i = 0; i < 29; ++i) p.in[i] = (const float*)d_in[i];
    p.out = (float*)d_out; p.ws = (unsigned char*)d_ws;
    (void)hipMemsetAsync((unsigned char*)d_ws + OFF_BAR, 0, XCD_BAR_WORDS * 4, stream);
    void* args[] = {&p};
    hipError_t e = hipLaunchCooperativeKernel((const void*)fwd_kernel, dim3(grid_blocks), dim3(NTHR), args, LDS_BYTES, stream);
    if (e != hipSuccess) fprintf(stderr, "cooperative launch failed: %s (grid %d)\n", hipGetErrorString(e), grid_blocks);
}
```

```cpp
#include <hip/hip_runtime.h>
#include <hip/hip_cooperative_groups.h>
#include <cstdio>
#include <cstdint>
namespace cg = cooperative_groups;
#ifndef PH_RET
#define PH_RET 1
#endif
#ifndef PH_GDN
#define PH_GDN 1
#endif
#ifndef PH_GDN2
#define PH_GDN2 1
#endif
#ifndef PH_GLA
#define PH_GLA 1
#endif
#ifndef PH_LRU
#define PH_LRU 1
#endif
#ifndef PH_GEMM
#define PH_GEMM 1
#endif
#ifndef HBMAX
#define HBMAX 8
#endif
namespace pg8 {
#define PG8_LAS __attribute__((address_space(3)))
typedef unsigned short bf16_t;
typedef short bf16x8 __attribute__((ext_vector_type(8)));
typedef float f32x4 __attribute__((ext_vector_type(4)));
typedef unsigned u32x4 __attribute__((ext_vector_type(4)));
constexpr int BM = 256, BK = 64, HALF = 128, HTB = HALF * BK * 2  , STAGE_BYTES = 8 * HTB, NXCD = 8, WGM = 4;

__host__ __device__ __forceinline__ int lds_byte(int r, int c) { const int st = (r >> 4) * 2 + (c >> 5), rr = r & 15, cc = c & 31, ob = rr * 64 + cc * 2; return st * 1024 + (ob ^ (((ob >> 9) & 1) << 5)); }
__host__ __device__ __forceinline__ void stage_rc(int b, int& R, int& C) { const int st = b / 1024, sb = b % 1024, swz = sb ^ (((sb >> 9) & 1) << 5); R = (st >> 1) * 16 + swz / 64; C = (st & 1) * 32 + (swz % 64) / 2; }
__host__ __device__ __forceinline__ int perm32(int rho) { const int n = rho >> 4, i = rho & 15; return 8 * (i >> 2) + 4 * n + (i & 3); }

struct Unit { int pm, pn; };
struct Gemm { const bf16_t* A; const bf16_t* Bt; int M, N, K; };

struct StaticOrder {
    int nM, nN, nwg, G, c;
    __host__ __device__ void init(int M, int N, int G_, int c_) { nM = M / BM; nN = N / BM; nwg = nM * nN; G = G_; c = c_; }
    __host__ __device__ bool next(int i, Unit& u) const {
        const long L = (long)i * G + c; if (L >= nwg) return false;
        int wgid = (int)L; { const int q = nwg / NXCD, r = nwg % NXCD, xcd = wgid % NXCD, off = wgid / NXCD; wgid = (xcd < r ? xcd * (q + 1) : r * (q + 1) + (xcd - r) * q) + off; }
        const int nig = WGM * nN, gid = wgid / nig, fm = gid * WGM, gsz = (nM - fm) < WGM ? (nM - fm) : WGM;
        u.pm = fm + ((wgid % nig) % gsz); u.pn = (wgid % nig) / gsz; return true;
    }
    __device__ __forceinline__ void a_ready(const Unit&) const {}
    __device__ __forceinline__ void done(const Unit&) const {}
    __device__ __forceinline__ void a_finish() const {}
};
typedef __bf16 hwbf16x2 __attribute__((ext_vector_type(2)));
typedef float cvtf32x2 __attribute__((ext_vector_type(2)));
__device__ __forceinline__ unsigned cvt_pk_bf16(float lo, float hi) { cvtf32x2 v; v.x = lo; v.y = hi; hwbf16x2 b = __builtin_convertvector(v, hwbf16x2); return __builtin_bit_cast(unsigned, b); }
template <class Epi, class Sched, bool ALIGN_EPI = false, bool SP2 = false>
__device__ __forceinline__ void gemm_phase(PG8_LAS unsigned char* lds, const Gemm g, const Sched& S, const Epi& E) {
    int tid = threadIdx.x; asm volatile("" : "+v"(tid)); const int wid = __builtin_amdgcn_readfirstlane(tid >> 6), lane = tid & 63, wr = wid >> 2, wc = wid & 3, fr = lane & 15, fq = lane >> 4;
    const int K = g.K, nt = K / BK;
    unsigned voffA[2], voffB[2];
#pragma unroll
    for (int i = 0; i < 2; ++i) { int R, C; stage_rc(tid * 16 + i * 8192, R, C); const int Rb = Epi::PERM ? ((R & ~31) + perm32(R & 31)) : R;
        voffA[i] = (unsigned)(R * K + C) * 2u; voffB[i] = (unsigned)(Rb * K + C) * 2u; }
    const size_t kstep = (size_t)(BK * 2);
    const size_t hstep = (size_t)HALF * K * 2;
    const size_t tstep = 2 * hstep;
    const unsigned ldsw = (unsigned)wid * 1024u;
    const int aoff = lds_byte(wr * 64 + fr, fq * 8), boff = lds_byte(wc * 32 + fr, fq * 8);
#define PG8_SA(b, h) (((b) * 2 + (h)) * HTB)
#define PG8_SB(b, h) ((4 + (b) * 2 + (h)) * HTB)
#define PG8_STAGE(bufoff, gbase, voff) do { _Pragma("unroll") for (int _i = 0; _i < 2; ++_i) \
        __builtin_amdgcn_global_load_lds((const unsigned*)((const char*)(gbase) + (voff)[_i]), (PG8_LAS unsigned*)(lds + (bufoff) + ldsw + _i * 8192), 16, 0, 0); } while (0)
#define PG8_LDA(dst, b, h) do { _Pragma("unroll") for (int m = 0; m < 4; ++m) _Pragma("unroll") for (int k = 0; k < 2; ++k) dst[m][k] = *(const PG8_LAS bf16x8*)(lds + PG8_SA(b, h) + aoff + m * 2048 + k * 1024); } while (0)
#define PG8_LDB(dst, b, h) do { _Pragma("unroll") for (int n = 0; n < 2; ++n) _Pragma("unroll") for (int k = 0; k < 2; ++k) dst[n][k] = *(const PG8_LAS bf16x8*)(lds + PG8_SB(b, h) + boff + n * 2048 + k * 1024); } while (0)
#define PG8_MMA(ai, bj, At, Bt) do { __builtin_amdgcn_s_setprio(1); _Pragma("unroll") for (int m = 0; m < 4; ++m) _Pragma("unroll") for (int n = 0; n < 2; ++n) _Pragma("unroll") for (int k = 0; k < 2; ++k) \
        acc[ai][bj][m][n] = __builtin_amdgcn_mfma_f32_16x16x32_bf16(Bt[n][k], At[m][k], acc[ai][bj][m][n], 0, 0, 0); __builtin_amdgcn_s_setprio(0); } while (0)
#define PG8_WAIT_V(n) asm volatile("s_waitcnt vmcnt(" #n ")" ::: "memory")
#define PG8_WAIT_L(n) asm volatile("s_waitcnt lgkmcnt(" #n ")" ::: "memory")
#define PG8_BAR __builtin_amdgcn_s_barrier()
#define PG8_SCHED __builtin_amdgcn_sched_barrier(0)
    Unit cur, nxt; int ui = 0;
    if (!S.next(0, cur)) return;
    f32x4 acc[2][2][4][2];
#pragma unroll
    for (int a = 0; a < 2; ++a)
#pragma unroll
        for (int b = 0; b < 2; ++b)
#pragma unroll
            for (int m = 0; m < 4; ++m)
#pragma unroll
                for (int n = 0; n < 2; ++n) acc[a][b][m][n] = (f32x4){0.f, 0.f, 0.f, 0.f};
    bf16x8 At[4][2], B0[2][2], B1[2][2];
    const char* cA = (const char*)g.A + (size_t)cur.pm * tstep; const char* cB = (const char*)g.Bt + (size_t)cur.pn * tstep;
    S.a_ready(cur); S.a_finish();
    if constexpr (SP2) {
        PG8_STAGE(PG8_SB(0, 0), cB, voffB); PG8_STAGE(PG8_SB(0, 1), cB + hstep, voffB); PG8_STAGE(PG8_SA(0, 0), cA, voffA); PG8_STAGE(PG8_SA(0, 1), cA + hstep, voffA);
        if (wr == 1) PG8_BAR;
        PG8_WAIT_V(2); PG8_BAR;
        PG8_STAGE(PG8_SB(1, 0), cB + kstep, voffB); PG8_STAGE(PG8_SA(1, 0), cA + kstep, voffA); PG8_STAGE(PG8_SB(1, 1), cB + hstep + kstep, voffB);
        PG8_WAIT_V(6); PG8_BAR;
    } else {
        PG8_STAGE(PG8_SB(0, 0), cB, voffB); PG8_STAGE(PG8_SA(0, 0), cA, voffA); PG8_STAGE(PG8_SB(0, 1), cB + hstep, voffB); PG8_STAGE(PG8_SA(0, 1), cA + hstep, voffA);
        if (wr == 1) PG8_BAR;
        PG8_WAIT_V(4); PG8_BAR;
        PG8_STAGE(PG8_SB(1, 0), cB + kstep, voffB); PG8_STAGE(PG8_SA(1, 0), cA + kstep, voffA); PG8_STAGE(PG8_SB(1, 1), cB + hstep + kstep, voffB);
        PG8_WAIT_V(6); PG8_BAR;
    }
    for (;;) {
        const bool has_next = S.next(ui + 1, nxt);
        const char* nA = has_next ? (const char*)g.A + (size_t)nxt.pm * tstep : cA; const char* nB = has_next ? (const char*)g.Bt + (size_t)nxt.pn * tstep : cB;
        for (int t = 0; t < nt; t += 2) {
            const bool last = (t == nt - 2);
            const char* a1 = cA + (size_t)(t + 1) * kstep;
            const char* a2 = last ? nA : cA + (size_t)(t + 2) * kstep; const char* b2 = last ? nB : cB + (size_t)(t + 2) * kstep;
            const char* a3 = a2 + kstep; const char* b3 = b2 + kstep;
            if (last && has_next) S.a_ready(nxt);
            if constexpr (SP2) {
            PG8_LDB(B0, 0, 0); PG8_LDB(B1, 0, 1); PG8_SCHED; PG8_LDA(At, 0, 0); PG8_STAGE(PG8_SA(1, 1), a1 + hstep, voffA);
            PG8_WAIT_V(8); PG8_WAIT_L(0); PG8_BAR; PG8_MMA(0, 0, At, B0); PG8_MMA(0, 1, At, B1); PG8_BAR; PG8_SCHED;
            PG8_LDA(At, 0, 1); PG8_STAGE(PG8_SB(0, 0), b2, voffB); PG8_STAGE(PG8_SB(0, 1), b2 + hstep, voffB); PG8_STAGE(PG8_SA(0, 0), a2, voffA);
            PG8_WAIT_V(8); PG8_WAIT_L(0); PG8_BAR; PG8_MMA(1, 0, At, B0); PG8_MMA(1, 1, At, B1); PG8_BAR; PG8_SCHED;
            PG8_LDB(B0, 1, 0); PG8_LDB(B1, 1, 1); PG8_SCHED; PG8_LDA(At, 1, 0); PG8_STAGE(PG8_SA(0, 1), a2 + hstep, voffA);
            PG8_WAIT_V(8); PG8_WAIT_L(0); PG8_BAR; PG8_MMA(0, 0, At, B0); PG8_MMA(0, 1, At, B1); PG8_BAR; PG8_SCHED;
            PG8_LDA(At, 1, 1); PG8_STAGE(PG8_SB(1, 0), b3, voffB); PG8_STAGE(PG8_SB(1, 1), b3 + hstep, voffB); PG8_STAGE(PG8_SA(1, 0), a3, voffA);
            PG8_WAIT_V(8); PG8_WAIT_L(0); PG8_BAR; PG8_MMA(1, 0, At, B0); PG8_MMA(1, 1, At, B1); PG8_BAR; PG8_SCHED;
            if (last && has_next) S.a_finish();
            } else {
            PG8_LDB(B0, 0, 0); PG8_SCHED; PG8_LDA(At, 0, 0); PG8_STAGE(PG8_SA(1, 1), a1 + hstep, voffA);
            PG8_WAIT_L(8); PG8_BAR; PG8_WAIT_L(0); PG8_MMA(0, 0, At, B0); PG8_BAR; PG8_SCHED;
            PG8_LDB(B1, 0, 1); PG8_STAGE(PG8_SB(0, 0), b2, voffB);
            PG8_BAR; PG8_WAIT_L(0); PG8_MMA(0, 1, At, B1); PG8_BAR;
            PG8_LDA(At, 0, 1); PG8_STAGE(PG8_SA(0, 0), a2, voffA);
            PG8_BAR; PG8_WAIT_L(0); PG8_MMA(1, 0, At, B0); PG8_BAR; PG8_SCHED;
            PG8_STAGE(PG8_SB(0, 1), b2 + hstep, voffB);
            PG8_WAIT_V(6); PG8_BAR; PG8_MMA(1, 1, At, B1); PG8_BAR;
            PG8_LDB(B0, 1, 0); PG8_SCHED; PG8_LDA(At, 1, 0); PG8_STAGE(PG8_SA(0, 1), a2 + hstep, voffA);
            PG8_WAIT_L(8); PG8_BAR; PG8_WAIT_L(0); PG8_MMA(0, 0, At, B0); PG8_BAR; PG8_SCHED;
            PG8_LDB(B1, 1, 1); PG8_STAGE(PG8_SB(1, 0), b3, voffB);
            PG8_BAR; PG8_WAIT_L(0); PG8_MMA(0, 1, At, B1); PG8_BAR;
            PG8_LDA(At, 1, 1); PG8_STAGE(PG8_SA(1, 0), a3, voffA);
            PG8_BAR; PG8_WAIT_L(0); PG8_MMA(1, 0, At, B0); PG8_BAR; PG8_SCHED;
            PG8_STAGE(PG8_SB(1, 1), b3 + hstep, voffB);
            PG8_WAIT_V(6); PG8_BAR; PG8_MMA(1, 1, At, B1); PG8_BAR;
            }
        }
        if constexpr (ALIGN_EPI) { if (wr == 0) PG8_BAR; }
        if constexpr (!Epi::AFTER_DRAIN) { E(acc, cur, wr, wc, fr, fq); S.done(cur); }
        if (!has_next) break;
#pragma unroll
        for (int a = 0; a < 2; ++a)
#pragma unroll
            for (int b = 0; b < 2; ++b)
#pragma unroll
                for (int m = 0; m < 4; ++m)
#pragma unroll
                    for (int n = 0; n < 2; ++n) acc[a][b][m][n] = (f32x4){0.f, 0.f, 0.f, 0.f};
        cur = nxt; cA = nA; cB = nB; ++ui;
        if constexpr (ALIGN_EPI) { if (wr == 1) PG8_BAR; }
    }
    PG8_WAIT_V(0);
    if constexpr (!ALIGN_EPI) { if (wr == 0) PG8_BAR; }
    PG8_BAR;
    if constexpr (Epi::AFTER_DRAIN) { E.fused(acc, cur, wr, wc, fr, fq, lds, wid, lane); S.done(cur); }
#undef PG8_SA
#undef PG8_SB
#undef PG8_STAGE
#undef PG8_LDA
#undef PG8_LDB
#undef PG8_MMA
#undef PG8_WAIT_V
#undef PG8_WAIT_L
#undef PG8_BAR
#undef PG8_SCHED
}

typedef unsigned u32x2 __attribute__((ext_vector_type(2)));
struct EpiBf {
    static constexpr bool PERM = true, AFTER_DRAIN = false;
    bf16_t* O; int ldo; float* SM; int slo, shi, relu2;
    const PG8_LAS float* ldsr; mutable int ne;
    __device__ __forceinline__ void operator()(const f32x4 (&acc)[2][2][4][2], const Unit& u, int wr, int wc, int fr, int fq) const {
        const int row0 = u.pm * BM + wr * 64 + fr, col0 = u.pn * BM + wc * 32 + 8 * fq;
        const PG8_LAS float* rsl = ldsr + (ne & 1) * 256 + wr * 64 + fr; ++ne;
#pragma unroll
        for (int ai = 0; ai < 2; ++ai)
#pragma unroll
            for (int m = 0; m < 4; ++m) { const size_t row = (size_t)(row0 + ai * HALF + m * 16); const float rs = rsl[ai * HALF + m * 16];
#pragma unroll
                for (int bj = 0; bj < 2; ++bj) { const int col = col0 + bj * HALF; f32x4 v0 = acc[ai][bj][m][0] * rs, v1 = acc[ai][bj][m][1] * rs;
                    if (relu2) { v0[0] = fmaxf(v0[0], 0.f); v0[1] = fmaxf(v0[1], 0.f); v0[2] = fmaxf(v0[2], 0.f); v0[3] = fmaxf(v0[3], 0.f); v0 = v0 * v0;
                                 v1[0] = fmaxf(v1[0], 0.f); v1[1] = fmaxf(v1[1], 0.f); v1[2] = fmaxf(v1[2], 0.f); v1[3] = fmaxf(v1[3], 0.f); v1 = v1 * v1; }
                    u32x4 o; o.x = cvt_pk_bf16(v0[0], v0[1]); o.y = cvt_pk_bf16(v0[2], v0[3]); o.z = cvt_pk_bf16(v1[0], v1[1]); o.w = cvt_pk_bf16(v1[2], v1[3]);
                    *(u32x4*)(O + row * ldo + col) = o;
                    if (col >= slo && col < shi) { *(f32x4*)(SM + row * 32 + (col - slo)) = v0; *(f32x4*)(SM + row * 32 + (col - slo) + 4) = v1; } } }
    }
};
struct EpiRes {
    static constexpr bool PERM = true, AFTER_DRAIN = false;
    float* X; const float* Xr; int ldx; bf16_t* XG; const float* g; float* RSS;
    __device__ __forceinline__ void operator()(const f32x4 (&acc)[2][2][4][2], const Unit& u, int wr, int wc, int fr, int fq) const {
        const int row0 = u.pm * BM + wr * 64 + fr, col0 = u.pn * BM + wc * 32 + 8 * fq;
        f32x4 gv[2][2];
#pragma unroll
        for (int bj = 0; bj < 2; ++bj)
#pragma unroll
            for (int n = 0; n < 2; ++n) gv[bj][n] = *(const f32x4*)(g + col0 + bj * HALF + 4 * n);
#pragma unroll
        for (int ai = 0; ai < 2; ++ai)
#pragma unroll
            for (int m = 0; m < 4; ++m) { const size_t row = (size_t)(row0 + ai * HALF + m * 16); float* rowp = X + row * ldx + col0; const float* rowr = Xr + row * ldx + col0; bf16_t* gp = XG + row * ldx + col0; float ss = 0.f;
#pragma unroll
                for (int bj = 0; bj < 2; ++bj) { f32x4* p = (f32x4*)(rowp + bj * HALF); const f32x4* pr = (const f32x4*)(rowr + bj * HALF);
                    const f32x4 x0 = pr[0] + acc[ai][bj][m][0], x1 = pr[1] + acc[ai][bj][m][1]; p[0] = x0; p[1] = x1;
                    ss += ((x0[0] * x0[0] + x0[1] * x0[1]) + (x0[2] * x0[2] + x0[3] * x0[3])) + ((x1[0] * x1[0] + x1[1] * x1[1]) + (x1[2] * x1[2] + x1[3] * x1[3]));
                    const f32x4 y0 = x0 * gv[bj][0], y1 = x1 * gv[bj][1];
                    u32x4 o; o.x = cvt_pk_bf16(y0[0], y0[1]); o.y = cvt_pk_bf16(y0[2], y0[3]); o.z = cvt_pk_bf16(y1[0], y1[1]); o.w = cvt_pk_bf16(y1[2], y1[3]); *(u32x4*)(gp + bj * HALF) = o; }
                ss += __shfl_xor(ss, 16); ss += __shfl_xor(ss, 32);
                if (fq == 0) RSS[row * 32 + u.pn * 4 + wc] = ss; }
    }
};
struct RstdOrder : StaticOrder {
    const float* RSS; PG8_LAS float* ldsr; mutable int na; mutable f32x4 ra, rb, rc, rd;
    __device__ __forceinline__ void a_ready(const Unit& u) const {
        int tid = threadIdx.x; asm volatile("" : "+v"(tid));
        const int rowl = (tid >> 6) * 32 + ((tid & 63) >> 1), half = tid & 1;
        const f32x4* p = (const f32x4*)(RSS + (size_t)(u.pm * BM + rowl) * 32 + 16 * half);
        ra = p[0]; rb = p[1]; rc = p[2]; rd = p[3];
    }
    __device__ __forceinline__ void a_finish() const {
        int tid = threadIdx.x; asm volatile("" : "+v"(tid));
        const int rowl = (tid >> 6) * 32 + ((tid & 63) >> 1), half = tid & 1;
        const f32x4 a = ra, b = rb, c = rc, d = rd;
        float s = (((a[0] + a[1]) + (a[2] + a[3])) + ((b[0] + b[1]) + (b[2] + b[3]))) + (((c[0] + c[1]) + (c[2] + c[3])) + ((d[0] + d[1]) + (d[2] + d[3])));
        s += __shfl_xor(s, 1);
        if (half == 0) ldsr[(na & 1) * 256 + rowl] = rsqrtf(s * (1.f / 2048.f) + 1e-6f);
        ++na;
    }
};
}

#define LAS __attribute__((address_space(3)))
typedef unsigned short bf16_t;
typedef short bf16x8 __attribute__((ext_vector_type(8)));
typedef float f32x4 __attribute__((ext_vector_type(4)));
typedef float f32x16 __attribute__((ext_vector_type(16)));
typedef unsigned u32x4 __attribute__((ext_vector_type(4)));
typedef unsigned u32x2 __attribute__((ext_vector_type(2)));

constexpr int T = 8192, D = 2048, FF = 8192, NTHR = 512;
constexpr int LDS_BYTES = 163840;
constexpr int NP_RET = 12288, NP_GDN = 8448, NP_GLA = 6400, NP_LRU = 4096;
constexpr size_t SZ_L = 33554432ull;
constexpr size_t OFF_WT_RET_IN = 0;
constexpr size_t OFF_WT_RET_OUT = OFF_WT_RET_IN + (size_t)NP_RET * D * 2;
constexpr size_t OFF_WT_GDN_IN = OFF_WT_RET_OUT + (size_t)D * 4096 * 2;
constexpr size_t OFF_WT_GDN_OUT = OFF_WT_GDN_IN + (size_t)NP_GDN * D * 2;
constexpr size_t OFF_WT_GLA_IN = OFF_WT_GDN_OUT + (size_t)D * D * 2;
constexpr size_t OFF_WT_GLA_OUT = OFF_WT_GLA_IN + (size_t)NP_GLA * D * 2;
constexpr size_t OFF_WT_LRU_IN = OFF_WT_GLA_OUT + (size_t)D * D * 2;
constexpr size_t OFF_WT_LRU_OUT = OFF_WT_LRU_IN + (size_t)NP_LRU * D * 2;
constexpr size_t OFF_WT_LRU_GR = OFF_WT_LRU_OUT + (size_t)D * D * 2;
constexpr size_t OFF_WT_LRU_GI = OFF_WT_LRU_GR + 16ull * 128 * 128 * 2;
constexpr size_t OFF_WT_UP = OFF_WT_LRU_GI + 16ull * 128 * 128 * 2;
constexpr size_t OFF_WT_DOWN = OFF_WT_UP + 4 * SZ_L;
constexpr size_t OFF_ROPE = OFF_WT_DOWN + 4 * SZ_L;
constexpr size_t OFF_XN = OFF_ROPE + 2ull * 2048 * 128 * 4;
constexpr size_t OFF_PROJ = OFF_XN + SZ_L;
constexpr size_t OFF_SM = OFF_PROJ + (size_t)T * NP_RET * 2;
constexpr size_t OFF_O = OFF_SM + (size_t)T * 32 * 4;
constexpr size_t OFF_ON = OFF_O + (size_t)T * 4096 * 4;
constexpr size_t OFF_GQ = OFF_ON + (size_t)T * 4096 * 2;
constexpr size_t OFF_GKE = OFF_GQ + SZ_L;
constexpr size_t OFF_GU = OFF_GKE + SZ_L;
constexpr size_t OFF_GW = OFF_GU + SZ_L;
constexpr size_t OFF_GG = OFF_GW + SZ_L;
constexpr size_t OFF_BAR = OFF_GG + 2048 * 4;
constexpr size_t OFF_RSS = OFF_BAR + 16384;
constexpr size_t WS_END = OFF_RSS + (size_t)T * 32 * 4;

__constant__ float LOGG[8] = {-0.0317486983145803f, -0.015748356968139168f, -0.007843177461025893f, -0.003913899321136329f,
                              -0.0019550348358033506f, -0.0009770396478266127f, -0.0004884004981088745f, -0.0002441704321739145f};

#define LDS_WAIT() asm volatile("s_waitcnt lgkmcnt(0)" ::: "memory")
__device__ __forceinline__ unsigned pk(float lo, float hi) { return pg8::cvt_pk_bf16(lo, hi); }
__device__ __forceinline__ bf16_t bf1(float v) { return (bf16_t)(pg8::cvt_pk_bf16(v, 0.f) & 0xffffu); }
__device__ __forceinline__ float bflo(unsigned v) { return __uint_as_float(v << 16); }
__device__ __forceinline__ float bfhi(unsigned v) { return __uint_as_float(v & 0xffff0000u); }
__device__ __forceinline__ float bf2f(bf16_t b) { return __uint_as_float(((unsigned)b) << 16); }
__device__ __forceinline__ float wave_sum(float v) {
#pragma unroll
    for (int o = 1; o < 64; o <<= 1) v += __shfl_xor(v, o);
    return v;
}
__device__ __forceinline__ float sigmoidf_(float x) { return __builtin_amdgcn_rcpf(1.f + __expf(-x)); }
__device__ __forceinline__ float siluf_(float x) { return x * __builtin_amdgcn_rcpf(1.f + __expf(-x)); }
#define ROWMAP(reg, hh) (((reg) & 3) + 8 * ((reg) >> 2) + 4 * (hh))

__device__ __forceinline__ void mma32(f32x16& acc, const LAS bf16_t* A, int lda, const LAS bf16_t* B, int ldb, int K, int lane) {
    const int r = lane & 31, h = lane >> 5;
    const LAS bf16_t* pa = A + r * lda + 8 * h; const LAS bf16_t* pb = B + r * ldb + 8 * h;
#pragma unroll 4
    for (int k = 0; k < K; k += 16) {
        const bf16x8 a = *(const LAS bf16x8*)(pa + k), b = *(const LAS bf16x8*)(pb + k);
        acc = __builtin_amdgcn_mfma_f32_32x32x16_bf16(a, b, acc, 0, 0, 0);
    }
}
__device__ __forceinline__ void mma32d(f32x16& acc, const LAS bf16_t* A, int lda, const LAS bf16_t* B, int ldb, int K, int lane) {
    const int r = lane & 31, h = lane >> 5;
    const LAS bf16_t* pa = A + r * lda + 8 * h; const LAS bf16_t* pb = B + r * ldb + 8 * h;
    f32x16 acc1;
#pragma unroll
    for (int i = 0; i < 16; ++i) acc1[i] = 0.f;
#pragma unroll 2
    for (int k = 0; k < K; k += 32) {
        const bf16x8 a0 = *(const LAS bf16x8*)(pa + k), b0 = *(const LAS bf16x8*)(pb + k), a1 = *(const LAS bf16x8*)(pa + k + 16), b1 = *(const LAS bf16x8*)(pb + k + 16);
        acc = __builtin_amdgcn_mfma_f32_32x32x16_bf16(a0, b0, acc, 0, 0, 0);
        acc1 = __builtin_amdgcn_mfma_f32_32x32x16_bf16(a1, b1, acc1, 0, 0, 0);
    }
    acc = acc + acc1;
}
__device__ __forceinline__ f32x16 zero16() { f32x16 z;
#pragma unroll
    for (int i = 0; i < 16; ++i) z[i] = 0.f; return z; }

struct Params { const float* in[29]; float* out; unsigned char* ws; };
template <int I> __device__ __forceinline__ const float* inptr() {
    const unsigned long long ka = (unsigned long long)__builtin_amdgcn_kernarg_segment_ptr();
    unsigned long long v;
    asm volatile("s_load_dwordx2 %0, %1, %2\n\ts_waitcnt lgkmcnt(0)" : "=&s"(v) : "s"(ka), "n"(I * 8) : "memory");
    return (const float*)(const __attribute__((address_space(1))) float*)v;
}

struct TDesc { const float* W; bf16_t* WT; int K, N, nblk, item; };
__device__ __forceinline__ void t_load(const TDesc& d, int lane, f32x4 (&v)[8]) {
    const int kb = d.item / d.nblk, nb = d.item - kb * d.nblk, k0 = 64 * kb, n0 = 32 * nb;
    const int n = n0 + 4 * (lane & 7); const bool ok = n < d.N;
#pragma unroll
    for (int i = 0; i < 8; ++i) { const int kk = 8 * i + (lane >> 3); v[i] = ok ? *(const f32x4*)(d.W + (size_t)(k0 + kk) * d.N + n) : (f32x4){0.f, 0.f, 0.f, 0.f}; }
}
__device__ __forceinline__ void t_store(const TDesc& d, LAS float* scr, int lane, const f32x4 (&v)[8]) {
    const int kb = d.item / d.nblk, nb = d.item - kb * d.nblk, k0 = 64 * kb, n0 = 32 * nb;
#pragma unroll
    for (int i = 0; i < 8; ++i) { const int kk = 8 * i + (lane >> 3); LAS float* q = scr + kk * 33 + 4 * (lane & 7); q[0] = v[i][0]; q[1] = v[i][1]; q[2] = v[i][2]; q[3] = v[i][3]; }
    LDS_WAIT();
    const int c = lane & 7;
#pragma unroll
    for (int j = 0; j < 4; ++j) { const int nn = (lane >> 3) + 8 * j; const LAS float* s = scr + (8 * c) * 33 + nn;
        u32x4 o; o.x = pk(s[0 * 33], s[1 * 33]); o.y = pk(s[2 * 33], s[3 * 33]); o.z = pk(s[4 * 33], s[5 * 33]); o.w = pk(s[6 * 33], s[7 * 33]);
        *(u32x4*)(d.WT + (size_t)(n0 + nn) * d.K + k0 + 8 * c) = o; }
    LDS_WAIT();
}
constexpr int I_RET_IN = (D / 64) * (NP_RET / 32), I_RET_OUT = (4096 / 64) * (D / 32), I_GDN_IN = (D / 64) * (NP_GDN / 32), I_SQ = (D / 64) * (D / 32),
              I_GLA_IN = (D / 64) * (NP_GLA / 32), I_LRU_IN = (D / 64) * (NP_LRU / 32), I_G = 16 * 8, I_UP = (D / 64) * (FF / 32), I_DN = (FF / 64) * (D / 32);
constexpr int NITEMS_A = I_RET_IN;
constexpr int NITEMS_C = I_GDN_IN + I_SQ + 2 * I_UP + 2 * I_DN + I_RET_OUT;
constexpr int NITEMS_B = I_GLA_IN + I_SQ + I_LRU_IN + I_SQ + 2 * I_G + 2 * I_UP + 2 * I_DN;
__device__ __forceinline__ TDesc p0_desc_a(unsigned char* ws, int it) {
    return TDesc{inptr<4>(), (bf16_t*)(ws + OFF_WT_RET_IN), D, 12288, NP_RET / 32, it};
}
__device__ __forceinline__ TDesc p0_desc_c(unsigned char* ws, int it) {
    int r = it;
    if (r < I_RET_OUT) return TDesc{inptr<6>(), (bf16_t*)(ws + OFF_WT_RET_OUT), 4096, D, D / 32, r}; r -= I_RET_OUT;
    if (r < 2 * I_UP) { const int l = r / I_UP; return TDesc{inptr<27>() + (size_t)l * D * FF, (bf16_t*)(ws + OFF_WT_UP + l * SZ_L), D, FF, FF / 32, r - l * I_UP}; } r -= 2 * I_UP;
    if (r < 2 * I_DN) { const int l = r / I_DN; return TDesc{inptr<28>() + (size_t)l * D * FF, (bf16_t*)(ws + OFF_WT_DOWN + l * SZ_L), FF, D, D / 32, r - l * I_DN}; } r -= 2 * I_DN;
    if (r < I_GDN_IN) return TDesc{inptr<7>(), (bf16_t*)(ws + OFF_WT_GDN_IN), D, 8224, NP_GDN / 32, r}; r -= I_GDN_IN;
    return TDesc{inptr<12>(), (bf16_t*)(ws + OFF_WT_GDN_OUT), D, D, D / 32, r};
}
__device__ __forceinline__ TDesc p0_desc_b(unsigned char* ws, int it) {
    int r = it;
    if (r < I_GLA_IN) return TDesc{inptr<13>(), (bf16_t*)(ws + OFF_WT_GLA_IN), D, 6160, NP_GLA / 32, r}; r -= I_GLA_IN;
    if (r < I_SQ) return TDesc{inptr<17>(), (bf16_t*)(ws + OFF_WT_GLA_OUT), D, D, D / 32, r}; r -= I_SQ;
    if (r < I_LRU_IN) return TDesc{inptr<18>(), (bf16_t*)(ws + OFF_WT_LRU_IN), D, 4096, NP_LRU / 32, r}; r -= I_LRU_IN;
    if (r < I_SQ) return TDesc{inptr<26>(), (bf16_t*)(ws + OFF_WT_LRU_OUT), D, D, D / 32, r}; r -= I_SQ;
    if (r < I_G) { const int blk = r >> 3; return TDesc{inptr<21>() + blk * 16384, (bf16_t*)(ws + OFF_WT_LRU_GR) + blk * 16384, 128, 128, 4, r & 7}; } r -= I_G;
    if (r < I_G) { const int blk = r >> 3; return TDesc{inptr<23>() + blk * 16384, (bf16_t*)(ws + OFF_WT_LRU_GI) + blk * 16384, 128, 128, 4, r & 7}; } r -= I_G;
    if (r < 2 * I_UP) { const int l = 2 + r / I_UP; return TDesc{inptr<27>() + (size_t)l * D * FF, (bf16_t*)(ws + OFF_WT_UP + l * SZ_L), D, FF, FF / 32, r - (l - 2) * I_UP}; } r -= 2 * I_UP;
    { const int l = 2 + r / I_DN; return TDesc{inptr<28>() + (size_t)l * D * FF, (bf16_t*)(ws + OFF_WT_DOWN + l * SZ_L), FF, D, D / 32, r - (l - 2) * I_DN}; }
}
__device__ __forceinline__ void p0_phase(const Params& p, LAS unsigned char* lds, int gw, int NGW, int wave, int lane) {
    LAS float* scr = (LAS float*)(lds + wave * 16384);
    unsigned char* ws = p.ws;
    constexpr int NITEMS = NITEMS_A;
#define p0_desc p0_desc_a
    if (gw < NITEMS) { int it = gw; TDesc d = p0_desc(ws, it); f32x4 v[8]; t_load(d, lane, v);
        for (;;) { const int itn = it + NGW; const bool more = itn < NITEMS; TDesc dn = d; f32x4 vn[8];
            if (more) { dn = p0_desc(ws, itn); t_load(dn, lane, vn); }
            t_store(d, scr, lane, v);
            if (!more) break;
            d = dn; it = itn;
#pragma unroll
            for (int i = 0; i < 8; ++i) v[i] = vn[i]; } }
#undef p0_desc
    { float* rss = (float*)(ws + OFF_RSS); for (int i = gw * 64 + lane; i < T * 32; i += NGW * 64) rss[i] = ((i & 31) == 0) ? 2047.997952f : 0.f; }
    float* rc = (float*)(ws + OFF_ROPE); float* rs = rc + 2048 * 128;
    for (int idx = gw * 64 + lane; idx < 2048 * 128; idx += NGW * 64) {
        const int s = idx >> 7, i = idx & 127;
        double inv = 1.0, bs = 0.9305720409296989792906463164991; int e = i;
#pragma unroll
        for (int b = 0; b < 7; ++b) { if (e & 1) inv *= bs; bs *= bs; e >>= 1; }
        const float angf = (float)s * (float)inv;
        const double a = (double)angf; const double q = __builtin_rint(a * 0.63661977236758134308);
        const double x = (a - q * 1.5707963267948965580) - q * 6.123233995736766e-17;
        const double x2 = x * x;
        const double sn = x * (1.0 + x2 * (-1.0 / 6 + x2 * (1.0 / 120 + x2 * (-1.0 / 5040 + x2 * (1.0 / 362880 + x2 * (-1.0 / 39916800 + x2 * (1.0 / 6227020800.0)))))));
        const double cs = 1.0 + x2 * (-0.5 + x2 * (1.0 / 24 + x2 * (-1.0 / 720 + x2 * (1.0 / 40320 + x2 * (-1.0 / 3628800 + x2 * (1.0 / 479001600.0))))));
        const int qi = ((int)q) & 3;
        const double co = (qi == 0) ? cs : (qi == 1) ? -sn : (qi == 2) ? -cs : sn;
        const double si = (qi == 0) ? sn : (qi == 1) ? cs : (qi == 2) ? -sn : -cs;
        rc[idx] = (float)co; rs[idx] = (float)si;
    }
}
__device__ __forceinline__ void rmsnorm_phase(const float* X, const float* g, bf16_t* XN, float* Xcopy, float* OutF, int gw, int NGW, int lane) {
    f32x4 gg[8];
#pragma unroll
    for (int j = 0; j < 8; ++j) gg[j] = ((const f32x4*)g)[lane + 64 * j];
    for (int m = gw; m < T; m += 2 * NGW) {
        const int m1 = (m + NGW < T) ? m + NGW : m;
        const f32x4* xr0 = (const f32x4*)(X + (size_t)m * D) + lane; const f32x4* xr1 = (const f32x4*)(X + (size_t)m1 * D) + lane;
        f32x4 v0[8], v1[8]; float s0 = 0.f, s1 = 0.f;
#pragma unroll
        for (int j = 0; j < 8; ++j) { v0[j] = xr0[64 * j]; v1[j] = xr1[64 * j]; }
#pragma unroll
        for (int j = 0; j < 8; ++j) { s0 += (v0[j][0] * v0[j][0] + v0[j][1] * v0[j][1]) + (v0[j][2] * v0[j][2] + v0[j][3] * v0[j][3]);
                                      s1 += (v1[j][0] * v1[j][0] + v1[j][1] * v1[j][1]) + (v1[j][2] * v1[j][2] + v1[j][3] * v1[j][3]); }
#pragma unroll
        for (int o = 1; o < 64; o <<= 1) { s0 += __shfl_xor(s0, o); s1 += __shfl_xor(s1, o); }
        const float rs0 = rsqrtf(s0 * (1.f / D) + 1e-6f), rs1 = rsqrtf(s1 * (1.f / D) + 1e-6f);
#pragma unroll
        for (int j = 0; j < 8; ++j) { const f32x4 y0 = v0[j] * rs0 * gg[j], y1 = v1[j] * rs1 * gg[j];
            if (XN) { u32x2 o; o.x = pk(y0[0], y0[1]); o.y = pk(y0[2], y0[3]); *(u32x2*)(XN + (size_t)m * D + 4 * lane + 256 * j) = o;
                      o.x = pk(y1[0], y1[1]); o.y = pk(y1[2], y1[3]); *(u32x2*)(XN + (size_t)m1 * D + 4 * lane + 256 * j) = o; }
            if (Xcopy) { ((f32x4*)(Xcopy + (size_t)m * D))[lane + 64 * j] = v0[j]; ((f32x4*)(Xcopy + (size_t)m1 * D))[lane + 64 * j] = v1[j]; }
            if (OutF) { ((f32x4*)(OutF + (size_t)m * D))[lane + 64 * j] = y0; ((f32x4*)(OutF + (size_t)m1 * D))[lane + 64 * j] = y1; } }
    }
}
#define LBAR() do { asm volatile("s_waitcnt lgkmcnt(0)" ::: "memory"); __builtin_amdgcn_s_barrier(); asm volatile("" ::: "memory"); } while (0)

__device__ __forceinline__ void ret_pre_phase(LAS unsigned char* lds, const bf16_t* __restrict__ PROJ, const float* __restrict__ ropeC, const float* __restrict__ ropeS,
                                              bf16_t* __restrict__ GQR, bf16_t* __restrict__ GKT, bf16_t* __restrict__ GS, int vcu, int G, int tid_in) {
    constexpr int LDP = NP_RET;
    LAS bf16_t* sQ = (LAS bf16_t*)lds;
    LAS bf16_t* sK = sQ + 64 * 264;
    LAS bf16_t* sKT = sK + 64 * 264;
    LAS bf16_t* sS = sKT + 256 * 72;
    for (int u = vcu; u < 1024; u += G) {
        int tid = tid_in; asm volatile("" : "+v"(tid)); const int lane = tid & 63, w = __builtin_amdgcn_readfirstlane(tid >> 6), r = lane & 31, hh = lane >> 5;
        const int bh = u >> 5, n = u & 31, b = bh >> 3, h = bh & 7, t0 = b * 2048 + n * 64, s0 = n * 64;
        const float lg = LOGG[h];
#pragma unroll
        for (int it = 0; it < 2; ++it) {
            const int idx = tid + it * 512, c = idx >> 4, g = idx & 15;
            const bf16_t* qrow = PROJ + (size_t)(t0 + c) * LDP + h * 256 + 8 * g;
            const u32x4 q1 = *(const u32x4*)qrow, q2 = *(const u32x4*)(qrow + 128), k1 = *(const u32x4*)(qrow + 2048), k2 = *(const u32x4*)(qrow + 2048 + 128);
            const float* cp = ropeC + (size_t)(s0 + c) * 128 + 8 * g; const float* sp = ropeS + (size_t)(s0 + c) * 128 + 8 * g;
            const f32x4 c0 = *(const f32x4*)cp, c1 = *(const f32x4*)(cp + 4), n0 = *(const f32x4*)sp, n1 = *(const f32x4*)(sp + 4);
            u32x4 oq1, oq2, ok1, ok2;
#pragma unroll
            for (int e = 0; e < 4; ++e) {
                const float ca = (e < 2) ? c0[2 * e] : c1[2 * e - 4], cb = (e < 2) ? c0[2 * e + 1] : c1[2 * e - 3];
                const float sa = (e < 2) ? n0[2 * e] : n1[2 * e - 4], sb = (e < 2) ? n0[2 * e + 1] : n1[2 * e - 3];
                const float x1a = bflo(q1[e]), x1b = bfhi(q1[e]), x2a = bflo(q2[e]), x2b = bfhi(q2[e]);
                oq1[e] = pk(x1a * ca - x2a * sa, x1b * cb - x2b * sb); oq2[e] = pk(x1a * sa + x2a * ca, x1b * sb + x2b * cb);
                const float y1a = bflo(k1[e]) * 0.0625f, y1b = bfhi(k1[e]) * 0.0625f, y2a = bflo(k2[e]) * 0.0625f, y2b = bfhi(k2[e]) * 0.0625f;
                ok1[e] = pk(y1a * ca - y2a * sa, y1b * cb - y2b * sb); ok2[e] = pk(y1a * sa + y2a * ca, y1b * sb + y2b * cb);
            }
            *(LAS u32x4*)(sQ + c * 264 + 8 * g) = oq1; *(LAS u32x4*)(sQ + c * 264 + 128 + 8 * g) = oq2;
            *(LAS u32x4*)(sK + c * 264 + 8 * g) = ok1; *(LAS u32x4*)(sK + c * 264 + 128 + 8 * g) = ok2;
            *(u32x4*)(GQR + ((size_t)u * 64 + c) * 256 + 8 * g) = oq1; *(u32x4*)(GQR + ((size_t)u * 64 + c) * 256 + 128 + 8 * g) = oq2;
        }
        LBAR();
#pragma unroll
        for (int it = 0; it < 4; ++it) { const int idx = tid + it * 512, d = idx & 255, c0 = (idx >> 8) * 8; u32x4 o;
#pragma unroll
            for (int e = 0; e < 4; ++e) { const float a = bf2f(sK[(c0 + 2 * e) * 264 + d]) * __expf(lg * (float)(63 - (c0 + 2 * e)));
                const float bb = bf2f(sK[(c0 + 2 * e + 1) * 264 + d]) * __expf(lg * (float)(62 - (c0 + 2 * e))); o[e] = pk(a, bb); }
            *(LAS u32x4*)(sKT + d * 72 + c0) = o; }
        if (w < 4) { const int ci = w >> 1, xi = w & 1; f32x16 acc = zero16();
            mma32(acc, sQ + 32 * ci * 264, 264, sK + 32 * xi * 264, 264, 256, lane);
#pragma unroll
            for (int reg = 0; reg < 16; ++reg) { const int c = 32 * ci + ROWMAP(reg, hh), m = 32 * xi + r; const int dd = c > m ? c - m : m - c;
                sS[c * 72 + m] = bf1(acc[reg] * __expf(lg * (float)dd)); } }
        LBAR();
#pragma unroll
        for (int it = 0; it < 4; ++it) { const int idx = tid + it * 512, d = idx >> 3, g = idx & 7; *(u32x4*)(GKT + ((size_t)u * 256 + d) * 64 + 8 * g) = *(const LAS u32x4*)(sKT + d * 72 + 8 * g); }
        *(u32x4*)(GS + ((size_t)u * 64 + (tid >> 3)) * 64 + 8 * (tid & 7)) = *(const LAS u32x4*)(sS + (tid >> 3) * 72 + 8 * (tid & 7));
        LBAR();
    }
}
__device__ __forceinline__ void ret_scan_phase(LAS unsigned char* lds, const bf16_t* __restrict__ PROJ, const bf16_t* __restrict__ GQR, const bf16_t* __restrict__ GKT,
                                               const bf16_t* __restrict__ GS, bf16_t* __restrict__ O, unsigned char* ws, int vcu, int G, int tid_in) {
    constexpr int LDP = NP_RET;
    const int wq = __builtin_amdgcn_readfirstlane(tid_in >> 6);
    int bj = vcu * 4 + wq; const int bstride = G * 4;
    TDesc bd0 = TDesc{nullptr, nullptr, 0, 0, 1, 0}; f32x4 bv0[8]; bool bh0 = false;
    LAS float* bscr = (LAS float*)(lds + 122880 + (wq & 3) * 8704);
#define BG_ISSUE(dd, vv_, hh_) do { if (bj < NITEMS_C) { dd = p0_desc_c(ws, bj); t_load(dd, blane, vv_); hh_ = true; bj += bstride; } else hh_ = false; } while (0)
#define BG_STEP(dd, vv_, hh_) do { if (hh_) { t_store(dd, bscr, blane, vv_); BG_ISSUE(dd, vv_, hh_); } } while (0)
    if (wq < 4) { int blane = tid_in & 63; asm volatile("" : "+v"(blane)); BG_ISSUE(bd0, bv0, bh0); }
    LAS bf16_t* sQ = (LAS bf16_t*)lds;
    LAS bf16_t* sKT = sQ + 64 * 264;
    LAS bf16_t* sVT = sKT + 256 * 72;
    LAS bf16_t* sS = sVT + 64 * 72;
    LAS bf16_t* sST = sS + 64 * 72;
    for (int u = vcu; u < 256; u += G) {
        const int bh = u >> 3, jv = u & 7, b = bh >> 3, h = bh & 7;
        const float lg = LOGG[h], cdec = __expf(lg * 64.f);
        f32x16 S0 = zero16(), S1 = zero16();
        u32x4 rQ[4], rK[4], rS, rvv;
#define RET_PREFETCH(nn) do { const size_t chn = (size_t)bh * 32 + (nn); const int t0p = b * 2048 + (nn) * 64; \
            _Pragma("unroll") for (int it = 0; it < 4; ++it) { const int idx = tidp + it * 512; \
                rQ[it] = *(const u32x4*)(GQR + (chn * 64 + (idx >> 5)) * 256 + 8 * (idx & 31)); rK[it] = *(const u32x4*)(GKT + (chn * 256 + (idx >> 3)) * 64 + 8 * (idx & 7)); } \
            rS = *(const u32x4*)(GS + (chn * 64 + (tidp >> 3)) * 64 + 8 * (tidp & 7)); \
            rvv = *(const u32x4*)(PROJ + (size_t)(t0p + (tidp >> 3)) * LDP + 4096 + h * 512 + jv * 64 + 8 * (tidp & 7)); } while (0)
        { int tidp = tid_in; asm volatile("" : "+v"(tidp)); RET_PREFETCH(0); }
        for (int n = 0; n < 32; ++n) {
            int tid = tid_in; asm volatile("" : "+v"(tid)); const int lane = tid & 63, w = __builtin_amdgcn_readfirstlane(tid >> 6), r = lane & 31, hh = lane >> 5;
            const int t0 = b * 2048 + n * 64;
#pragma unroll
            for (int it = 0; it < 4; ++it) { const int idx = tid + it * 512; *(LAS u32x4*)(sQ + (idx >> 5) * 264 + 8 * (idx & 31)) = rQ[it]; *(LAS u32x4*)(sKT + (idx >> 3) * 72 + 8 * (idx & 7)) = rK[it]; }
            *(LAS u32x4*)(sS + (tid >> 3) * 72 + 8 * (tid & 7)) = rS;
            { const int c = tid >> 3, g = tid & 7;
#pragma unroll
              for (int e = 0; e < 4; ++e) { sVT[(8 * g + 2 * e) * 72 + c] = (bf16_t)(rvv[e] & 0xffffu); sVT[(8 * g + 2 * e + 1) * 72 + c] = (bf16_t)(rvv[e] >> 16); } }
            if (n == 0) {
#pragma unroll
                for (int g4 = 0; g4 < 4; ++g4) { const int dk = 32 * w + 8 * g4 + 4 * hh; u32x2 a; a.x = 0u; a.y = 0u; *(LAS u32x2*)(sST + r * 264 + dk) = a; *(LAS u32x2*)(sST + (32 + r) * 264 + dk) = a; } }
            LBAR();
            if (n < 31) { const int tidp = tid; RET_PREFETCH(n + 1); }
            if (w < 4) { const int blane = lane; BG_STEP(bd0, bv0, bh0); }
            if (w >= 4) { const int ci = (w - 4) >> 1, xi = (w - 4) & 1; f32x16 acc = zero16();
                mma32(acc, sQ + 32 * ci * 264, 264, sST + 32 * xi * 264, 264, 256, lane);
#pragma unroll
                for (int reg = 0; reg < 16; ++reg) { const int c = 32 * ci + ROWMAP(reg, hh); acc[reg] *= __expf(lg * (float)(c + 1)); }
                mma32(acc, sS + 32 * ci * 72, 72, sVT + 32 * xi * 72, 72, 64, lane);
#pragma unroll
                for (int reg = 0; reg < 16; ++reg) { const int c = 32 * ci + ROWMAP(reg, hh); O[(size_t)(t0 + c) * 4096 + h * 512 + jv * 64 + 32 * xi + r] = bf1(acc[reg]); } }
            { f32x16 u0 = S0 * cdec, u1 = S1 * cdec;
              mma32(u0, sKT + 32 * w * 72, 72, sVT, 72, 64, lane); mma32(u1, sKT + 32 * w * 72, 72, sVT + 32 * 72, 72, 64, lane); S0 = u0; S1 = u1; }
            LBAR();
#pragma unroll
            for (int g4 = 0; g4 < 4; ++g4) { const int dk = 32 * w + 8 * g4 + 4 * hh; u32x2 a, c2;
                a.x = pk(S0[4 * g4], S0[4 * g4 + 1]); a.y = pk(S0[4 * g4 + 2], S0[4 * g4 + 3]); c2.x = pk(S1[4 * g4], S1[4 * g4 + 1]); c2.y = pk(S1[4 * g4 + 2], S1[4 * g4 + 3]);
                *(LAS u32x2*)(sST + r * 264 + dk) = a; *(LAS u32x2*)(sST + (32 + r) * 264 + dk) = c2; }
            if (w < 4) { const int blane = lane; BG_STEP(bd0, bv0, bh0); }
        }
#undef RET_PREFETCH
        LBAR();
    }
    if (wq < 4) { int blane = tid_in & 63; asm volatile("" : "+v"(blane)); while (bh0) { BG_STEP(bd0, bv0, bh0); } }
#undef BG_ISSUE
#undef BG_STEP
}
template <bool CENTER>
__device__ __forceinline__ void hn512_phase(const bf16_t* __restrict__ O, int ldo, int H, const float* __restrict__ gain, const bf16_t* __restrict__ PROJ, int ldp, int gcol0,
                                            bf16_t* __restrict__ ON, int gw, int NGW, int lane) {
    const int NI = T * H;
    for (int it0 = gw; it0 < NI; it0 += 4 * NGW) {
        f32x4 v[4][2], gg[4][2]; u32x4 gt[4]; int tt[4], hx[4];
#pragma unroll
        for (int q = 0; q < 4; ++q) { int it = it0 + q * NGW; if (it >= NI) it = it0;
            const int t = it / H, h = it - t * H; tt[q] = t; hx[q] = h; const int col = h * 512 + 8 * lane;
            const u32x4 a = *(const u32x4*)(O + (size_t)t * ldo + col);
            v[q][0] = (f32x4){bflo(a.x), bfhi(a.x), bflo(a.y), bfhi(a.y)}; v[q][1] = (f32x4){bflo(a.z), bfhi(a.z), bflo(a.w), bfhi(a.w)};
            gg[q][0] = *(const f32x4*)(gain + col); gg[q][1] = *(const f32x4*)(gain + col + 4); gt[q] = *(const u32x4*)(PROJ + (size_t)t * ldp + gcol0 + col); }
        float rs[4];
        if (CENTER) { float mean[4];
#pragma unroll
            for (int q = 0; q < 4; ++q) mean[q] = (v[q][0][0] + v[q][0][1]) + (v[q][0][2] + v[q][0][3]) + (v[q][1][0] + v[q][1][1]) + (v[q][1][2] + v[q][1][3]);
#pragma unroll
            for (int o = 1; o < 64; o <<= 1) {
#pragma unroll
                for (int q = 0; q < 4; ++q) mean[q] += __shfl_xor(mean[q], o); }
#pragma unroll
            for (int q = 0; q < 4; ++q) { const float mu = mean[q] * (1.f / 512.f); v[q][0] = v[q][0] - mu; v[q][1] = v[q][1] - mu; } }
#pragma unroll
        for (int q = 0; q < 4; ++q) rs[q] = (v[q][0][0] * v[q][0][0] + v[q][0][1] * v[q][0][1]) + (v[q][0][2] * v[q][0][2] + v[q][0][3] * v[q][0][3]) + (v[q][1][0] * v[q][1][0] + v[q][1][1] * v[q][1][1]) + (v[q][1][2] * v[q][1][2] + v[q][1][3] * v[q][1][3]);
#pragma unroll
        for (int o = 1; o < 64; o <<= 1) {
#pragma unroll
            for (int q = 0; q < 4; ++q) rs[q] += __shfl_xor(rs[q], o); }
#pragma unroll
        for (int q = 0; q < 4; ++q) { const float r1 = rsqrtf(rs[q] * (1.f / 512.f) + 1e-6f); const int col = hx[q] * 512 + 8 * lane; const u32x4 gq = gt[q]; const f32x4 g0 = gg[q][0], g1 = gg[q][1];
            u32x4 o; o.x = pk(v[q][0][0] * r1 * g0[0] * siluf_(bflo(gq.x)), v[q][0][1] * r1 * g0[1] * siluf_(bfhi(gq.x)));
            o.y = pk(v[q][0][2] * r1 * g0[2] * siluf_(bflo(gq.y)), v[q][0][3] * r1 * g0[3] * siluf_(bfhi(gq.y)));
            o.z = pk(v[q][1][0] * r1 * g1[0] * siluf_(bflo(gq.z)), v[q][1][1] * r1 * g1[1] * siluf_(bfhi(gq.z)));
            o.w = pk(v[q][1][2] * r1 * g1[2] * siluf_(bflo(gq.w)), v[q][1][3] * r1 * g1[3] * siluf_(bfhi(gq.w)));
            *(u32x4*)(ON + (size_t)tt[q] * ldo + col) = o; }
    }
}

__device__ __forceinline__ void gdn_prep_phase(LAS unsigned char* lds, const bf16_t* __restrict__ PROJ, const float* __restrict__ SM, const float* __restrict__ conv_w,
                                               const float* __restrict__ a_log, const float* __restrict__ dt_bias, bf16_t* __restrict__ GQ, bf16_t* __restrict__ GKE,
                                               bf16_t* __restrict__ GU, bf16_t* __restrict__ GW, float* __restrict__ GG, int vcu, int G, int tid_in) {
    constexpr int LDP = NP_GDN;
    LAS float* sSol = (LAS float*)lds;
    LAS float* sA = sSol + 64 * 257;
    LAS float* sBeta = sA + 64 * 68;
    LAS float* sCum = sBeta + 64;
    LAS bf16_t* sKb = (LAS bf16_t*)(sCum + 64);
    LAS bf16_t* sRaw = sKb + 64 * 136;
    for (int u = vcu; u < 2048; u += G) {
        int tid = tid_in; asm volatile("" : "+v"(tid)); const int lane = tid & 63, w = __builtin_amdgcn_readfirstlane(tid >> 6), r = lane & 31, hh = lane >> 5;
        const int b = u >> 9, h = (u >> 5) & 15, n = u & 31;
        const int t0 = b * 2048 + n * 64, s0 = n * 64;
        u32x4 raw[3];
#define GDN_PREFETCH(ten) do { _Pragma("unroll") for (int it = 0; it < 3; ++it) { const int idx = tid + it * 512, rr = idx >> 4, g = idx & 15; raw[it] = (u32x4){0u, 0u, 0u, 0u}; \
            if (idx < 67 * 16 && s0 - 3 + rr >= 0) raw[it] = *(const u32x4*)(PROJ + (size_t)(t0 - 3 + rr) * LDP + (ten) * 2048 + h * 128 + 8 * g); } } while (0)
        GDN_PREFETCH(0);
        float cw[3][4][2];
#pragma unroll
        for (int ten = 0; ten < 3; ++ten)
#pragma unroll
            for (int tap = 0; tap < 4; ++tap) { const float* cp = conv_w + tap * 6144 + ten * 2048 + h * 128 + 2 * lane; cw[ten][tap][0] = cp[0]; cw[ten][tap][1] = cp[1]; }
        if (tid < 64) {
            const float bl = SM[(size_t)(t0 + tid) * 32 + h], al = SM[(size_t)(t0 + tid) * 32 + 16 + h];
            const float x = al + dt_bias[h];
            const float sp = (x > 20.f) ? x : log1pf(__expf(x));
            float la = -__expf(a_log[h]) * sp;
#pragma unroll
            for (int o = 1; o < 64; o <<= 1) { const float y = __shfl_up(la, o); if (lane >= o) la += y; }
            sBeta[tid] = sigmoidf_(bl); sCum[tid] = la;
        }
#pragma unroll
        for (int ten = 0; ten < 3; ++ten) {
#pragma unroll
            for (int it = 0; it < 3; ++it) { const int idx = tid + it * 512, rr = idx >> 4, g = idx & 15; if (idx < 67 * 16) *(LAS u32x4*)(sRaw + rr * 136 + 8 * g) = raw[it]; }
            LBAR();
            if (ten == 0) GDN_PREFETCH(1);
            if (ten == 1) GDN_PREFETCH(2);
            const float cumL = sCum[63];
            float a0[8], a1[8], ss[8];
#pragma unroll
            for (int rr = 0; rr < 8; ++rr) { const int c = w + 8 * rr; float x0 = 0.f, x1 = 0.f;
#pragma unroll
                for (int tap = 0; tap < 4; ++tap) { const unsigned xv = *(const LAS unsigned*)(sRaw + (c + tap) * 136 + 2 * lane); x0 += bflo(xv) * cw[ten][tap][0]; x1 += bfhi(xv) * cw[ten][tap][1]; }
                a0[rr] = siluf_(x0); a1[rr] = siluf_(x1); ss[rr] = a0[rr] * a0[rr] + a1[rr] * a1[rr]; }
            if (ten != 2) {
#pragma unroll
                for (int o = 1; o < 64; o <<= 1) {
#pragma unroll
                    for (int rr = 0; rr < 8; ++rr) ss[rr] += __shfl_xor(ss[rr], o); } }
#pragma unroll
            for (int rr = 0; rr < 8; ++rr) { const int c = w + 8 * rr; const float beta = sBeta[c], cum = sCum[c];
                if (ten == 2) { sSol[c * 257 + 2 * lane] = beta * a0[rr]; sSol[c * 257 + 2 * lane + 1] = beta * a1[rr]; }
                else { float rn = rsqrtf(ss[rr] + 1e-6f);
                    if (ten == 0) { rn *= 0.08838834764831845f; *(unsigned*)(GQ + ((size_t)u * 64 + c) * 128 + 2 * lane) = pk(a0[rr] * rn, a1[rr] * rn); }
                    else { const float k0 = a0[rr] * rn, k1 = a1[rr] * rn; *(LAS unsigned*)(sKb + c * 136 + 2 * lane) = pk(k0, k1);
                        const float f = beta * __expf(cum); sSol[c * 257 + 128 + 2 * lane] = f * k0; sSol[c * 257 + 128 + 2 * lane + 1] = f * k1;
                        const float e = __expf(cumL - cum); *(unsigned*)(GKE + ((size_t)u * 64 + c) * 128 + 2 * lane) = pk(k0 * e, k1 * e); } } }
            LBAR();
        }
#undef GDN_PREFETCH
        const float cumL = sCum[63];
        if (w < 4) { const int ci = w >> 1, mi = w & 1; f32x16 acc = zero16();
            mma32(acc, sKb + 32 * ci * 136, 136, sKb + 32 * mi * 136, 136, 128, lane);
#pragma unroll
            for (int reg = 0; reg < 16; ++reg) { const int c = 32 * ci + ROWMAP(reg, hh), m = 32 * mi + r;
                sA[c * 68 + m] = (c > m) ? sBeta[c] * __expf(sCum[c] - sCum[m]) * acc[reg] : 0.f; } }
        LBAR();
        { const int j = tid & 255, pp = tid >> 8;
          for (int kb = 0; kb < 8; ++kb) { const int c0 = 8 * kb + 4 * pp; float a[4];
#pragma unroll
              for (int q = 0; q < 4; ++q) a[q] = sSol[(c0 + q) * 257 + j];
              for (int m = 0; m < 8 * kb; m += 4) { float sv[4];
#pragma unroll
                  for (int q = 0; q < 4; ++q) sv[q] = sSol[(m + q) * 257 + j];
#pragma unroll
                  for (int q = 0; q < 4; ++q) { const f32x4 A = *(const LAS f32x4*)(sA + (c0 + q) * 68 + m); a[q] -= (A[0] * sv[0] + A[1] * sv[1]) + (A[2] * sv[2] + A[3] * sv[3]); } }
              if (pp == 1) LBAR();
              if (pp == 1) { float sv[4];
#pragma unroll
                  for (int q = 0; q < 4; ++q) sv[q] = sSol[(8 * kb + q) * 257 + j];
#pragma unroll
                  for (int q = 0; q < 4; ++q) { const f32x4 A = *(const LAS f32x4*)(sA + (c0 + q) * 68 + 8 * kb); a[q] -= (A[0] * sv[0] + A[1] * sv[1]) + (A[2] * sv[2] + A[3] * sv[3]); } }
              { const f32x4 D1 = *(const LAS f32x4*)(sA + (c0 + 1) * 68 + c0), D2 = *(const LAS f32x4*)(sA + (c0 + 2) * 68 + c0), D3 = *(const LAS f32x4*)(sA + (c0 + 3) * 68 + c0);
                a[1] -= D1[0] * a[0]; a[2] -= D2[0] * a[0] + D2[1] * a[1]; a[3] -= D3[0] * a[0] + D3[1] * a[1] + D3[2] * a[2]; }
#pragma unroll
              for (int q = 0; q < 4; ++q) sSol[(c0 + q) * 257 + j] = a[q];
              if (pp == 0) LBAR();
              LBAR(); } }
#pragma unroll 4
        for (int it = 0; it < 16; ++it) { const int idx = tid + it * 512, c = idx >> 7, p2 = idx & 127; const unsigned o = pk(sSol[c * 257 + 2 * p2], sSol[c * 257 + 2 * p2 + 1]);
            if (p2 < 64) *(unsigned*)(GU + ((size_t)u * 64 + c) * 128 + 2 * p2) = o; else *(unsigned*)(GW + ((size_t)u * 64 + c) * 128 + 2 * p2 - 128) = o; }
        if (tid == 0) GG[u] = __expf(cumL);
        LBAR();
    }
}
__device__ __forceinline__ void gdn_scan_phase(LAS unsigned char* lds, const bf16_t* __restrict__ GQ, const bf16_t* __restrict__ GKE, const bf16_t* __restrict__ GU,
                                               const bf16_t* __restrict__ GW, const float* __restrict__ GG, bf16_t* __restrict__ O, unsigned char* ws, int vcu, int G, int tid_in) {
    const int wq = __builtin_amdgcn_readfirstlane(tid_in >> 6);
    int bj = vcu * 4 + (wq - 4); const int bstride = G * 4;
    TDesc bd0 = TDesc{nullptr, nullptr, 0, 0, 1, 0}, bd1 = bd0; f32x4 bv0[8], bv1[8]; bool bh0 = false, bh1 = false;
    LAS float* bscr = (LAS float*)(lds + 81920 + (wq & 3) * 8704);
#define BG_ISSUE(dd, vv_, hh_) do { if (bj < NITEMS_B) { dd = p0_desc_b(ws, bj); t_load(dd, blane, vv_); hh_ = true; bj += bstride; } else hh_ = false; } while (0)
#define BG_STEP(dd, vv_, hh_) do { if (hh_) { t_store(dd, bscr, blane, vv_); BG_ISSUE(dd, vv_, hh_); } } while (0)
    if (wq >= 4) { int blane = tid_in & 63; asm volatile("" : "+v"(blane)); BG_ISSUE(bd0, bv0, bh0); BG_ISSUE(bd1, bv1, bh1); }
    LAS bf16_t* sW = (LAS bf16_t*)lds;
    LAS bf16_t* sQ = sW + 64 * 136;
    LAS bf16_t* sKET = sQ + 64 * 136;
    LAS bf16_t* sST = sKET + 128 * 72;
    LAS bf16_t* sDT = sST + 32 * 136;
    LAS bf16_t* sU = sDT + 32 * 72;
    for (int u = vcu; u < 256; u += G) {
        const int bh = u >> 2, jv = u & 3, b = bh >> 4, h = bh & 15;
        f32x16 S = zero16();
        u32x4 rW[2], rQ[2], rK[2], rU; float rg = 0.f; int zoff = 0; asm volatile("" : "+v"(zoff));
        rU = (u32x4){0u, 0u, 0u, 0u};
#define SCAN_PREFETCH(nn) do { const size_t chn = (size_t)bh * 32 + (nn); \
            _Pragma("unroll") for (int it = 0; it < 2; ++it) { const int idx = tidp + it * 512, c = idx >> 4, g = idx & 15; const size_t go = (chn * 64 + c) * 128 + 8 * g; \
                rW[it] = *(const u32x4*)(GW + go); rQ[it] = *(const u32x4*)(GQ + go); rK[it] = *(const u32x4*)(GKE + go); } \
            if (tidp < 256) rU = *(const u32x4*)(GU + (chn * 64 + (tidp >> 2)) * 128 + jv * 32 + 8 * (tidp & 3)); \
            rg = GG[chn + zoff]; } while (0)
        { int tidp = tid_in; asm volatile("" : "+v"(tidp)); SCAN_PREFETCH(0); }
        for (int n = 0; n < 32; ++n) {
            int tid = tid_in; asm volatile("" : "+v"(tid)); const int lane = tid & 63, w = __builtin_amdgcn_readfirstlane(tid >> 6), r = lane & 31, hh = lane >> 5;
            const int t0 = b * 2048 + n * 64;
#pragma unroll
            for (int it = 0; it < 2; ++it) { const int idx = tid + it * 512, c = idx >> 4, g = idx & 15;
                *(LAS u32x4*)(sW + c * 136 + 8 * g) = rW[it]; *(LAS u32x4*)(sQ + c * 136 + 8 * g) = rQ[it];
#pragma unroll
                for (int e = 0; e < 4; ++e) { sKET[(8 * g + 2 * e) * 72 + c] = (bf16_t)(rK[it][e] & 0xffffu); sKET[(8 * g + 2 * e + 1) * 72 + c] = (bf16_t)(rK[it][e] >> 16); } }
            if (tid < 256) *(LAS u32x4*)(sU + (tid >> 2) * 40 + 8 * (tid & 3)) = rU;
            if (n == 0 && w < 4) {
#pragma unroll
                for (int g4 = 0; g4 < 4; ++g4) { u32x2 a; a.x = 0u; a.y = 0u; *(LAS u32x2*)(sST + r * 136 + 32 * w + 8 * g4 + 4 * hh) = a; } }
            const float cg_ = rg;
            LBAR();
            if (n < 31) { const int tidp = tid; SCAN_PREFETCH(n + 1); }
            if (w >= 4) { const int blane = lane; BG_STEP(bd0, bv0, bh0); }
            if (w < 2) { f32x16 acc = zero16(); mma32(acc, sW + 32 * w * 136, 136, sST, 136, 128, lane);
#pragma unroll
                for (int g4 = 0; g4 < 4; ++g4) { const int c = 32 * w + 8 * g4 + 4 * hh; const LAS bf16_t* up = sU + c * 40 + r;
                    u32x2 a; a.x = pk(bf2f(up[0]) - acc[4 * g4], bf2f(up[40]) - acc[4 * g4 + 1]); a.y = pk(bf2f(up[80]) - acc[4 * g4 + 2], bf2f(up[120]) - acc[4 * g4 + 3]);
                    *(LAS u32x2*)(sDT + r * 72 + c) = a; } }
            LBAR();
            if (w < 4) { f32x16 s2 = S * cg_; mma32(s2, sKET + 32 * w * 72, 72, sDT, 72, 64, lane); S = s2;
#pragma unroll
                for (int g4 = 0; g4 < 4; ++g4) { u32x2 a; a.x = pk(S[4 * g4], S[4 * g4 + 1]); a.y = pk(S[4 * g4 + 2], S[4 * g4 + 3]); *(LAS u32x2*)(sST + r * 136 + 32 * w + 8 * g4 + 4 * hh) = a; } }
            LBAR();
            if (w >= 4) { const int blane = lane; BG_STEP(bd1, bv1, bh1); }
            if (w < 2) { f32x16 acc = zero16(); mma32(acc, sQ + 32 * w * 136, 136, sST, 136, 128, lane);
#pragma unroll
                for (int reg = 0; reg < 16; ++reg) { const int c = 32 * w + ROWMAP(reg, hh); O[(size_t)(t0 + c) * 2048 + h * 128 + jv * 32 + r] = bf1(acc[reg]); } }
            LBAR();
        }
#undef SCAN_PREFETCH
    }
    if (wq >= 4) { int blane = tid_in & 63; asm volatile("" : "+v"(blane)); while (bh0 || bh1) { BG_STEP(bd0, bv0, bh0); BG_STEP(bd1, bv1, bh1); } }
#undef BG_ISSUE
#undef BG_STEP
}
__device__ __forceinline__ void gdn_hn_phase(const bf16_t* __restrict__ O, const float* __restrict__ gain, const bf16_t* __restrict__ PROJ, bf16_t* __restrict__ ON, int gw, int NGW, int lane) {
    for (int t = gw; t < T; t += NGW) {
#pragma unroll
        for (int j = 0; j < 8; ++j) { const int col = 4 * lane + 256 * j;
            const u32x2 ov = *(const u32x2*)(O + (size_t)t * 2048 + col); const f32x4 v = (f32x4){bflo(ov.x), bfhi(ov.x), bflo(ov.y), bfhi(ov.y)};
            float ss = (v[0] * v[0] + v[1] * v[1]) + (v[2] * v[2] + v[3] * v[3]);
#pragma unroll
            for (int o = 1; o < 32; o <<= 1) ss += __shfl_xor(ss, o);
            const float rs = rsqrtf(ss * (1.f / 128.f) + 1e-6f);
            const f32x4 gg = *(const f32x4*)(gain + (col & 127)); const u32x2 zt = *(const u32x2*)(PROJ + (size_t)t * NP_GDN + 6144 + col);
            u32x2 o; o.x = pk(v[0] * rs * gg[0] * siluf_(bflo(zt.x)), v[1] * rs * gg[1] * siluf_(bfhi(zt.x)));
            o.y = pk(v[2] * rs * gg[2] * siluf_(bflo(zt.y)), v[3] * rs * gg[3] * siluf_(bfhi(zt.y)));
            *(u32x2*)(ON + (size_t)t * 2048 + col) = o; }
    }
}

__device__ __forceinline__ void gla_pre_phase(LAS unsigned char* lds, const bf16_t* __restrict__ PROJ, const float* __restrict__ SM, const float* __restrict__ wg,
                                              const float* __restrict__ gbias, bf16_t* __restrict__ GQI, bf16_t* __restrict__ GKBT, bf16_t* __restrict__ GS, float* __restrict__ GE,
                                              int vcu, int G, int tid_in) {
    constexpr int LDP = NP_GLA;
    LAS bf16_t* bufA = (LAS bf16_t*)lds;
    LAS bf16_t* bufB = bufA + 64 * 264;
    LAS bf16_t* sKbT = bufB + 64 * 264;
    LAS bf16_t* sS = sKbT + 256 * 72;
    LAS float* sTot = (LAS float*)(sS + 64 * 72);
    LAS float* sGL = sTot + 512;
    for (int u = vcu; u < 512; u += G) {
        int tid = tid_in; asm volatile("" : "+v"(tid)); const int lane = tid & 63, w = __builtin_amdgcn_readfirstlane(tid >> 6), r = lane & 31, hh = lane >> 5;
        const int dk = tid & 255, half = tid >> 8;
        const int bh = u >> 5, n = u & 31, b = bh >> 2, h = bh & 3, t0 = b * 2048 + n * 64;
        float wgc[16];
#pragma unroll
        for (int q = 0; q < 16; ++q) wgc[q] = wg[q * 1024 + h * 256 + dk];
        const float gb = gbias[h * 256 + dk];
        u32x4 qraw[4], kraw[4];
#pragma unroll
        for (int it = 0; it < 4; ++it) { const int idx = tid + it * 512, c = idx >> 5, g = idx & 31; const bf16_t* pr = PROJ + (size_t)(t0 + c) * LDP + h * 256 + 8 * g;
            qraw[it] = *(const u32x4*)pr; kraw[it] = *(const u32x4*)(pr + 1024); }
        if (tid < 256) *(LAS f32x4*)(sGL + (tid >> 2) * 16 + 4 * (tid & 3)) = *(const f32x4*)(SM + (size_t)(t0 + (tid >> 2)) * 32 + 4 * (tid & 3));
#pragma unroll
        for (int it = 0; it < 4; ++it) { const int idx = tid + it * 512, c = idx >> 5, g = idx & 31; *(LAS u32x4*)(bufA + c * 264 + 8 * g) = qraw[it]; *(LAS u32x4*)(bufB + c * 264 + 8 * g) = kraw[it]; }
        LBAR();
        float cum[32]; float run = 0.f;
#pragma unroll
        for (int i = 0; i < 32; ++i) { const int c = 32 * half + i; float x = gb;
#pragma unroll
            for (int q = 0; q < 16; ++q) x += sGL[c * 16 + q] * wgc[q];
            const float ls = fminf(x, 0.f) - __logf(1.f + __expf(-fabsf(x))); run += ls * 0.0625f; cum[i] = run;
            if ((i & 7) == 7) __builtin_amdgcn_sched_barrier(0); }
        sTot[half * 256 + dk] = run;
        LBAR();
        const float tot0 = sTot[dk], tot1 = sTot[256 + dk], E0 = __expf(tot0);
        if (half == 0) { GE[(size_t)u * 512 + dk] = __expf(tot1); GE[(size_t)u * 512 + 256 + dk] = __expf(tot0 + tot1); }
        const float off = half ? 0.f : -tot0;
        unsigned pkreg[32]; unsigned kbp[16]; unsigned pkq[16];
#pragma unroll
        for (int i = 0; i < 32; ++i) { const int c = 32 * half + i; const float v = cum[i] + off, e = __expf(v), ei = __expf(-v);
            const float q = bf2f(bufA[c * 264 + dk]) * 0.0625f, k = bf2f(bufB[c * 264 + dk]);
            const unsigned a = pk(q * e, k * ei);
            bufA[c * 264 + dk] = (bf16_t)(a & 0xffffu); bufB[c * 264 + dk] = (bf16_t)(a >> 16);
            if (i & 1) kbp[i >> 1] |= (a & 0xffff0000u); else kbp[i >> 1] = a >> 16;
            const unsigned qi = pk(q * e * E0, 0.f);
            if (i & 1) pkq[i >> 1] |= (qi << 16); else pkq[i >> 1] = qi & 0xffffu;
            pkreg[i] = pk(q * ei, k * e);
            if ((i & 7) == 7) __builtin_amdgcn_sched_barrier(0); }
#pragma unroll
        for (int q = 0; q < 4; ++q) { u32x4 o; o.x = kbp[4 * q]; o.y = kbp[4 * q + 1]; o.z = kbp[4 * q + 2]; o.w = kbp[4 * q + 3]; *(LAS u32x4*)(sKbT + dk * 72 + 32 * half + 8 * q) = o; }
        LBAR();
        f32x16 accA = zero16();
        const int ci = (w & 3) >> 1, mi = w & 1;
        if (w < 4) mma32(accA, bufA + 32 * ci * 264, 264, bufB + 32 * mi * 264, 264, 256, lane);
#pragma unroll
        for (int it = 0; it < 4; ++it) { const int idx = tid + it * 512, d = idx >> 3, g = idx & 7; *(u32x4*)(GKBT + ((size_t)u * 256 + d) * 64 + 8 * g) = *(const LAS u32x4*)(sKbT + d * 72 + 8 * g); }
        LBAR();
#pragma unroll
        for (int i = 0; i < 32; ++i) { const int c = 32 * half + i; bufA[c * 264 + dk] = (bf16_t)(pkreg[i] & 0xffffu); bufB[c * 264 + dk] = (bf16_t)(pkreg[i] >> 16); }
        LBAR();
        if (w < 4) { f32x16 accU = zero16(); mma32(accU, bufA + 32 * ci * 264, 264, bufB + 32 * mi * 264, 264, 256, lane);
#pragma unroll
            for (int reg = 0; reg < 16; ++reg) { const int c = 32 * ci + ROWMAP(reg, hh), m = 32 * mi + r; sS[c * 72 + m] = bf1((c >= m) ? accA[reg] : accU[reg]); } }
        LBAR();
#pragma unroll
        for (int i = 0; i < 32; ++i) { const int c = 32 * half + i; bufA[c * 264 + dk] = (bf16_t)((i & 1) ? (pkq[i >> 1] >> 16) : (pkq[i >> 1] & 0xffffu)); }
        *(u32x4*)(GS + ((size_t)u * 64 + (tid >> 3)) * 64 + 8 * (tid & 7)) = *(const LAS u32x4*)(sS + (tid >> 3) * 72 + 8 * (tid & 7));
        LBAR();
#pragma unroll
        for (int it = 0; it < 4; ++it) { const int idx = tid + it * 512, c = idx >> 5, g = idx & 31; *(u32x4*)(GQI + ((size_t)u * 64 + c) * 256 + 8 * g) = *(const LAS u32x4*)(bufA + c * 264 + 8 * g); }
        LBAR();
    }
}
__device__ __forceinline__ void gla_scan_phase(LAS unsigned char* lds, const bf16_t* __restrict__ PROJ, const bf16_t* __restrict__ GQI, const bf16_t* __restrict__ GKBT,
                                               const bf16_t* __restrict__ GS, const float* __restrict__ GE, bf16_t* __restrict__ O, int vcu, int G, int tid_in) {
    constexpr int LDP = NP_GLA;
    LAS bf16_t* bufA = (LAS bf16_t*)lds;
    LAS bf16_t* sKbT = bufA + 64 * 264;
    LAS bf16_t* sVT = sKbT + 256 * 72;
    LAS bf16_t* sS = sVT + 32 * 72;
    LAS bf16_t* sST = sS + 64 * 72;
    LAS float* sE = (LAS float*)(sST + 32 * 264);
    for (int u = vcu; u < 256; u += G) {
        const int bh = u >> 4, jv = u & 15, b = bh >> 2, h = bh & 3;
        f32x16 S = zero16();
        u32x4 rQ[4], rK[4], rS; f32x4 rE = (f32x4){0.f, 0.f, 0.f, 0.f}; u32x2 vv;
#define GLA_PREFETCH(nn) do { const size_t chn = (size_t)bh * 32 + (nn); const int t0p = b * 2048 + (nn) * 64; \
            _Pragma("unroll") for (int it = 0; it < 4; ++it) { const int idx = tidp + it * 512; \
                rQ[it] = *(const u32x4*)(GQI + (chn * 64 + (idx >> 5)) * 256 + 8 * (idx & 31)); rK[it] = *(const u32x4*)(GKBT + (chn * 256 + (idx >> 3)) * 64 + 8 * (idx & 7)); } \
            rS = *(const u32x4*)(GS + (chn * 64 + (tidp >> 3)) * 64 + 8 * (tidp & 7)); \
            if (tidp < 128) rE = *(const f32x4*)(GE + chn * 512 + 4 * tidp); \
            vv = *(const u32x2*)(PROJ + (size_t)(t0p + (tidp >> 3)) * LDP + 2048 + h * 512 + jv * 32 + 4 * (tidp & 7)); } while (0)
        { int tidp = tid_in; asm volatile("" : "+v"(tidp)); GLA_PREFETCH(0); }
        for (int n = 0; n < 32; ++n) {
            int tid = tid_in; asm volatile("" : "+v"(tid)); const int lane = tid & 63, w = __builtin_amdgcn_readfirstlane(tid >> 6), r = lane & 31, hh = lane >> 5;
            const int t0 = b * 2048 + n * 64;
#pragma unroll
            for (int it = 0; it < 4; ++it) { const int idx = tid + it * 512; *(LAS u32x4*)(bufA + (idx >> 5) * 264 + 8 * (idx & 31)) = rQ[it]; *(LAS u32x4*)(sKbT + (idx >> 3) * 72 + 8 * (idx & 7)) = rK[it]; }
            *(LAS u32x4*)(sS + (tid >> 3) * 72 + 8 * (tid & 7)) = rS;
            if (tid < 128) *(LAS f32x4*)(sE + 4 * tid) = rE;
            { const int c = tid >> 3, g = tid & 7;
              sVT[(4 * g) * 72 + c] = (bf16_t)(vv.x & 0xffffu); sVT[(4 * g + 1) * 72 + c] = (bf16_t)(vv.x >> 16); sVT[(4 * g + 2) * 72 + c] = (bf16_t)(vv.y & 0xffffu); sVT[(4 * g + 3) * 72 + c] = (bf16_t)(vv.y >> 16); }
            if (n == 0) {
#pragma unroll
                for (int g4 = 0; g4 < 4; ++g4) { u32x2 a; a.x = 0u; a.y = 0u; *(LAS u32x2*)(sST + r * 264 + 32 * w + 8 * g4 + 4 * hh) = a; } }
            LBAR();
            if (n < 31) { const int tidp = tid; GLA_PREFETCH(n + 1); }
            if (w == 4 || w == 5) { f32x16 acc = zero16(); mma32(acc, bufA + 32 * (w - 4) * 264, 264, sST, 264, 256, lane); mma32(acc, sS + 32 * (w - 4) * 72, 72, sVT, 72, 64, lane);
#pragma unroll
                for (int reg = 0; reg < 16; ++reg) { const int c = 32 * (w - 4) + ROWMAP(reg, hh); O[(size_t)(t0 + c) * 2048 + h * 512 + jv * 32 + r] = bf1(acc[reg]); } }
            { f32x16 up = zero16(); mma32(up, sKbT + 32 * w * 72, 72, sVT, 72, 64, lane);
#pragma unroll
              for (int reg = 0; reg < 16; ++reg) { const int dkr = 32 * w + ROWMAP(reg, hh); S[reg] = S[reg] * sE[256 + dkr] + sE[dkr] * up[reg]; } }
            LBAR();
#pragma unroll
            for (int g4 = 0; g4 < 4; ++g4) { u32x2 a; a.x = pk(S[4 * g4], S[4 * g4 + 1]); a.y = pk(S[4 * g4 + 2], S[4 * g4 + 3]); *(LAS u32x2*)(sST + r * 264 + 32 * w + 8 * g4 + 4 * hh) = a; }
        }
#undef GLA_PREFETCH
        LBAR();
    }
}
__device__ __forceinline__ float gelu_tanh_(float y) { const float z = 0.7978845608028654f * (y + 0.044715f * y * y * y); const float th = 1.f - 2.f * __builtin_amdgcn_rcpf(1.f + __expf(2.f * z)); return 0.5f * y * (1.f + th); }
__device__ __forceinline__ void lru_phase(LAS unsigned char* lds, const bf16_t* __restrict__ PROJ, const float* __restrict__ conv_w, const float* __restrict__ conv_b,
                                          const bf16_t* __restrict__ WTr, const bf16_t* __restrict__ WTi, const float* __restrict__ b_r, const float* __restrict__ b_i,
                                          const float* __restrict__ lam, bf16_t* __restrict__ ON, int vcu, int G, int tid_in) {
    constexpr int LDP = NP_LRU;
    LAS bf16_t* sX = (LAS bf16_t*)lds;
    LAS bf16_t* sWr = sX + 128 * 136;
    LAS bf16_t* sWi = sWr + 32 * 136;
    LAS float* sXf = (LAS float*)(sWi + 32 * 136);
    LAS float* sA = sXf + 128 * 33;
    LAS float* sM = sA + 128 * 33;
    LAS float* sU = sM + 128 * 33;
    LAS float* sSeg = sU + 128 * 33;
    LAS float* sCarry = sSeg + 1024;
    for (int u = vcu; u < 256; u += G) {
        const int b = u >> 6, nb = (u >> 2) & 15, es = u & 3, ch0 = nb * 128 + es * 32;
        int tidu = tid_in; asm volatile("" : "+v"(tidu));
        { const int tid = tidu; const int e = tid >> 4, g = tid & 15; const size_t go = ((size_t)nb * 128 + es * 32 + e) * 128 + 8 * g;
          *(LAS u32x4*)(sWr + e * 136 + 8 * g) = *(const u32x4*)(WTr + go); *(LAS u32x4*)(sWi + e * 136 + 8 * g) = *(const u32x4*)(WTi + go); }
        float cw[4][2];
#pragma unroll
        for (int tap = 0; tap < 4; ++tap) { cw[tap][0] = conv_w[tap * 2048 + nb * 128 + 2 * (tidu & 63)]; cw[tap][1] = conv_w[tap * 2048 + nb * 128 + 2 * (tidu & 63) + 1]; }
        const float cb0 = conv_b[nb * 128 + 2 * (tidu & 63)], cb1 = conv_b[nb * 128 + 2 * (tidu & 63) + 1];
        if (tidu < 32) sCarry[tidu] = 0.f;
        const float br = b_r[ch0 + (tidu & 31)], bi = b_i[ch0 + (tidu & 31)], c8 = -8.f * log1pf(__expf(-lam[ch0 + (tidu & 31)]));
        for (int tt = 0; tt < 16; ++tt) {
            int tid = tid_in; asm volatile("" : "+v"(tid)); const int lane = tid & 63, w = __builtin_amdgcn_readfirstlane(tid >> 6), r = lane & 31, hh = lane >> 5; (void)r; (void)hh; (void)w; (void)lane;
            const int s0 = tt * 128; const size_t t0 = (size_t)b * 2048 + s0;
            __syncthreads();
            { const int p2 = tid & 63, rg = tid >> 6, col = nb * 128 + 2 * p2;
              float xa[3], xb[3];
#pragma unroll
              for (int k = 0; k < 3; ++k) { const int s = s0 + 16 * rg - 3 + k; unsigned xv = 0u; if (s >= 0) xv = *(const unsigned*)(PROJ + (t0 + 16 * rg - 3 + k) * LDP + col); xa[k] = bflo(xv); xb[k] = bfhi(xv); }
              const bool mine = ((2 * p2) >> 5) == es;
#pragma unroll
              for (int i = 0; i < 16; ++i) { const int row = 16 * rg + i; const unsigned xv = *(const unsigned*)(PROJ + (t0 + row) * LDP + col); const float ca = bflo(xv), cbv = bfhi(xv);
                  const float o0 = cb0 + cw[0][0] * xa[0] + cw[1][0] * xa[1] + cw[2][0] * xa[2] + cw[3][0] * ca;
                  const float o1 = cb1 + cw[0][1] * xb[0] + cw[1][1] * xb[1] + cw[2][1] * xb[2] + cw[3][1] * cbv;
                  *(LAS unsigned*)(sX + row * 136 + 2 * p2) = pk(o0, o1);
                  if (mine) { sXf[row * 33 + ((2 * p2) & 31)] = o0; sXf[row * 33 + ((2 * p2) & 31) + 1] = o1; }
                  xa[0] = xa[1]; xa[1] = xa[2]; xa[2] = ca; xb[0] = xb[1]; xb[1] = xb[2]; xb[2] = cbv; } }
            __syncthreads();
            { f32x16 acc = zero16(); const int rt = w & 3;
              if (w < 4) { mma32(acc, sX + 32 * rt * 136, 136, sWr, 136, 128, lane);
#pragma unroll
                  for (int reg = 0; reg < 16; ++reg) { const int row = 32 * rt + ROWMAP(reg, hh); const float la = c8 * sigmoidf_(acc[reg] + br); const float av = __expf(la); sA[row * 33 + r] = av; sM[row * 33 + r] = __builtin_amdgcn_sqrtf(fmaxf(1.f - av * av, 0.f)); } }
              else { mma32(acc, sX + 32 * rt * 136, 136, sWi, 136, 128, lane);
#pragma unroll
                  for (int reg = 0; reg < 16; ++reg) { const int row = 32 * rt + ROWMAP(reg, hh); sU[row * 33 + r] = sigmoidf_(acc[reg] + bi) * sXf[row * 33 + r]; } } }
            __syncthreads();
            { const int e = tid & 31, seg = tid >> 5; float A = 1.f, H = 0.f; float av[8], uv[8];
#pragma unroll
              for (int i = 0; i < 8; ++i) { const int t = seg * 8 + i; av[i] = sA[t * 33 + e]; uv[i] = sM[t * 33 + e] * sU[t * 33 + e]; H = av[i] * H + uv[i]; A *= av[i]; }
              sSeg[(seg * 32 + e) * 2] = A; sSeg[(seg * 32 + e) * 2 + 1] = H;
              __syncthreads();
              float hin = sCarry[e]; float sa_[15], sh_[15];
#pragma unroll
              for (int s2 = 0; s2 < 15; ++s2) { sa_[s2] = sSeg[(s2 * 32 + e) * 2]; sh_[s2] = sSeg[(s2 * 32 + e) * 2 + 1]; }
#pragma unroll
              for (int s2 = 0; s2 < 15; ++s2) hin = (s2 < seg) ? sa_[s2] * hin + sh_[s2] : hin;
#pragma unroll
              for (int i = 0; i < 8; ++i) { hin = av[i] * hin + uv[i]; const size_t t = t0 + seg * 8 + i;
                  const float y = bf2f(PROJ[t * LDP + 2048 + ch0 + e]); ON[t * 2048 + ch0 + e] = bf1(hin * gelu_tanh_(y)); }
              __syncthreads();
              if (seg == 15) sCarry[e] = hin; }
        }
        __syncthreads();
    }
}

#define XB_TMO      128
#define XB_XCNT(j)  (256  + 64 * (j))
#define XB_XSUB(j)  (1280 + 64 * (j))
#define XB_XGEN(j)  (2304 + 64 * (j))
#define XB_TOP      3328
#define XB_TOPGEN   3392
#define XCD_BAR_WORDS 3456
#define XB_SPIN_CAP (1u << 18)

__device__ __forceinline__ unsigned xb_ld(unsigned* p)              { return __hip_atomic_load(p, __ATOMIC_RELAXED, __HIP_MEMORY_SCOPE_AGENT); }
__device__ __forceinline__ unsigned xb_add(unsigned* p, unsigned v) { return __hip_atomic_fetch_add(p, v, __ATOMIC_RELAXED, __HIP_MEMORY_SCOPE_AGENT); }
__device__ __forceinline__ unsigned xb_xcc_id() { return (unsigned)__builtin_amdgcn_s_getreg((3 << 11) | 20) & 0xFu; }
#define XB_SPIN(cond, bar) do { unsigned _sp = 0; while (cond) { __builtin_amdgcn_s_sleep(1); \
    if ((++_sp & 255u) == 0u) { if (xb_ld(&(bar)[XB_TMO])) break; if (_sp > XB_SPIN_CAP) { atomicAdd(&(bar)[XB_TMO], 1u); break; } } } } while (0)

struct XcdBarrier {
    unsigned* bar; unsigned x;
    volatile LAS unsigned* st;
};

__device__ __forceinline__ XcdBarrier xcd_barrier_post(unsigned* bar, volatile LAS unsigned* st) {
    XcdBarrier b; b.bar = bar; b.x = xb_xcc_id(); b.st = st;
    if (threadIdx.x == 0) (void)xb_add(&bar[XB_XCNT(b.x)], 1u);
    return b;
}
__device__ __forceinline__ void xcd_barrier_complete(unsigned* bar, unsigned x, unsigned& nloc, unsigned& nx) {
    const unsigned G = gridDim.x * gridDim.y * gridDim.z;
    unsigned sum, cnt, mine, sp = 0u;
    for (;;) {
        sum = 0u; cnt = 0u; mine = 0u;
#pragma unroll
        for (unsigned j = 0; j < 16; ++j) { const unsigned c = xb_ld(&bar[XB_XCNT(j)]); sum += c; cnt += (c > 0u) ? 1u : 0u; mine = (j == x) ? c : mine; }
        if (sum == G) break;
        __builtin_amdgcn_s_sleep(1);
        if ((++sp & 255u) == 0u) { if (xb_ld(&bar[XB_TMO])) break; if (sp > XB_SPIN_CAP) { atomicAdd(&bar[XB_TMO], 1u); break; } }
    }
    nloc = mine > 0u ? mine : 1u; nx = cnt > 0u ? cnt : 1u;
}

__device__ __forceinline__ void xcd_barrier(const XcdBarrier& b) {
    asm volatile("s_waitcnt vmcnt(0)" ::: "memory");
    __syncthreads();
    if (threadIdx.x == 0) {
        unsigned* bar = b.bar;
        __builtin_amdgcn_s_waitcnt(0);
        unsigned nloc = b.st[0], nx = b.st[1];
        if (nloc == 0u) { xcd_barrier_complete(bar, b.x, nloc, nx); b.st[0] = nloc; b.st[1] = nx; }
        const unsigned old = xb_add(&bar[XB_XSUB(b.x)], 1u);
        const unsigned gen = old / nloc;
        if (old + 1u == (gen + 1u) * nloc) {
            __builtin_amdgcn_fence(__ATOMIC_RELEASE, "agent");
            asm volatile("s_waitcnt vmcnt(0)" ::: "memory");
            const unsigned og = xb_add(&bar[XB_TOP], 1u);
            const unsigned tg = og / nx;
            if (og + 1u == (tg + 1u) * nx) xb_add(&bar[XB_TOPGEN], 1u);
            else XB_SPIN(xb_ld(&bar[XB_TOPGEN]) == tg, bar);
            __builtin_amdgcn_fence(__ATOMIC_ACQUIRE, "agent");
            xb_add(&bar[XB_XGEN(b.x)], 1u);
            asm volatile("s_waitcnt vmcnt(0)" ::: "memory");
        } else {
            XB_SPIN(xb_ld(&bar[XB_XGEN(b.x)]) == gen, bar);
            __builtin_amdgcn_fence(__ATOMIC_ACQUIRE, "agent");
            asm volatile("s_waitcnt vmcnt(0)" ::: "memory");
        }
    }
    __syncthreads();
}

template <class Epi> __device__ __forceinline__ void run_gemm(LAS unsigned char* lds, const bf16_t* A, const bf16_t* Bt, int N, int K, const Epi& E) {
    pg8::Gemm g{A, Bt, T, N, K}; pg8::StaticOrder S; S.init(T, N, (int)gridDim.x, (int)blockIdx.x);
    pg8::gemm_phase<Epi, pg8::StaticOrder, true, true>(lds, g, S, E);
}
template <class Epi> __device__ __forceinline__ void run_gemm_rstd(LAS unsigned char* lds, const bf16_t* A, const bf16_t* Bt, int N, int K, const Epi& E, const float* RSS, LAS float* ldsr) {
    pg8::Gemm g{A, Bt, T, N, K}; pg8::RstdOrder S; S.init(T, N, (int)gridDim.x, (int)blockIdx.x); S.RSS = RSS; S.ldsr = ldsr; S.na = 0;
    pg8::gemm_phase<Epi, pg8::RstdOrder, true, true>(lds, g, S, E);
}
#define GRID_SYNC_CG() do { asm volatile("s_waitcnt vmcnt(0) lgkmcnt(0)" ::: "memory"); grid.sync(); \
    if (wave == 0) { __builtin_amdgcn_fence(__ATOMIC_ACQUIRE, "agent"); asm volatile("s_waitcnt vmcnt(0)" ::: "memory"); } \
    asm volatile("" ::: "memory"); __builtin_amdgcn_s_barrier(); asm volatile("" ::: "memory"); } while (0)
#define GRID_SYNC() xcd_barrier(xbar)
__global__ void __launch_bounds__(NTHR, 2) fwd_kernel(Params p) {
    extern __shared__ __attribute__((aligned(16))) unsigned char lds_raw[];
    LAS unsigned char* lds = (LAS unsigned char*)lds_raw;
    cg::grid_group grid = cg::this_grid();
    const int tid = threadIdx.x, lane = tid & 63, wave = __builtin_amdgcn_readfirstlane(tid >> 6);
    const int G = gridDim.x, bx = blockIdx.x, vcu = (G % 8 == 0) ? (bx % 8) * (G / 8) + bx / 8 : bx;
    const int gw = vcu * 8 + wave, NGW = G * 8;
    unsigned char* ws = p.ws;
    float* X = p.out;
    bf16_t* XN = (bf16_t*)(ws + OFF_XN); bf16_t* PROJ = (bf16_t*)(ws + OFF_PROJ); float* SM = (float*)(ws + OFF_SM);
    bf16_t* O = (bf16_t*)(ws + OFF_O); bf16_t* ON = (bf16_t*)(ws + OFF_ON);
    volatile LAS unsigned* xst = (volatile LAS unsigned*)(lds + LDS_BYTES - 64);
    if (tid == 0) { xst[0] = 0u; xst[1] = 0u; }
    __syncthreads();
    const XcdBarrier xbar = xcd_barrier_post((unsigned*)(ws + OFF_BAR), xst);

#define STAMP(id) do { } while (0)
    p0_phase(p, lds, gw, NGW, wave, lane);
    rmsnorm_phase(inptr<0>(), inptr<1>(), XN, nullptr, nullptr, gw, NGW, lane);
    GRID_SYNC_CG(); STAMP(0);
    for (int hb = 0; hb < HBMAX; ++hb) {
        const int L = hb >> 1, half = hb & 1;
        int tq = tid; asm volatile("" : "+v"(tq)); const int lane = tq & 63;
        {
            const bf16_t* Bt; int N; pg8::EpiBf E; E.O = PROJ; E.SM = SM; E.slo = 0; E.shi = 0; E.relu2 = half;
            if (half) { Bt = (const bf16_t*)(ws + OFF_WT_UP + L * SZ_L); N = FF; }
            else if (L == 0) { Bt = (const bf16_t*)(ws + OFF_WT_RET_IN); N = NP_RET; }
            else if (L == 1) { Bt = (const bf16_t*)(ws + OFF_WT_GDN_IN); N = NP_GDN; E.slo = 8192; E.shi = 8224; }
            else if (L == 2) { Bt = (const bf16_t*)(ws + OFF_WT_GLA_IN); N = NP_GLA; E.slo = 6144; E.shi = 6160; }
            else { Bt = (const bf16_t*)(ws + OFF_WT_LRU_IN); N = NP_LRU; }
            E.ldo = N; E.ldsr = (const LAS float*)(lds + 131072); E.ne = 0;
#if PH_GEMM
            run_gemm_rstd(lds, XN, Bt, N, D, E, (const float*)(ws + OFF_RSS), (LAS float*)(lds + 131072));
#endif
        }
        GRID_SYNC(); STAMP(1);
        int K2 = FF;
        if (!half) {
            K2 = D;
            if (L == 0) {
#if PH_RET
                ret_pre_phase(lds, PROJ, (const float*)(ws + OFF_ROPE), (const float*)(ws + OFF_ROPE) + 2048 * 128, (bf16_t*)(ws + OFF_GQ), (bf16_t*)(ws + OFF_GKE), (bf16_t*)(ws + OFF_GU), vcu, G, tid);
                GRID_SYNC(); STAMP(13);
                ret_scan_phase(lds, PROJ, (const bf16_t*)(ws + OFF_GQ), (const bf16_t*)(ws + OFF_GKE), (const bf16_t*)(ws + OFF_GU), O, ws, vcu, G, tid);
#endif
                GRID_SYNC(); STAMP(2);
                hn512_phase<true>(O, 4096, 8, inptr<5>(), PROJ, NP_RET, 8192, ON, gw, NGW, lane);
                K2 = 4096;
            } else if (L == 1) {
#if PH_GDN
                gdn_prep_phase(lds, PROJ, SM, inptr<8>(), inptr<9>(), inptr<10>(), (bf16_t*)(ws + OFF_GQ), (bf16_t*)(ws + OFF_GKE), (bf16_t*)(ws + OFF_GU), (bf16_t*)(ws + OFF_GW), (float*)(ws + OFF_GG), vcu, G, tid);
#endif
                GRID_SYNC(); STAMP(4);
#if PH_GDN2
                gdn_scan_phase(lds, (const bf16_t*)(ws + OFF_GQ), (const bf16_t*)(ws + OFF_GKE), (const bf16_t*)(ws + OFF_GU), (const bf16_t*)(ws + OFF_GW), (const float*)(ws + OFF_GG), O, ws, vcu, G, tid);
#endif
                GRID_SYNC(); STAMP(5);
                gdn_hn_phase(O, inptr<11>(), PROJ, ON, gw, NGW, lane);
            } else if (L == 2) {
#if PH_GLA
                gla_pre_phase(lds, PROJ, SM, inptr<14>(), inptr<15>(), (bf16_t*)(ws + OFF_GQ), (bf16_t*)(ws + OFF_GKE), (bf16_t*)(ws + OFF_GU), (float*)(ws + OFF_GW), vcu, G, tid);
                GRID_SYNC(); STAMP(12);
                gla_scan_phase(lds, PROJ, (const bf16_t*)(ws + OFF_GQ), (const bf16_t*)(ws + OFF_GKE), (const bf16_t*)(ws + OFF_GU), (const float*)(ws + OFF_GW), O, vcu, G, tid);
#endif
                GRID_SYNC(); STAMP(7);
                hn512_phase<false>(O, 2048, 4, inptr<16>(), PROJ, NP_GLA, 4096, ON, gw, NGW, lane);
            } else {
#if PH_LRU
                lru_phase(lds, PROJ, inptr<19>(), inptr<20>(), (const bf16_t*)(ws + OFF_WT_LRU_GR), (const bf16_t*)(ws + OFF_WT_LRU_GI), inptr<22>(), inptr<24>(), inptr<25>(), ON, vcu, G, tid);
#endif
            }
            GRID_SYNC(); STAMP((L == 0 ? 3 : L == 1 ? 6 : L == 2 ? 8 : 9));
        }
        {
            const bf16_t* A2 = half ? PROJ : ON; const bf16_t* Bt;
            if (half) Bt = (const bf16_t*)(ws + OFF_WT_DOWN + L * SZ_L);
            else Bt = (const bf16_t*)(ws + (L == 0 ? OFF_WT_RET_OUT : L == 1 ? OFF_WT_GDN_OUT : L == 2 ? OFF_WT_GLA_OUT : OFF_WT_LRU_OUT));
            pg8::EpiRes E; E.X = X; E.Xr = (hb == 0) ? inptr<0>() : (const float*)X; E.ldx = D; E.XG = XN; E.RSS = (float*)(ws + OFF_RSS);
            E.g = (hb == HBMAX - 1) ? inptr<3>() : (half ? inptr<1>() + (L + 1) * D : inptr<2>() + L * D);
#if PH_GEMM
            run_gemm(lds, A2, Bt, D, K2, E);
#endif
        }
        GRID_SYNC(); STAMP(10);
        if (hb == HBMAX - 1) { rmsnorm_phase(X, inptr<3>(), nullptr, nullptr, X, gw, NGW, lane); GRID_SYNC(); STAMP(11); }
    }

}

extern "C" void kernel_launch(void* const* d_in, const int* in_sizes, int n_in, void* d_out, int out_size, void* d_ws, size_t ws_size, hipStream_t stream) {
    static int grid_blocks = 0;
    if (!grid_blocks) {
        int dev = 0, cus = 0, per_cu = 0;
        hipGetDevice(&dev);
        hipDeviceGetAttribute(&cus, hipDeviceAttributeMultiprocessorCount, dev);
        hipFuncSetAttribute((const void*)fwd_kernel, hipFuncAttributeMaxDynamicSharedMemorySize, LDS_BYTES);
        hipOccupancyMaxActiveBlocksPerMultiprocessor(&per_cu, (const void*)fwd_kernel, NTHR, LDS_BYTES);
        if (per_cu < 1) { fprintf(stderr, "kernel_launch: occupancy query says %d blocks/CU\n", per_cu); per_cu = 1; }
        grid_blocks = cus * 1;
        if (ws_size < WS_END) fprintf(stderr, "kernel_launch: workspace too small: %zu < %zu\n", ws_size, (size_t)WS_END);
        if (n_in != 29) fprintf(stderr, "kernel_launch: expected 29 inputs, got %d\n", n_in);
    }
    Params p{};
    for (int i = 0; i < 29; ++i) p.in[i] = (const float*)d_in[i];
    p.out = (float*)d_out; p.ws = (unsigned char*)d_ws;
    (void)hipMemsetAsync((unsigned char*)d_ws + OFF_BAR, 0, XCD_BAR_WORDS * 4, stream);
    void* args[] = {&p};
    hipError_t e = hipLaunchCooperativeKernel((const void*)fwd_kernel, dim3(grid_blocks), dim3(NTHR), args, LDS_BYTES, stream);
    if (e != hipSuccess) fprintf(stderr, "cooperative launch failed: %s (grid %d)\n", hipGetErrorString(e), grid_blocks);
}
```

```cpp
#include <hip/hip_runtime.h>
#include <hip/hip_cooperative_groups.h>
#include <cstdio>
#include <cstdint>
namespace cg = cooperative_groups;
#ifndef PH_RET
#define PH_RET 1
#endif
#ifndef PH_GDN
#define PH_GDN 1
#endif
#ifndef PH_GDN2
#define PH_GDN2 1
#endif
#ifndef PH_GLA
#define PH_GLA 1
#endif
#ifndef PH_LRU
#define PH_LRU 1
#endif
#ifndef PH_GEMM
#define PH_GEMM 1
#endif
#ifndef HBMAX
#define HBMAX 8
#endif
namespace pg8 {
#define PG8_LAS __attribute__((address_space(3)))
typedef unsigned short bf16_t;
typedef short bf16x8 __attribute__((ext_vector_type(8)));
typedef float f32x4 __attribute__((ext_vector_type(4)));
typedef unsigned u32x4 __attribute__((ext_vector_type(4)));
constexpr int BM = 256, BK = 64, HALF = 128, HTB = HALF * BK * 2  , STAGE_BYTES = 8 * HTB, NXCD = 8, WGM = 4;

__host__ __device__ __forceinline__ int lds_byte(int r, int c) { const int st = (r >> 4) * 2 + (c >> 5), rr = r & 15, cc = c & 31, ob = rr * 64 + cc * 2; return st * 1024 + (ob ^ (((ob >> 9) & 1) << 5)); }
__host__ __device__ __forceinline__ void stage_rc(int b, int& R, int& C) { const int st = b / 1024, sb = b % 1024, swz = sb ^ (((sb >> 9) & 1) << 5); R = (st >> 1) * 16 + swz / 64; C = (st & 1) * 32 + (swz % 64) / 2; }
__host__ __device__ __forceinline__ int perm32(int rho) { const int n = rho >> 4, i = rho & 15; return 8 * (i >> 2) + 4 * n + (i & 3); }

struct Unit { int pm, pn; };
struct Gemm { const bf16_t* A; const bf16_t* Bt; int M, N, K; };

struct StaticOrder {
    int nM, nN, nwg, G, c;
    __host__ __device__ void init(int M, int N, int G_, int c_) { nM = M / BM; nN = N / BM; nwg = nM * nN; G = G_; c = c_; }
    __host__ __device__ bool next(int i, Unit& u) const {
        const long L = (long)i * G + c; if (L >= nwg) return false;
        int wgid = (int)L; { const int q = nwg / NXCD, r = nwg % NXCD, xcd = wgid % NXCD, off = wgid / NXCD; wgid = (xcd < r ? xcd * (q + 1) : r * (q + 1) + (xcd - r) * q) + off; }
        const int nig = WGM * nN, gid = wgid / nig, fm = gid * WGM, gsz = (nM - fm) < WGM ? (nM - fm) : WGM;
        u.pm = fm + ((wgid % nig) % gsz); u.pn = (wgid % nig) / gsz; return true;
    }
    __device__ __forceinline__ void a_ready(const Unit&) const {}
    __device__ __forceinline__ void done(const Unit&) const {}
    __device__ __forceinline__ void a_finish() const {}
};
typedef __bf16 hwbf16x2 __attribute__((ext_vector_type(2)));
typedef float cvtf32x2 __attribute__((ext_vector_type(2)));
__device__ __forceinline__ unsigned cvt_pk_bf16(float lo, float hi) { cvtf32x2 v; v.x = lo; v.y = hi; hwbf16x2 b = __builtin_convertvector(v, hwbf16x2); return __builtin_bit_cast(unsigned, b); }
template <class Epi, class Sched, bool ALIGN_EPI = false, bool SP2 = false>
__device__ __forceinline__ void gemm_phase(PG8_LAS unsigned char* lds, const Gemm g, const Sched& S, const Epi& E) {
    int tid = threadIdx.x; asm volatile("" : "+v"(tid)); const int wid = __builtin_amdgcn_readfirstlane(tid >> 6), lane = tid & 63, wr = wid >> 2, wc = wid & 3, fr = lane & 15, fq = lane >> 4;
    const int K = g.K, nt = K / BK;
    unsigned voffA[2], voffB[2];
#pragma unroll
    for (int i = 0; i < 2; ++i) { int R, C; stage_rc(tid * 16 + i * 8192, R, C); const int Rb = Epi::PERM ? ((R & ~31) + perm32(R & 31)) : R;
        voffA[i] = (unsigned)(R * K + C) * 2u; voffB[i] = (unsigned)(Rb * K + C) * 2u; }
    const size_t kstep = (size_t)(BK * 2);
    const size_t hstep = (size_t)HALF * K * 2;
    const size_t tstep = 2 * hstep;
    const unsigned ldsw = (unsigned)wid * 1024u;
    const int aoff = lds_byte(wr * 64 + fr, fq * 8), boff = lds_byte(wc * 32 + fr, fq * 8);
#define PG8_SA(b, h) (((b) * 2 + (h)) * HTB)
#define PG8_SB(b, h) ((4 + (b) * 2 + (h)) * HTB)
#define PG8_STAGE(bufoff, gbase, voff) do { _Pragma("unroll") for (int _i = 0; _i < 2; ++_i) \
        __builtin_amdgcn_global_load_lds((const unsigned*)((const char*)(gbase) + (voff)[_i]), (PG8_LAS unsigned*)(lds + (bufoff) + ldsw + _i * 8192), 16, 0, 0); } while (0)
#define PG8_LDA(dst, b, h) do { _Pragma("unroll") for (int m = 0; m < 4; ++m) _Pragma("unroll") for (int k = 0; k < 2; ++k) dst[m][k] = *(const PG8_LAS bf16x8*)(lds + PG8_SA(b, h) + aoff + m * 2048 + k * 1024); } while (0)
#define PG8_LDB(dst, b, h) do { _Pragma("unroll") for (int n = 0; n < 2; ++n) _Pragma("unroll") for (int k = 0; k < 2; ++k) dst[n][k] = *(const PG8_LAS bf16x8*)(lds + PG8_SB(b, h) + boff + n * 2048 + k * 1024); } while (0)
#define PG8_MMA(ai, bj, At, Bt) do { __builtin_amdgcn_s_setprio(1); _Pragma("unroll") for (int m = 0; m < 4; ++m) _Pragma("unroll") for (int n = 0; n < 2; ++n) _Pragma("unroll") for (int k = 0; k < 2; ++k) \
        acc[ai][bj][m][n] = __builtin_amdgcn_mfma_f32_16x16x32_bf16(Bt[n][k], At[m][k], acc[ai][bj][m][n], 0, 0, 0); __builtin_amdgcn_s_setprio(0); } while (0)
#define PG8_WAIT_V(n) asm volatile("s_waitcnt vmcnt(" #n ")" ::: "memory")
#define PG8_WAIT_L(n) asm volatile("s_waitcnt lgkmcnt(" #n ")" ::: "memory")
#define PG8_BAR __builtin_amdgcn_s_barrier()
#define PG8_SCHED __builtin_amdgcn_sched_barrier(0)
    Unit cur, nxt; int ui = 0;
    if (!S.next(0, cur)) return;
    f32x4 acc[2][2][4][2];
#pragma unroll
    for (int a = 0; a < 2; ++a)
#pragma unroll
        for (int b = 0; b < 2; ++b)
#pragma unroll
            for (int m = 0; m < 4; ++m)
#pragma unroll
                for (int n = 0; n < 2; ++n) acc[a][b][m][n] = (f32x4){0.f, 0.f, 0.f, 0.f};
    bf16x8 At[4][2], B0[2][2], B1[2][2];
    const char* cA = (const char*)g.A + (size_t)cur.pm * tstep; const char* cB = (const char*)g.Bt + (size_t)cur.pn * tstep;
    S.a_ready(cur); S.a_finish();
    if constexpr (SP2) {
        PG8_STAGE(PG8_SB(0, 0), cB, voffB); PG8_STAGE(PG8_SB(0, 1), cB + hstep, voffB); PG8_STAGE(PG8_SA(0, 0), cA, voffA); PG8_STAGE(PG8_SA(0, 1), cA + hstep, voffA);
        if (wr == 1) PG8_BAR;
        PG8_WAIT_V(2); PG8_BAR;
        PG8_STAGE(PG8_SB(1, 0), cB + kstep, voffB); PG8_STAGE(PG8_SA(1, 0), cA + kstep, voffA); PG8_STAGE(PG8_SB(1, 1), cB + hstep + kstep, voffB);
        PG8_WAIT_V(6); PG8_BAR;
    } else {
        PG8_STAGE(PG8_SB(0, 0), cB, voffB); PG8_STAGE(PG8_SA(0, 0), cA, voffA); PG8_STAGE(PG8_SB(0, 1), cB + hstep, voffB); PG8_STAGE(PG8_SA(0, 1), cA + hstep, voffA);
        if (wr == 1) PG8_BAR;
        PG8_WAIT_V(4); PG8_BAR;
        PG8_STAGE(PG8_SB(1, 0), cB + kstep, voffB); PG8_STAGE(PG8_SA(1, 0), cA + kstep, voffA); PG8_STAGE(PG8_SB(1, 1), cB + hstep + kstep, voffB);
        PG8_WAIT_V(6); PG8_BAR;
    }
    for (;;) {
        const bool has_next = S.next(ui + 1, nxt);
        const char* nA = has_next ? (const char*)g.A + (size_t)nxt.pm * tstep : cA; const char* nB = has_next ? (const char*)g.Bt + (size_t)nxt.pn * tstep : cB;
        for (int t = 0; t < nt; t += 2) {
            const bool last = (t == nt - 2);
            const char* a1 = cA + (size_t)(t + 1) * kstep;
            const char* a2 = last ? nA : cA + (size_t)(t + 2) * kstep; const char* b2 = last ? nB : cB + (size_t)(t + 2) * kstep;
            const char* a3 = a2 + kstep; const char* b3 = b2 + kstep;
            if (last && has_next) S.a_ready(nxt);
            if constexpr (SP2) {
            PG8_LDB(B0, 0, 0); PG8_LDB(B1, 0, 1); PG8_SCHED; PG8_LDA(At, 0, 0); PG8_STAGE(PG8_SA(1, 1), a1 + hstep, voffA);
            PG8_WAIT_V(8); PG8_WAIT_L(0); PG8_BAR; PG8_MMA(0, 0, At, B0); PG8_MMA(0, 1, At, B1); PG8_BAR; PG8_SCHED;
            PG8_LDA(At, 0, 1); PG8_STAGE(PG8_SB(0, 0), b2, voffB); PG8_STAGE(PG8_SB(0, 1), b2 + hstep, voffB); PG8_STAGE(PG8_SA(0, 0), a2, voffA);
            PG8_WAIT_V(8); PG8_WAIT_L(0); PG8_BAR; PG8_MMA(1, 0, At, B0); PG8_MMA(1, 1, At, B1); PG8_BAR; PG8_SCHED;
            PG8_LDB(B0, 1, 0); PG8_LDB(B1, 1, 1); PG8_SCHED; PG8_LDA(At, 1, 0); PG8_STAGE(PG8_SA(0, 1), a2 + hstep, voffA);
            PG8_WAIT_V(8); PG8_WAIT_L(0); PG8_BAR; PG8_MMA(0, 0, At, B0); PG8_MMA(0, 1, At, B1); PG8_BAR; PG8_SCHED;
            PG8_LDA(At, 1, 1); PG8_STAGE(PG8_SB(1, 0), b3, voffB); PG8_STAGE(PG8_SB(1, 1), b3 + hstep, voffB); PG8_STAGE(PG8_SA(1, 0), a3, voffA);
            PG8_WAIT_V(8); PG8_WAIT_L(0); PG8_BAR; PG8_MMA(1, 0, At, B0); PG8_MMA(1, 1, At, B1); PG8_BAR; PG8_SCHED;
            if (last && has_next) S.a_finish();
            } else {
            PG8_LDB(B0, 0, 0); PG8_SCHED; PG8_LDA(At, 0, 0); PG8_STAGE(PG8_SA(1, 1), a1 + hstep, voffA);
            PG8_WAIT_L(8); PG8_BAR; PG8_WAIT_L(0); PG8_MMA(0, 0, At, B0); PG8_BAR; PG8_SCHED;
            PG8_LDB(B1, 0, 1); PG8_STAGE(PG8_SB(0, 0), b2, voffB);
            PG8_BAR; PG8_WAIT_L(0); PG8_MMA(0, 1, At, B1); PG8_BAR;
            PG8_LDA(At, 0, 1); PG8_STAGE(PG8_SA(0, 0), a2, voffA);
            PG8_BAR; PG8_WAIT_L(0); PG8_MMA(1, 0, At, B0); PG8_BAR; PG8_SCHED;
            PG8_STAGE(PG8_SB(0, 1), b2 + hstep, voffB);
            PG8_WAIT_V(6); PG8_BAR; PG8_MMA(1, 1, At, B1); PG8_BAR;
            PG8_LDB(B0, 1, 0); PG8_SCHED; PG8_LDA(At, 1, 0); PG8_STAGE(PG8_SA(0, 1), a2 + hstep, voffA);
            PG8_WAIT_L(8); PG8_BAR; PG8_WAIT_L(0); PG8_MMA(0, 0, At, B0); PG8_BAR; PG8_SCHED;
            PG8_LDB(B1, 1, 1); PG8_STAGE(PG8_SB(1, 0), b3, voffB);
            PG8_BAR; PG8_WAIT_L(0); PG8_MMA(0, 1, At, B1); PG8_BAR;
            PG8_LDA(At, 1, 1); PG8_STAGE(PG8_SA(1, 0), a3, voffA);
            PG8_BAR; PG8_WAIT_L(0); PG8_MMA(1, 0, At, B0); PG8_BAR; PG8_SCHED;
            PG8_STAGE(PG8_SB(1, 1), b3 + hstep, voffB);
            PG8_WAIT_V(6); PG8_BAR; PG8_MMA(1, 1, At, B1); PG8_BAR;
            }
        }
        if constexpr (ALIGN_EPI) { if (wr == 0) PG8_BAR; }
        if constexpr (!Epi::AFTER_DRAIN) { E(acc, cur, wr, wc, fr, fq); S.done(cur); }
        if (!has_next) break;
#pragma unroll
        for (int a = 0; a < 2; ++a)
#pragma unroll
            for (int b = 0; b < 2; ++b)
#pragma unroll
                for (int m = 0; m < 4; ++m)
#pragma unroll
                    for (int n = 0; n < 2; ++n) acc[a][b][m][n] = (f32x4){0.f, 0.f, 0.f, 0.f};
        cur = nxt; cA = nA; cB = nB; ++ui;
        if constexpr (ALIGN_EPI) { if (wr == 1) PG8_BAR; }
    }
    PG8_WAIT_V(0);
    if constexpr (!ALIGN_EPI) { if (wr == 0) PG8_BAR; }
    PG8_BAR;
    if constexpr (Epi::AFTER_DRAIN) { E.fused(acc, cur, wr, wc, fr, fq, lds, wid, lane); S.done(cur); }
#undef PG8_SA
#undef PG8_SB
#undef PG8_STAGE
#undef PG8_LDA
#undef PG8_LDB
#undef PG8_MMA
#undef PG8_WAIT_V
#undef PG8_WAIT_L
#undef PG8_BAR
#undef PG8_SCHED
}

typedef unsigned u32x2 __attribute__((ext_vector_type(2)));
struct EpiBf {
    static constexpr bool PERM = true, AFTER_DRAIN = false;
    bf16_t* O; int ldo; float* SM; int slo, shi, relu2;
    const PG8_LAS float* ldsr; mutable int ne;
    __device__ __forceinline__ void operator()(const f32x4 (&acc)[2][2][4][2], const Unit& u, int wr, int wc, int fr, int fq) const {
        const int row0 = u.pm * BM + wr * 64 + fr, col0 = u.pn * BM + wc * 32 + 8 * fq;
        const PG8_LAS float* rsl = ldsr + (ne & 1) * 256 + wr * 64 + fr; ++ne;
#pragma unroll
        for (int ai = 0; ai < 2; ++ai)
#pragma unroll
            for (int m = 0; m < 4; ++m) { const size_t row = (size_t)(row0 + ai * HALF + m * 16); const float rs = rsl[ai * HALF + m * 16];
#pragma unroll
                for (int bj = 0; bj < 2; ++bj) { const int col = col0 + bj * HALF; f32x4 v0 = acc[ai][bj][m][0] * rs, v1 = acc[ai][bj][m][1] * rs;
                    if (relu2) { v0[0] = fmaxf(v0[0], 0.f); v0[1] = fmaxf(v0[1], 0.f); v0[2] = fmaxf(v0[2], 0.f); v0[3] = fmaxf(v0[3], 0.f); v0 = v0 * v0;
                                 v1[0] = fmaxf(v1[0], 0.f); v1[1] = fmaxf(v1[1], 0.f); v1[2] = fmaxf(v1[2], 0.f); v1[3] = fmaxf(v1[3], 0.f); v1 = v1 * v1; }
                    u32x4 o; o.x = cvt_pk_bf16(v0[0], v0[1]); o.y = cvt_pk_bf16(v0[2], v0[3]); o.z = cvt_pk_bf16(v1[0], v1[1]); o.w = cvt_pk_bf16(v1[2], v1[3]);
                    *(u32x4*)(O + row * ldo + col) = o;
                    if (col >= slo && col < shi) { *(f32x4*)(SM + row * 32 + (col - slo)) = v0; *(f32x4*)(SM + row * 32 + (col - slo) + 4) = v1; } } }
    }
};
struct EpiRes {
    static constexpr bool PERM = true, AFTER_DRAIN = false;
    float* X; const float* Xr; int ldx; bf16_t* XG; const float* g; float* RSS;
    __device__ __forceinline__ void operator()(const f32x4 (&acc)[2][2][4][2], const Unit& u, int wr, int wc, int fr, int fq) const {
        const int row0 = u.pm * BM + wr * 64 + fr, col0 = u.pn * BM + wc * 32 + 8 * fq;
        f32x4 gv[2][2];
#pragma unroll
        for (int bj = 0; bj < 2; ++bj)
#pragma unroll
            for (int n = 0; n < 2; ++n) gv[bj][n] = *(const f32x4*)(g + col0 + bj * HALF + 4 * n);
#pragma unroll
        for (int ai = 0; ai < 2; ++ai)
#pragma unroll
            for (int m = 0; m < 4; ++m) { const size_t row = (size_t)(row0 + ai * HALF + m * 16); float* rowp = X + row * ldx + col0; const float* rowr = Xr + row * ldx + col0; bf16_t* gp = XG + row * ldx + col0; float ss = 0.f;
#pragma unroll
                for (int bj = 0; bj < 2; ++bj) { f32x4* p = (f32x4*)(rowp + bj * HALF); const f32x4* pr = (const f32x4*)(rowr + bj * HALF);
                    const f32x4 x0 = pr[0] + acc[ai][bj][m][0], x1 = pr[1] + acc[ai][bj][m][1]; p[0] = x0; p[1] = x1;
                    ss += ((x0[0] * x0[0] + x0[1] * x0[1]) + (x0[2] * x0[2] + x0[3] * x0[3])) + ((x1[0] * x1[0] + x1[1] * x1[1]) + (x1[2] * x1[2] + x1[3] * x1[3]));
                    const f32x4 y0 = x0 * gv[bj][0], y1 = x1 * gv[bj][1];
                    u32x4 o; o.x = cvt_pk_bf16(y0[0], y0[1]); o.y = cvt_pk_bf16(y0[2], y0[3]); o.z = cvt_pk_bf16(y1[0], y1[1]); o.w = cvt_pk_bf16(y1[2], y1[3]); *(u32x4*)(gp + bj * HALF) = o; }
                ss += __shfl_xor(ss, 16); ss += __shfl_xor(ss, 32);
                if (fq == 0) RSS[row * 32 + u.pn * 4 + wc] = ss; }
    }
};
struct RstdOrder : StaticOrder {
    const float* RSS; PG8_LAS float* ldsr; mutable int na; mutable f32x4 ra, rb, rc, rd;
    __device__ __forceinline__ void a_ready(const Unit& u) const {
        int tid = threadIdx.x; asm volatile("" : "+v"(tid));
        const int rowl = (tid >> 6) * 32 + ((tid & 63) >> 1), half = tid & 1;
        const f32x4* p = (const f32x4*)(RSS + (size_t)(u.pm * BM + rowl) * 32 + 16 * half);
        ra = p[0]; rb = p[1]; rc = p[2]; rd = p[3];
    }
    __device__ __forceinline__ void a_finish() const {
        int tid = threadIdx.x; asm volatile("" : "+v"(tid));
        const int rowl = (tid >> 6) * 32 + ((tid & 63) >> 1), half = tid & 1;
        const f32x4 a = ra, b = rb, c = rc, d = rd;
        float s = (((a[0] + a[1]) + (a[2] + a[3])) + ((b[0] + b[1]) + (b[2] + b[3]))) + (((c[0] + c[1]) + (c[2] + c[3])) + ((d[0] + d[1]) + (d[2] + d[3])));
        s += __shfl_xor(s, 1);
        if (half == 0) ldsr[(na & 1) * 256 + rowl] = rsqrtf(s * (1.f / 2048.f) + 1e-6f);
        ++na;
    }
};
}

#define LAS __attribute__((address_space(3)))
typedef unsigned short bf16_t;
typedef short bf16x8 __attribute__((ext_vector_type(8)));
typedef float f32x4 __attribute__((ext_vector_type(4)));
typedef float f32x16 __attribute__((ext_vector_type(16)));
typedef unsigned u32x4 __attribute__((ext_vector_type(4)));
typedef unsigned u32x2 __attribute__((ext_vector_type(2)));

constexpr int T = 8192, D = 2048, FF = 8192, NTHR = 512;
constexpr int LDS_BYTES = 163840;
constexpr int NP_RET = 12288, NP_GDN = 8448, NP_GLA = 6400, NP_LRU = 4096;
constexpr size_t SZ_L = 33554432ull;
constexpr size_t OFF_WT_RET_IN = 0;
constexpr size_t OFF_WT_RET_OUT = OFF_WT_RET_IN + (size_t)NP_RET * D * 2;
constexpr size_t OFF_WT_GDN_IN = OFF_WT_RET_OUT + (size_t)D * 4096 * 2;
constexpr size_t OFF_WT_GDN_OUT = OFF_WT_GDN_IN + (size_t)NP_GDN * D * 2;
constexpr size_t OFF_WT_GLA_IN = OFF_WT_GDN_OUT + (size_t)D * D * 2;
constexpr size_t OFF_WT_GLA_OUT = OFF_WT_GLA_IN + (size_t)NP_GLA * D * 2;
constexpr size_t OFF_WT_LRU_IN = OFF_WT_GLA_OUT + (size_t)D * D * 2;
constexpr size_t OFF_WT_LRU_OUT = OFF_WT_LRU_IN + (size_t)NP_LRU * D * 2;
constexpr size_t OFF_WT_LRU_GR = OFF_WT_LRU_OUT + (size_t)D * D * 2;
constexpr size_t OFF_WT_LRU_GI = OFF_WT_LRU_GR + 16ull * 128 * 128 * 2;
constexpr size_t OFF_WT_UP = OFF_WT_LRU_GI + 16ull * 128 * 128 * 2;
constexpr size_t OFF_WT_DOWN = OFF_WT_UP + 4 * SZ_L;
constexpr size_t OFF_ROPE = OFF_WT_DOWN + 4 * SZ_L;
constexpr size_t OFF_XN = OFF_ROPE + 2ull * 2048 * 128 * 4;
constexpr size_t OFF_PROJ = OFF_XN + SZ_L;
constexpr size_t OFF_SM = OFF_PROJ + (size_t)T * NP_RET * 2;
constexpr size_t OFF_O = OFF_SM + (size_t)T * 32 * 4;
constexpr size_t OFF_ON = OFF_O + (size_t)T * 4096 * 4;
constexpr size_t OFF_GQ = OFF_ON + (size_t)T * 4096 * 2;
constexpr size_t OFF_GKE = OFF_GQ + SZ_L;
constexpr size_t OFF_GU = OFF_GKE + SZ_L;
constexpr size_t OFF_GW = OFF_GU + SZ_L;
constexpr size_t OFF_GG = OFF_GW + SZ_L;
constexpr size_t OFF_BAR = OFF_GG + 2048 * 4;
constexpr size_t OFF_RSS = OFF_BAR + 16384;
constexpr size_t WS_END = OFF_RSS + (size_t)T * 32 * 4;

__constant__ float LOGG[8] = {-0.0317486983145803f, -0.015748356968139168f, -0.007843177461025893f, -0.003913899321136329f,
                              -0.0019550348358033506f, -0.0009770396478266127f, -0.0004884004981088745f, -0.0002441704321739145f};

#define LDS_WAIT() asm volatile("s_waitcnt lgkmcnt(0)" ::: "memory")
__device__ __forceinline__ unsigned pk(float lo, float hi) { return pg8::cvt_pk_bf16(lo, hi); }
__device__ __forceinline__ bf16_t bf1(float v) { return (bf16_t)(pg8::cvt_pk_bf16(v, 0.f) & 0xffffu); }
__device__ __forceinline__ float bflo(unsigned v) { return __uint_as_float(v << 16); }
__device__ __forceinline__ float bfhi(unsigned v) { return __uint_as_float(v & 0xffff0000u); }
__device__ __forceinline__ float bf2f(bf16_t b) { return __uint_as_float(((unsigned)b) << 16); }
__device__ __forceinline__ float wave_sum(float v) {
#pragma unroll
    for (int o = 1; o < 64; o <<= 1) v += __shfl_xor(v, o);
    return v;
}
__device__ __forceinline__ float sigmoidf_(float x) { return __builtin_amdgcn_rcpf(1.f + __expf(-x)); }
__device__ __forceinline__ float siluf_(float x) { return x * __builtin_amdgcn_rcpf(1.f + __expf(-x)); }
#define ROWMAP(reg, hh) (((reg) & 3) + 8 * ((reg) >> 2) + 4 * (hh))

__device__ __forceinline__ void mma32(f32x16& acc, const LAS bf16_t* A, int lda, const LAS bf16_t* B, int ldb, int K, int lane) {
    const int r = lane & 31, h = lane >> 5;
    const LAS bf16_t* pa = A + r * lda + 8 * h; const LAS bf16_t* pb = B + r * ldb + 8 * h;
#pragma unroll 4
    for (int k = 0; k < K; k += 16) {
        const bf16x8 a = *(const LAS bf16x8*)(pa + k), b = *(const LAS bf16x8*)(pb + k);
        acc = __builtin_amdgcn_mfma_f32_32x32x16_bf16(a, b, acc, 0, 0, 0);
    }
}
__device__ __forceinline__ void mma32d(f32x16& acc, const LAS bf16_t* A, int lda, const LAS bf16_t* B, int ldb, int K, int lane) {
    const int r = lane & 31, h = lane >> 5;
    const LAS bf16_t* pa = A + r * lda + 8 * h; const LAS bf16_t* pb = B + r * ldb + 8 * h;
    f32x16 acc1;
#pragma unroll
    for (int i = 0; i < 16; ++i) acc1[i] = 0.f;
#pragma unroll 2
    for (int k = 0; k < K; k += 32) {
        const bf16x8 a0 = *(const LAS bf16x8*)(pa + k), b0 = *(const LAS bf16x8*)(pb + k), a1 = *(const LAS bf16x8*)(pa + k + 16), b1 = *(const LAS bf16x8*)(pb + k + 16);
        acc = __builtin_amdgcn_mfma_f32_32x32x16_bf16(a0, b0, acc, 0, 0, 0);
        acc1 = __builtin_amdgcn_mfma_f32_32x32x16_bf16(a1, b1, acc1, 0, 0, 0);
    }
    acc = acc + acc1;
}
__device__ __forceinline__ f32x16 zero16() { f32x16 z;
#pragma unroll
    for (int i = 0; i < 16; ++i) z[i] = 0.f; return z; }

struct Params { const float* in[29]; float* out; unsigned char* ws; };
template <int I> __device__ __forceinline__ const float* inptr() {
    const unsigned long long ka = (unsigned long long)__builtin_amdgcn_kernarg_segment_ptr();
    unsigned long long v;
    asm volatile("s_load_dwordx2 %0, %1, %2\n\ts_waitcnt lgkmcnt(0)" : "=&s"(v) : "s"(ka), "n"(I * 8) : "memory");
    return (const float*)(const __attribute__((address_space(1))) float*)v;
}

struct TDesc { const float* W; bf16_t* WT; int K, N, nblk, item; };
__device__ __forceinline__ void t_load(const TDesc& d, int lane, f32x4 (&v)[8]) {
    const int kb = d.item / d.nblk, nb = d.item - kb * d.nblk, k0 = 64 * kb, n0 = 32 * nb;
    const int n = n0 + 4 * (lane & 7); const bool ok = n < d.N;
#pragma unroll
    for (int i = 0; i < 8; ++i) { const int kk = 8 * i + (lane >> 3); v[i] = ok ? *(const f32x4*)(d.W + (size_t)(k0 + kk) * d.N + n) : (f32x4){0.f, 0.f, 0.f, 0.f}; }
}
__device__ __forceinline__ void t_store(const TDesc& d, LAS float* scr, int lane, const f32x4 (&v)[8]) {
    const int kb = d.item / d.nblk, nb = d.item - kb * d.nblk, k0 = 64 * kb, n0 = 32 * nb;
#pragma unroll
    for (int i = 0; i < 8; ++i) { const int kk = 8 * i + (lane >> 3); LAS float* q = scr + kk * 33 + 4 * (lane & 7); q[0] = v[i][0]; q[1] = v[i][1]; q[2] = v[i][2]; q[3] = v[i][3]; }
    LDS_WAIT();
    const int c = lane & 7;
#pragma unroll
    for (int j = 0; j < 4; ++j) { const int nn = (lane >> 3) + 8 * j; const LAS float* s = scr + (8 * c) * 33 + nn;
        u32x4 o; o.x = pk(s[0 * 33], s[1 * 33]); o.y = pk(s[2 * 33], s[3 * 33]); o.z = pk(s[4 * 33], s[5 * 33]); o.w = pk(s[6 * 33], s[7 * 33]);
        *(u32x4*)(d.WT + (size_t)(n0 + nn) * d.K + k0 + 8 * c) = o; }
    LDS_WAIT();
}
constexpr int I_RET_IN = (D / 64) * (NP_RET / 32), I_RET_OUT = (4096 / 64) * (D / 32), I_GDN_IN = (D / 64) * (NP_GDN / 32), I_SQ = (D / 64) * (D / 32),
              I_GLA_IN = (D / 64) * (NP_GLA / 32), I_LRU_IN = (D / 64) * (NP_LRU / 32), I_G = 16 * 8, I_UP = (D / 64) * (FF / 32), I_DN = (FF / 64) * (D / 32);
constexpr int NITEMS_A = I_RET_IN;
constexpr int NITEMS_C = I_GDN_IN + I_SQ + 2 * I_UP + 2 * I_DN + I_RET_OUT;
constexpr int NITEMS_B = I_GLA_IN + I_SQ + I_LRU_IN + I_SQ + 2 * I_G + 2 * I_UP + 2 * I_DN;
__device__ __forceinline__ TDesc p0_desc_a(unsigned char* ws, int it) {
    return TDesc{inptr<4>(), (bf16_t*)(ws + OFF_WT_RET_IN), D, 12288, NP_RET / 32, it};
}
__device__ __forceinline__ TDesc p0_desc_c(unsigned char* ws, int it) {
    int r = it;
    if (r < I_RET_OUT) return TDesc{inptr<6>(), (bf16_t*)(ws + OFF_WT_RET_OUT), 4096, D, D / 32, r}; r -= I_RET_OUT;
    if (r < 2 * I_UP) { const int l = r / I_UP; return TDesc{inptr<27>() + (size_t)l * D * FF, (bf16_t*)(ws + OFF_WT_UP + l * SZ_L), D, FF, FF / 32, r - l * I_UP}; } r -= 2 * I_UP;
    if (r < 2 * I_DN) { const int l = r / I_DN; return TDesc{inptr<28>() + (size_t)l * D * FF, (bf16_t*)(ws + OFF_WT_DOWN + l * SZ_L), FF, D, D / 32, r - l * I_DN}; } r -= 2 * I_DN;
    if (r < I_GDN_IN) return TDesc{inptr<7>(), (bf16_t*)(ws + OFF_WT_GDN_IN), D, 8224, NP_GDN / 32, r}; r -= I_GDN_IN;
    return TDesc{inptr<12>(), (bf16_t*)(ws + OFF_WT_GDN_OUT), D, D, D / 32, r};
}
__device__ __forceinline__ TDesc p0_desc_b(unsigned char* ws, int it) {
    int r = it;
    if (r < I_GLA_IN) return TDesc{inptr<13>(), (bf16_t*)(ws + OFF_WT_GLA_IN), D, 6160, NP_GLA / 32, r}; r -= I_GLA_IN;
    if (r < I_SQ) return TDesc{inptr<17>(), (bf16_t*)(ws + OFF_WT_GLA_OUT), D, D, D / 32, r}; r -= I_SQ;
    if (r < I_LRU_IN) return TDesc{inptr<18>(), (bf16_t*)(ws + OFF_WT_LRU_IN), D, 4096, NP_LRU / 32, r}; r -= I_LRU_IN;
    if (r < I_SQ) return TDesc{inptr<26>(), (bf16_t*)(ws + OFF_WT_LRU_OUT), D, D, D / 32, r}; r -= I_SQ;
    if (r < I_G) { const int blk = r >> 3; return TDesc{inptr<21>() + blk * 16384, (bf16_t*)(ws + OFF_WT_LRU_GR) + blk * 16384, 128, 128, 4, r & 7}; } r -= I_G;
    if (r < I_G) { const int blk = r >> 3; return TDesc{inptr<23>() + blk * 16384, (bf16_t*)(ws + OFF_WT_LRU_GI) + blk * 16384, 128, 128, 4, r & 7}; } r -= I_G;
    if (r < 2 * I_UP) { const int l = 2 + r / I_UP; return TDesc{inptr<27>() + (size_t)l * D * FF, (bf16_t*)(ws + OFF_WT_UP + l * SZ_L), D, FF, FF / 32, r - (l - 2) * I_UP}; } r -= 2 * I_UP;
    { const int l = 2 + r / I_DN; return TDesc{inptr<28>() + (size_t)l * D * FF, (bf16_t*)(ws + OFF_WT_DOWN + l * SZ_L), FF, D, D / 32, r - (l - 2) * I_DN}; }
}
__device__ __forceinline__ void p0_phase(const Params& p, LAS unsigned char* lds, int gw, int NGW, int wave, int lane) {
    LAS float* scr = (LAS float*)(lds + wave * 16384);
    unsigned char* ws = p.ws;
    constexpr int NITEMS = NITEMS_A;
#define p0_desc p0_desc_a
    if (gw < NITEMS) { int it = gw; TDesc d = p0_desc(ws, it); f32x4 v[8]; t_load(d, lane, v);
        for (;;) { const int itn = it + NGW; const bool more = itn < NITEMS; TDesc dn = d; f32x4 vn[8];
            if (more) { dn = p0_desc(ws, itn); t_load(dn, lane, vn); }
            t_store(d, scr, lane, v);
            if (!more) break;
            d = dn; it = itn;
#pragma unroll
            for (int i = 0; i < 8; ++i) v[i] = vn[i]; } }
#undef p0_desc
    { float* rss = (float*)(ws + OFF_RSS); for (int i = gw * 64 + lane; i < T * 32; i += NGW * 64) rss[i] = ((i & 31) == 0) ? 2047.997952f : 0.f; }
    float* rc = (float*)(ws + OFF_ROPE); float* rs = rc + 2048 * 128;
    for (int idx = gw * 64 + lane; idx < 2048 * 128; idx += NGW * 64) {
        const int s = idx >> 7, i = idx & 127;
        double inv = 1.0, bs = 0.9305720409296989792906463164991; int e = i;
#pragma unroll
        for (int b = 0; b < 7; ++b) { if (e & 1) inv *= bs; bs *= bs; e >>= 1; }
        const float angf = (float)s * (float)inv;
        const double a = (double)angf; const double q = __builtin_rint(a * 0.63661977236758134308);
        const double x = (a - q * 1.5707963267948965580) - q * 6.123233995736766e-17;
        const double x2 = x * x;
        const double sn = x * (1.0 + x2 * (-1.0 / 6 + x2 * (1.0 / 120 + x2 * (-1.0 / 5040 + x2 * (1.0 / 362880 + x2 * (-1.0 / 39916800 + x2 * (1.0 / 6227020800.0)))))));
        const double cs = 1.0 + x2 * (-0.5 + x2 * (1.0 / 24 + x2 * (-1.0 / 720 + x2 * (1.0 / 40320 + x2 * (-1.0 / 3628800 + x2 * (1.0 / 479001600.0))))));
        const int qi = ((int)q) & 3;
        const double co = (qi == 0) ? cs : (qi == 1) ? -sn : (qi == 2) ? -cs : sn;
        const double si = (qi == 0) ? sn : (qi == 1) ? cs : (qi == 2) ? -sn : -cs;
        rc[idx] = (float)co; rs[idx] = (float)si;
    }
}
__device__ __forceinline__ void rmsnorm_phase(const float* X, const float* g, bf16_t* XN, float* Xcopy, float* OutF, int gw, int NGW, int lane) {
    f32x4 gg[8];
#pragma unroll
    for (int j = 0; j < 8; ++j) gg[j] = ((const f32x4*)g)[lane + 64 * j];
    for (int m = gw; m < T; m += 2 * NGW) {
        const int m1 = (m + NGW < T) ? m + NGW : m;
        const f32x4* xr0 = (const f32x4*)(X + (size_t)m * D) + lane; const f32x4* xr1 = (const f32x4*)(X + (size_t)m1 * D) + lane;
        f32x4 v0[8], v1[8]; float s0 = 0.f, s1 = 0.f;
#pragma unroll
        for (int j = 0; j < 8; ++j) { v0[j] = xr0[64 * j]; v1[j] = xr1[64 * j]; }
#pragma unroll
        for (int j = 0; j < 8; ++j) { s0 += (v0[j][0] * v0[j][0] + v0[j][1] * v0[j][1]) + (v0[j][2] * v0[j][2] + v0[j][3] * v0[j][3]);
                                      s1 += (v1[j][0] * v1[j][0] + v1[j][1] * v1[j][1]) + (v1[j][2] * v1[j][2] + v1[j][3] * v1[j][3]); }
#pragma unroll
        for (int o = 1; o < 64; o <<= 1) { s0 += __shfl_xor(s0, o); s1 += __shfl_xor(s1, o); }
        const float rs0 = rsqrtf(s0 * (1.f / D) + 1e-6f), rs1 = rsqrtf(s1 * (1.f / D) + 1e-6f);
#pragma unroll
        for (int j = 0; j < 8; ++j) { const f32x4 y0 = v0[j] * rs0 * gg[j], y1 = v1[j] * rs1 * gg[j];
            if (XN) { u32x2 o; o.x = pk(y0[0], y0[1]); o.y = pk(y0[2], y0[3]); *(u32x2*)(XN + (size_t)m * D + 4 * lane + 256 * j) = o;
                      o.x = pk(y1[0], y1[1]); o.y = pk(y1[2], y1[3]); *(u32x2*)(XN + (size_t)m1 * D + 4 * lane + 256 * j) = o; }
            if (Xcopy) { ((f32x4*)(Xcopy + (size_t)m * D))[lane + 64 * j] = v0[j]; ((f32x4*)(Xcopy + (size_t)m1 * D))[lane + 64 * j] = v1[j]; }
            if (OutF) { ((f32x4*)(OutF + (size_t)m * D))[lane + 64 * j] = y0; ((f32x4*)(OutF + (size_t)m1 * D))[lane + 64 * j] = y1; } }
    }
}
#define LBAR() do { asm volatile("s_waitcnt lgkmcnt(0)" ::: "memory"); __builtin_amdgcn_s_barrier(); asm volatile("" ::: "memory"); } while (0)

__device__ __forceinline__ void ret_pre_phase(LAS unsigned char* lds, const bf16_t* __restrict__ PROJ, const float* __restrict__ ropeC, const float* __restrict__ ropeS,
                                              bf16_t* __restrict__ GQR, bf16_t* __restrict__ GKT, bf16_t* __restrict__ GS, int vcu, int G, int tid_in) {
    constexpr int LDP = NP_RET;
    LAS bf16_t* sQ = (LAS bf16_t*)lds;
    LAS bf16_t* sK = sQ + 64 * 264;
    LAS bf16_t* sKT = sK + 64 * 264;
    LAS bf16_t* sS = sKT + 256 * 72;
    for (int u = vcu; u < 1024; u += G) {
        int tid = tid_in; asm volatile("" : "+v"(tid)); const int lane = tid & 63, w = __builtin_amdgcn_readfirstlane(tid >> 6), r = lane & 31, hh = lane >> 5;
        const int bh = u >> 5, n = u & 31, b = bh >> 3, h = bh & 7, t0 = b * 2048 + n * 64, s0 = n * 64;
        const float lg = LOGG[h];
#pragma unroll
        for (int it = 0; it < 2; ++it) {
            const int idx = tid + it * 512, c = idx >> 4, g = idx & 15;
            const bf16_t* qrow = PROJ + (size_t)(t0 + c) * LDP + h * 256 + 8 * g;
            const u32x4 q1 = *(const u32x4*)qrow, q2 = *(const u32x4*)(qrow + 128), k1 = *(const u32x4*)(qrow + 2048), k2 = *(const u32x4*)(qrow + 2048 + 128);
            const float* cp = ropeC + (size_t)(s0 + c) * 128 + 8 * g; const float* sp = ropeS + (size_t)(s0 + c) * 128 + 8 * g;
            const f32x4 c0 = *(const f32x4*)cp, c1 = *(const f32x4*)(cp + 4), n0 = *(const f32x4*)sp, n1 = *(const f32x4*)(sp + 4);
            u32x4 oq1, oq2, ok1, ok2;
#pragma unroll
            for (int e = 0; e < 4; ++e) {
                const float ca = (e < 2) ? c0[2 * e] : c1[2 * e - 4], cb = (e < 2) ? c0[2 * e + 1] : c1[2 * e - 3];
                const float sa = (e < 2) ? n0[2 * e] : n1[2 * e - 4], sb = (e < 2) ? n0[2 * e + 1] : n1[2 * e - 3];
                const float x1a = bflo(q1[e]), x1b = bfhi(q1[e]), x2a = bflo(q2[e]), x2b = bfhi(q2[e]);
                oq1[e] = pk(x1a * ca - x2a * sa, x1b * cb - x2b * sb); oq2[e] = pk(x1a * sa + x2a * ca, x1b * sb + x2b * cb);
                const float y1a = bflo(k1[e]) * 0.0625f, y1b = bfhi(k1[e]) * 0.0625f, y2a = bflo(k2[e]) * 0.0625f, y2b = bfhi(k2[e]) * 0.0625f;
                ok1[e] = pk(y1a * ca - y2a * sa, y1b * cb - y2b * sb); ok2[e] = pk(y1a * sa + y2a * ca, y1b * sb + y2b * cb);
            }
            *(LAS u32x4*)(sQ + c * 264 + 8 * g) = oq1; *(LAS u32x4*)(sQ + c * 264 + 128 + 8 * g) = oq2;
            *(LAS u32x4*)(sK + c * 264 + 8 * g) = ok1; *(LAS u32x4*)(sK + c * 264 + 128 + 8 * g) = ok2;
            *(u32x4*)(GQR + ((size_t)u * 64 + c) * 256 + 8 * g) = oq1; *(u32x4*)(GQR + ((size_t)u * 64 + c) * 256 + 128 + 8 * g) = oq2;
        }
        LBAR();
#pragma unroll
        for (int it = 0; it < 4; ++it) { const int idx = tid + it * 512, d = idx & 255, c0 = (idx >> 8) * 8; u32x4 o;
#pragma unroll
            for (int e = 0; e < 4; ++e) { const float a = bf2f(sK[(c0 + 2 * e) * 264 + d]) * __expf(lg * (float)(63 - (c0 + 2 * e)));
                const float bb = bf2f(sK[(c0 + 2 * e + 1) * 264 + d]) * __expf(lg * (float)(62 - (c0 + 2 * e))); o[e] = pk(a, bb); }
            *(LAS u32x4*)(sKT + d * 72 + c0) = o; }
        if (w < 4) { const int ci = w >> 1, xi = w & 1; f32x16 acc = zero16();
            mma32(acc, sQ + 32 * ci * 264, 264, sK + 32 * xi * 264, 264, 256, lane);
#pragma unroll
            for (int reg = 0; reg < 16; ++reg) { const int c = 32 * ci + ROWMAP(reg, hh), m = 32 * xi + r; const int dd = c > m ? c - m : m - c;
                sS[c * 72 + m] = bf1(acc[reg] * __expf(lg * (float)dd)); } }
        LBAR();
#pragma unroll
        for (int it = 0; it < 4; ++it) { const int idx = tid + it * 512, d = idx >> 3, g = idx & 7; *(u32x4*)(GKT + ((size_t)u * 256 + d) * 64 + 8 * g) = *(const LAS u32x4*)(sKT + d * 72 + 8 * g); }
        *(u32x4*)(GS + ((size_t)u * 64 + (tid >> 3)) * 64 + 8 * (tid & 7)) = *(const LAS u32x4*)(sS + (tid >> 3) * 72 + 8 * (tid & 7));
        LBAR();
    }
}
__device__ __forceinline__ void ret_scan_phase(LAS unsigned char* lds, const bf16_t* __restrict__ PROJ, const bf16_t* __restrict__ GQR, const bf16_t* __restrict__ GKT,
                                               const bf16_t* __restrict__ GS, bf16_t* __restrict__ O, unsigned char* ws, int vcu, int G, int tid_in) {
    constexpr int LDP = NP_RET;
    const int wq = __builtin_amdgcn_readfirstlane(tid_in >> 6);
    int bj = vcu * 4 + wq; const int bstride = G * 4;
    TDesc bd0 = TDesc{nullptr, nullptr, 0, 0, 1, 0}; f32x4 bv0[8]; bool bh0 = false;
    LAS float* bscr = (LAS float*)(lds + 122880 + (wq & 3) * 8704);
#define BG_ISSUE(dd, vv_, hh_) do { if (bj < NITEMS_C) { dd = p0_desc_c(ws, bj); t_load(dd, blane, vv_); hh_ = true; bj += bstride; } else hh_ = false; } while (0)
#define BG_STEP(dd, vv_, hh_) do { if (hh_) { t_store(dd, bscr, blane, vv_); BG_ISSUE(dd, vv_, hh_); } } while (0)
    if (wq < 4) { int blane = tid_in & 63; asm volatile("" : "+v"(blane)); BG_ISSUE(bd0, bv0, bh0); }
    LAS bf16_t* sQ = (LAS bf16_t*)lds;
    LAS bf16_t* sKT = sQ + 64 * 264;
    LAS bf16_t* sVT = sKT + 256 * 72;
    LAS bf16_t* sS = sVT + 64 * 72;
    LAS bf16_t* sST = sS + 64 * 72;
    for (int u = vcu; u < 256; u += G) {
        const int bh = u >> 3, jv = u & 7, b = bh >> 3, h = bh & 7;
        const float lg = LOGG[h], cdec = __expf(lg * 64.f);
        f32x16 S0 = zero16(), S1 = zero16();
        u32x4 rQ[4], rK[4], rS, rvv;
#define RET_PREFETCH(nn) do { const size_t chn = (size_t)bh * 32 + (nn); const int t0p = b * 2048 + (nn) * 64; \
            _Pragma("unroll") for (int it = 0; it < 4; ++it) { const int idx = tidp + it * 512; \
                rQ[it] = *(const u32x4*)(GQR + (chn * 64 + (idx >> 5)) * 256 + 8 * (idx & 31)); rK[it] = *(const u32x4*)(GKT + (chn * 256 + (idx >> 3)) * 64 + 8 * (idx & 7)); } \
            rS = *(const u32x4*)(GS + (chn * 64 + (tidp >> 3)) * 64 + 8 * (tidp & 7)); \
            rvv = *(const u32x4*)(PROJ + (size_t)(t0p + (tidp >> 3)) * LDP + 4096 + h * 512 + jv * 64 + 8 * (tidp & 7)); } while (0)
        { int tidp = tid_in; asm volatile("" : "+v"(tidp)); RET_PREFETCH(0); }
        for (int n = 0; n < 32; ++n) {
            int tid = tid_in; asm volatile("" : "+v"(tid)); const int lane = tid & 63, w = __builtin_amdgcn_readfirstlane(tid >> 6), r = lane & 31, hh = lane >> 5;
            const int t0 = b * 2048 + n * 64;
#pragma unroll
            for (int it = 0; it < 4; ++it) { const int idx = tid + it * 512; *(LAS u32x4*)(sQ + (idx >> 5) * 264 + 8 * (idx & 31)) = rQ[it]; *(LAS u32x4*)(sKT + (idx >> 3) * 72 + 8 * (idx & 7)) = rK[it]; }
            *(LAS u32x4*)(sS + (tid >> 3) * 72 + 8 * (tid & 7)) = rS;
            { const int c = tid >> 3, g = tid & 7;
#pragma unroll
              for (int e = 0; e < 4; ++e) { sVT[(8 * g + 2 * e) * 72 + c] = (bf16_t)(rvv[e] & 0xffffu); sVT[(8 * g + 2 * e + 1) * 72 + c] = (bf16_t)(rvv[e] >> 16); } }
            if (n == 0) {
#pragma unroll
                for (int g4 = 0; g4 < 4; ++g4) { const int dk = 32 * w + 8 * g4 + 4 * hh; u32x2 a; a.x = 0u; a.y = 0u; *(LAS u32x2*)(sST + r * 264 + dk) = a; *(LAS u32x2*)(sST + (32 + r) * 264 + dk) = a; } }
            LBAR();
            if (n < 31) { const int tidp = tid; RET_PREFETCH(n + 1); }
            if (w < 4) { const int blane = lane; BG_STEP(bd0, bv0, bh0); }
            if (w >= 4) { const int ci = (w - 4) >> 1, xi = (w - 4) & 1; f32x16 acc = zero16();
                mma32(acc, sQ + 32 * ci * 264, 264, sST + 32 * xi * 264, 264, 256, lane);
#pragma unroll
                for (int reg = 0; reg < 16; ++reg) { const int c = 32 * ci + ROWMAP(reg, hh); acc[reg] *= __expf(lg * (float)(c + 1)); }
                mma32(acc, sS + 32 * ci * 72, 72, sVT + 32 * xi * 72, 72, 64, lane);
#pragma unroll
                for (int reg = 0; reg < 16; ++reg) { const int c = 32 * ci + ROWMAP(reg, hh); O[(size_t)(t0 + c) * 4096 + h * 512 + jv * 64 + 32 * xi + r] = bf1(acc[reg]); } }
            { f32x16 u0 = S0 * cdec, u1 = S1 * cdec;
              mma32(u0, sKT + 32 * w * 72, 72, sVT, 72, 64, lane); mma32(u1, sKT + 32 * w * 72, 72, sVT + 32 * 72, 72, 64, lane); S0 = u0; S1 = u1; }
            LBAR();
#pragma unroll
            for (int g4 = 0; g4 < 4; ++g4) { const int dk = 32 * w + 8 * g4 + 4 * hh; u32x2 a, c2;
                a.x = pk(S0[4 * g4], S0[4 * g4 + 1]); a.y = pk(S0[4 * g4 + 2], S0[4 * g4 + 3]); c2.x = pk(S1[4 * g4], S1[4 * g4 + 1]); c2.y = pk(S1[4 * g4 + 2], S1[4 * g4 + 3]);
                *(LAS u32x2*)(sST + r * 264 + dk) = a; *(LAS u32x2*)(sST + (32 + r) * 264 + dk) = c2; }
            if (w < 4) { const int blane = lane; BG_STEP(bd0, bv0, bh0); }
        }
#undef RET_PREFETCH
        LBAR();
    }
    if (wq < 4) { int blane = tid_in & 63; asm volatile("" : "+v"(blane)); while (bh0) { BG_STEP(bd0, bv0, bh0); } }
#undef BG_ISSUE
#undef BG_STEP
}
template <bool CENTER>
__device__ __forceinline__ void hn512_phase(const bf16_t* __restrict__ O, int ldo, int H, const float* __restrict__ gain, const bf16_t* __restrict__ PROJ, int ldp, int gcol0,
                                            bf16_t* __restrict__ ON, int gw, int NGW, int lane) {
    const int NI = T * H;
    for (int it0 = gw; it0 < NI; it0 += 4 * NGW) {
        f32x4 v[4][2], gg[4][2]; u32x4 gt[4]; int tt[4], hx[4];
#pragma unroll
        for (int q = 0; q < 4; ++q) { int it = it0 + q * NGW; if (it >= NI) it = it0;
            const int t = it / H, h = it - t * H; tt[q] = t; hx[q] = h; const int col = h * 512 + 8 * lane;
            const u32x4 a = *(const u32x4*)(O + (size_t)t * ldo + col);
            v[q][0] = (f32x4){bflo(a.x), bfhi(a.x), bflo(a.y), bfhi(a.y)}; v[q][1] = (f32x4){bflo(a.z), bfhi(a.z), bflo(a.w), bfhi(a.w)};
            gg[q][0] = *(const f32x4*)(gain + col); gg[q][1] = *(const f32x4*)(gain + col + 4); gt[q] = *(const u32x4*)(PROJ + (size_t)t * ldp + gcol0 + col); }
        float rs[4];
        if (CENTER) { float mean[4];
#pragma unroll
            for (int q = 0; q < 4; ++q) mean[q] = (v[q][0][0] + v[q][0][1]) + (v[q][0][2] + v[q][0][3]) + (v[q][1][0] + v[q][1][1]) + (v[q][1][2] + v[q][1][3]);
#pragma unroll
            for (int o = 1; o < 64; o <<= 1) {
#pragma unroll
                for (int q = 0; q < 4; ++q) mean[q] += __shfl_xor(mean[q], o); }
#pragma unroll
            for (int q = 0; q < 4; ++q) { const float mu = mean[q] * (1.f / 512.f); v[q][0] = v[q][0] - mu; v[q][1] = v[q][1] - mu; } }
#pragma unroll
        for (int q = 0; q < 4; ++q) rs[q] = (v[q][0][0] * v[q][0][0] + v[q][0][1] * v[q][0][1]) + (v[q][0][2] * v[q][0][2] + v[q][0][3] * v[q][0][3]) + (v[q][1][0] * v[q][1][0] + v[q][1][1] * v[q][1][1]) + (v[q][1][2] * v[q][1][2] + v[q][1][3] * v[q][1][3]);
#pragma unroll
        for (int o = 1; o < 64; o <<= 1) {
#pragma unroll
            for (int q = 0; q < 4; ++q) rs[q] += __shfl_xor(rs[q], o); }
#pragma unroll
        for (int q = 0; q < 4; ++q) { const float r1 = rsqrtf(rs[q] * (1.f / 512.f) + 1e-6f); const int col = hx[q] * 512 + 8 * lane; const u32x4 gq = gt[q]; const f32x4 g0 = gg[q][0], g1 = gg[q][1];
            u32x4 o; o.x = pk(v[q][0][0] * r1 * g0[0] * siluf_(bflo(gq.x)), v[q][0][1] * r1 * g0[1] * siluf_(bfhi(gq.x)));
            o.y = pk(v[q][0][2] * r1 * g0[2] * siluf_(bflo(gq.y)), v[q][0][3] * r1 * g0[3] * siluf_(bfhi(gq.y)));
            o.z = pk(v[q][1][0] * r1 * g1[0] * siluf_(bflo(gq.z)), v[q][1][1] * r1 * g1[1] * siluf_(bfhi(gq.z)));
            o.w = pk(v[q][1][2] * r1 * g1[2] * siluf_(bflo(gq.w)), v[q][1][3] * r1 * g1[3] * siluf_(bfhi(gq.w)));
            *(u32x4*)(ON + (size_t)tt[q] * ldo + col) = o; }
    }
}

__device__ __forceinline__ void gdn_prep_phase(LAS unsigned char* lds, const bf16_t* __restrict__ PROJ, const float* __restrict__ SM, const float* __restrict__ conv_w,
                                               const float* __restrict__ a_log, const float* __restrict__ dt_bias, bf16_t* __restrict__ GQ, bf16_t* __restrict__ GKE,
                                               bf16_t* __restrict__ GU, bf16_t* __restrict__ GW, float* __restrict__ GG, int vcu, int G, int tid_in) {
    constexpr int LDP = NP_GDN;
    LAS float* sSol = (LAS float*)lds;
    LAS float* sA = sSol + 64 * 257;
    LAS float* sBeta = sA + 64 * 68;
    LAS float* sCum = sBeta + 64;
    LAS bf16_t* sKb = (LAS bf16_t*)(sCum + 64);
    LAS bf16_t* sRaw = sKb + 64 * 136;
    for (int u = vcu; u < 2048; u += G) {
        int tid = tid_in; asm volatile("" : "+v"(tid)); const int lane = tid & 63, w = __builtin_amdgcn_readfirstlane(tid >> 6), r = lane & 31, hh = lane >> 5;
        const int b = u >> 9, h = (u >> 5) & 15, n = u & 31;
        const int t0 = b * 2048 + n * 64, s0 = n * 64;
        u32x4 raw[3];
#define GDN_PREFETCH(ten) do { _Pragma("unroll") for (int it = 0; it < 3; ++it) { const int idx = tid + it * 512, rr = idx >> 4, g = idx & 15; raw[it] = (u32x4){0u, 0u, 0u, 0u}; \
            if (idx < 67 * 16 && s0 - 3 + rr >= 0) raw[it] = *(const u32x4*)(PROJ + (size_t)(t0 - 3 + rr) * LDP + (ten) * 2048 + h * 128 + 8 * g); } } while (0)
        GDN_PREFETCH(0);
        float cw[3][4][2];
#pragma unroll
        for (int ten = 0; ten < 3; ++ten)
#pragma unroll
            for (int tap = 0; tap < 4; ++tap) { const float* cp = conv_w + tap * 6144 + ten * 2048 + h * 128 + 2 * lane; cw[ten][tap][0] = cp[0]; cw[ten][tap][1] = cp[1]; }
        if (tid < 64) {
            const float bl = SM[(size_t)(t0 + tid) * 32 + h], al = SM[(size_t)(t0 + tid) * 32 + 16 + h];
            const float x = al + dt_bias[h];
            const float sp = (x > 20.f) ? x : log1pf(__expf(x));
            float la = -__expf(a_log[h]) * sp;
#pragma unroll
            for (int o = 1; o < 64; o <<= 1) { const float y = __shfl_up(la, o); if (lane >= o) la += y; }
            sBeta[tid] = sigmoidf_(bl); sCum[tid] = la;
        }
#pragma unroll
        for (int ten = 0; ten < 3; ++ten) {
#pragma unroll
            for (int it = 0; it < 3; ++it) { const int idx = tid + it * 512, rr = idx >> 4, g = idx & 15; if (idx < 67 * 16) *(LAS u32x4*)(sRaw + rr * 136 + 8 * g) = raw[it]; }
            LBAR();
            if (ten == 0) GDN_PREFETCH(1);
            if (ten == 1) GDN_PREFETCH(2);
            const float cumL = sCum[63];
            float a0[8], a1[8], ss[8];
#pragma unroll
            for (int rr = 0; rr < 8; ++rr) { const int c = w + 8 * rr; float x0 = 0.f, x1 = 0.f;
#pragma unroll
                for (int tap = 0; tap < 4; ++tap) { const unsigned xv = *(const LAS unsigned*)(sRaw + (c + tap) * 136 + 2 * lane); x0 += bflo(xv) * cw[ten][tap][0]; x1 += bfhi(xv) * cw[ten][tap][1]; }
                a0[rr] = siluf_(x0); a1[rr] = siluf_(x1); ss[rr] = a0[rr] * a0[rr] + a1[rr] * a1[rr]; }
            if (ten != 2) {
#pragma unroll
                for (int o = 1; o < 64; o <<= 1) {
#pragma unroll
                    for (int rr = 0; rr < 8; ++rr) ss[rr] += __shfl_xor(ss[rr], o); } }
#pragma unroll
            for (int rr = 0; rr < 8; ++rr) { const int c = w + 8 * rr; const float beta = sBeta[c], cum = sCum[c];
                if (ten == 2) { sSol[c * 257 + 2 * lane] = beta * a0[rr]; sSol[c * 257 + 2 * lane + 1] = beta * a1[rr]; }
                else { float rn = rsqrtf(ss[rr] + 1e-6f);
                    if (ten == 0) { rn *= 0.08838834764831845f; *(unsigned*)(GQ + ((size_t)u * 64 + c) * 128 + 2 * lane) = pk(a0[rr] * rn, a1[rr] * rn); }
                    else { const float k0 = a0[rr] * rn, k1 = a1[rr] * rn; *(LAS unsigned*)(sKb + c * 136 + 2 * lane) = pk(k0, k1);
                        const float f = beta * __expf(cum); sSol[c * 257 + 128 + 2 * lane] = f * k0; sSol[c * 257 + 128 + 2 * lane + 1] = f * k1;
                        const float e = __expf(cumL - cum); *(unsigned*)(GKE + ((size_t)u * 64 + c) * 128 + 2 * lane) = pk(k0 * e, k1 * e); } } }
            LBAR();
        }
#undef GDN_PREFETCH
        const float cumL = sCum[63];
        if (w < 4) { const int ci = w >> 1, mi = w & 1; f32x16 acc = zero16();
            mma32(acc, sKb + 32 * ci * 136, 136, sKb + 32 * mi * 136, 136, 128, lane);
#pragma unroll
            for (int reg = 0; reg < 16; ++reg) { const int c = 32 * ci + ROWMAP(reg, hh), m = 32 * mi + r;
                sA[c * 68 + m] = (c > m) ? sBeta[c] * __expf(sCum[c] - sCum[m]) * acc[reg] : 0.f; } }
        LBAR();
        { const int j = tid & 255, pp = tid >> 8;
          for (int kb = 0; kb < 8; ++kb) { const int c0 = 8 * kb + 4 * pp; float a[4];
#pragma unroll
              for (int q = 0; q < 4; ++q) a[q] = sSol[(c0 + q) * 257 + j];
              for (int m = 0; m < 8 * kb; m += 4) { float sv[4];
#pragma unroll
                  for (int q = 0; q < 4; ++q) sv[q] = sSol[(m + q) * 257 + j];
#pragma unroll
                  for (int q = 0; q < 4; ++q) { const f32x4 A = *(const LAS f32x4*)(sA + (c0 + q) * 68 + m); a[q] -= (A[0] * sv[0] + A[1] * sv[1]) + (A[2] * sv[2] + A[3] * sv[3]); } }
              if (pp == 1) LBAR();
              if (pp == 1) { float sv[4];
#pragma unroll
                  for (int q = 0; q < 4; ++q) sv[q] = sSol[(8 * kb + q) * 257 + j];
#pragma unroll
                  for (int q = 0; q < 4; ++q) { const f32x4 A = *(const LAS f32x4*)(sA + (c0 + q) * 68 + 8 * kb); a[q] -= (A[0] * sv[0] + A[1] * sv[1]) + (A[2] * sv[2] + A[3] * sv[3]); } }
              { const f32x4 D1 = *(const LAS f32x4*)(sA + (c0 + 1) * 68 + c0), D2 = *(const LAS f32x4*)(sA + (c0 + 2) * 68 + c0), D3 = *(const LAS f32x4*)(sA + (c0 + 3) * 68 + c0);
                a[1] -= D1[0] * a[0]; a[2] -= D2[0] * a[0] + D2[1] * a[1]; a[3] -= D3[0] * a[0] + D3[1] * a[1] + D3[2] * a[2]; }
#pragma unroll
              for (int q = 0; q < 4; ++q) sSol[(c0 + q) * 257 + j] = a[q];
              if (pp == 0) LBAR();
              LBAR(); } }
#pragma unroll 4
        for (int it = 0; it < 16; ++it) { const int idx = tid + it * 512, c = idx >> 7, p2 = idx & 127; const unsigned o = pk(sSol[c * 257 + 2 * p2], sSol[c * 257 + 2 * p2 + 1]);
            if (p2 < 64) *(unsigned*)(GU + ((size_t)u * 64 + c) * 128 + 2 * p2) = o; else *(unsigned*)(GW + ((size_t)u * 64 + c) * 128 + 2 * p2 - 128) = o; }
        if (tid == 0) GG[u] = __expf(cumL);
        LBAR();
    }
}
__device__ __forceinline__ void gdn_scan_phase(LAS unsigned char* lds, const bf16_t* __restrict__ GQ, const bf16_t* __restrict__ GKE, const bf16_t* __restrict__ GU,
                                               const bf16_t* __restrict__ GW, const float* __restrict__ GG, bf16_t* __restrict__ O, unsigned char* ws, int vcu, int G, int tid_in) {
    const int wq = __builtin_amdgcn_readfirstlane(tid_in >> 6);
    int bj = vcu * 4 + (wq - 4); const int bstride = G * 4;
    TDesc bd0 = TDesc{nullptr, nullptr, 0, 0, 1, 0}, bd1 = bd0; f32x4 bv0[8], bv1[8]; bool bh0 = false, bh1 = false;
    LAS float* bscr = (LAS float*)(lds + 81920 + (wq & 3) * 8704);
#define BG_ISSUE(dd, vv_, hh_) do { if (bj < NITEMS_B) { dd = p0_desc_b(ws, bj); t_load(dd, blane, vv_); hh_ = true; bj += bstride; } else hh_ = false; } while (0)
#define BG_STEP(dd, vv_, hh_) do { if (hh_) { t_store(dd, bscr, blane, vv_); BG_ISSUE(dd, vv_, hh_); } } while (0)
    if (wq >= 4) { int blane = tid_in & 63; asm volatile("" : "+v"(blane)); BG_ISSUE(bd0, bv0, bh0); BG_ISSUE(bd1, bv1, bh1); }
    LAS bf16_t* sW = (LAS bf16_t*)lds;
    LAS bf16_t* sQ = sW + 64 * 136;
    LAS bf16_t* sKET = sQ + 64 * 136;
    LAS bf16_t* sST = sKET + 128 * 72;
    LAS bf16_t* sDT = sST + 32 * 136;
    LAS bf16_t* sU = sDT + 32 * 72;
    for (int u = vcu; u < 256; u += G) {
        const int bh = u >> 2, jv = u & 3, b = bh >> 4, h = bh & 15;
        f32x16 S = zero16();
        u32x4 rW[2], rQ[2], rK[2], rU; float rg = 0.f; int zoff = 0; asm volatile("" : "+v"(zoff));
        rU = (u32x4){0u, 0u, 0u, 0u};
#define SCAN_PREFETCH(nn) do { const size_t chn = (size_t)bh * 32 + (nn); \
            _Pragma("unroll") for (int it = 0; it < 2; ++it) { const int idx = tidp + it * 512, c = idx >> 4, g = idx & 15; const size_t go = (chn * 64 + c) * 128 + 8 * g; \
                rW[it] = *(const u32x4*)(GW + go); rQ[it] = *(const u32x4*)(GQ + go); rK[it] = *(const u32x4*)(GKE + go); } \
            if (tidp < 256) rU = *(const u32x4*)(GU + (chn * 64 + (tidp >> 2)) * 128 + jv * 32 + 8 * (tidp & 3)); \
            rg = GG[chn + zoff]; } while (0)
        { int tidp = tid_in; asm volatile("" : "+v"(tidp)); SCAN_PREFETCH(0); }
        for (int n = 0; n < 32; ++n) {
            int tid = tid_in; asm volatile("" : "+v"(tid)); const int lane = tid & 63, w = __builtin_amdgcn_readfirstlane(tid >> 6), r = lane & 31, hh = lane >> 5;
            const int t0 = b * 2048 + n * 64;
#pragma unroll
            for (int it = 0; it < 2; ++it) { const int idx = tid + it * 512, c = idx >> 4, g = idx & 15;
                *(LAS u32x4*)(sW + c * 136 + 8 * g) = rW[it]; *(LAS u32x4*)(sQ + c * 136 + 8 * g) = rQ[it];
#pragma unroll
                for (int e = 0; e < 4; ++e) { sKET[(8 * g + 2 * e) * 72 + c] = (bf16_t)(rK[it][e] & 0xffffu); sKET[(8 * g + 2 * e + 1) * 72 + c] = (bf16_t)(rK[it][e] >> 16); } }
            if (tid < 256) *(LAS u32x4*)(sU + (tid >> 2) * 40 + 8 * (tid & 3)) = rU;
            if (n == 0 && w < 4) {
#pragma unroll
                for (int g4 = 0; g4 < 4; ++g4) { u32x2 a; a.x = 0u; a.y = 0u; *(LAS u32x2*)(sST + r * 136 + 32 * w + 8 * g4 + 4 * hh) = a; } }
            const float cg_ = rg;
            LBAR();
            if (n < 31) { const int tidp = tid; SCAN_PREFETCH(n + 1); }
            if (w >= 4) { const int blane = lane; BG_STEP(bd0, bv0, bh0); }
            if (w < 2) { f32x16 acc = zero16(); mma32(acc, sW + 32 * w * 136, 136, sST, 136, 128, lane);
#pragma unroll
                for (int g4 = 0; g4 < 4; ++g4) { const int c = 32 * w + 8 * g4 + 4 * hh; const LAS bf16_t* up = sU + c * 40 + r;
                    u32x2 a; a.x = pk(bf2f(up[0]) - acc[4 * g4], bf2f(up[40]) - acc[4 * g4 + 1]); a.y = pk(bf2f(up[80]) - acc[4 * g4 + 2], bf2f(up[120]) - acc[4 * g4 + 3]);
                    *(LAS u32x2*)(sDT + r * 72 + c) = a; } }
            LBAR();
            if (w < 4) { f32x16 s2 = S * cg_; mma32(s2, sKET + 32 * w * 72, 72, sDT, 72, 64, lane); S = s2;
#pragma unroll
                for (int g4 = 0; g4 < 4; ++g4) { u32x2 a; a.x = pk(S[4 * g4], S[4 * g4 + 1]); a.y = pk(S[4 * g4 + 2], S[4 * g4 + 3]); *(LAS u32x2*)(sST + r * 136 + 32 * w + 8 * g4 + 4 * hh) = a; } }
            LBAR();
            if (w >= 4) { const int blane = lane; BG_STEP(bd1, bv1, bh1); }
            if (w < 2) { f32x16 acc = zero16(); mma32(acc, sQ + 32 * w * 136, 136, sST, 136, 128, lane);
#pragma unroll
                for (int reg = 0; reg < 16; ++reg) { const int c = 32 * w + ROWMAP(reg, hh); O[(size_t)(t0 + c) * 2048 + h * 128 + jv * 32 + r] = bf1(acc[reg]); } }
            LBAR();
        }
#undef SCAN_PREFETCH
    }
    if (wq >= 4) { int blane = tid_in & 63; asm volatile("" : "+v"(blane)); while (bh0 || bh1) { BG_STEP(bd0, bv0, bh0); BG_STEP(bd1, bv1, bh1); } }
#undef BG_ISSUE
#undef BG_STEP
}
__device__ __forceinline__ void gdn_hn_phase(const bf16_t* __restrict__ O, const float* __restrict__ gain, const bf16_t* __restrict__ PROJ, bf16_t* __restrict__ ON, int gw, int NGW, int lane) {
    for (int t = gw; t < T; t += NGW) {
        f32x4 v[4][2]; u32x4 zt[4]; float ss[4];
#pragma unroll
        for (int j = 0; j < 4; ++j) { const int col = 8 * lane + 512 * j;
            const u32x4 ov = *(const u32x4*)(O + (size_t)t * 2048 + col); zt[j] = *(const u32x4*)(PROJ + (size_t)t * NP_GDN + 6144 + col);
            v[j][0] = (f32x4){bflo(ov.x), bfhi(ov.x), bflo(ov.y), bfhi(ov.y)}; v[j][1] = (f32x4){bflo(ov.z), bfhi(ov.z), bflo(ov.w), bfhi(ov.w)};
            ss[j] = ((v[j][0][0] * v[j][0][0] + v[j][0][1] * v[j][0][1]) + (v[j][0][2] * v[j][0][2] + v[j][0][3] * v[j][0][3])) + ((v[j][1][0] * v[j][1][0] + v[j][1][1] * v[j][1][1]) + (v[j][1][2] * v[j][1][2] + v[j][1][3] * v[j][1][3])); }
#pragma unroll
        for (int o = 1; o < 16; o <<= 1) {
#pragma unroll
            for (int j = 0; j < 4; ++j) ss[j] += __shfl_xor(ss[j], o); }
        const f32x4 g0 = *(const f32x4*)(gain + ((8 * lane) & 127)), g1 = *(const f32x4*)(gain + ((8 * lane) & 127) + 4);
#pragma unroll
        for (int j = 0; j < 4; ++j) { const int col = 8 * lane + 512 * j; const float rs = rsqrtf(ss[j] * (1.f / 128.f) + 1e-6f); const u32x4 z = zt[j];
            u32x4 o; o.x = pk(v[j][0][0] * rs * g0[0] * siluf_(bflo(z.x)), v[j][0][1] * rs * g0[1] * siluf_(bfhi(z.x)));
            o.y = pk(v[j][0][2] * rs * g0[2] * siluf_(bflo(z.y)), v[j][0][3] * rs * g0[3] * siluf_(bfhi(z.y)));
            o.z = pk(v[j][1][0] * rs * g1[0] * siluf_(bflo(z.z)), v[j][1][1] * rs * g1[1] * siluf_(bfhi(z.z)));
            o.w = pk(v[j][1][2] * rs * g1[2] * siluf_(bflo(z.w)), v[j][1][3] * rs * g1[3] * siluf_(bfhi(z.w)));
            *(u32x4*)(ON + (size_t)t * 2048 + col) = o; }
    }
}

__device__ __forceinline__ void gla_pre_phase(LAS unsigned char* lds, const bf16_t* __restrict__ PROJ, const float* __restrict__ SM, const float* __restrict__ wg,
                                              const float* __restrict__ gbias, bf16_t* __restrict__ GQI, bf16_t* __restrict__ GKBT, bf16_t* __restrict__ GS, float* __restrict__ GE,
                                              int vcu, int G, int tid_in) {
    constexpr int LDP = NP_GLA;
    LAS bf16_t* bufA = (LAS bf16_t*)lds;
    LAS bf16_t* bufB = bufA + 64 * 264;
    LAS bf16_t* sKbT = bufB + 64 * 264;
    LAS bf16_t* sS = sKbT + 256 * 72;
    LAS float* sTot = (LAS float*)(sS + 64 * 72);
    LAS float* sGL = sTot + 512;
    for (int u = vcu; u < 512; u += G) {
        int tid = tid_in; asm volatile("" : "+v"(tid)); const int lane = tid & 63, w = __builtin_amdgcn_readfirstlane(tid >> 6), r = lane & 31, hh = lane >> 5;
        const int dk = tid & 255, half = tid >> 8;
        const int bh = u >> 5, n = u & 31, b = bh >> 2, h = bh & 3, t0 = b * 2048 + n * 64;
        float wgc[16];
#pragma unroll
        for (int q = 0; q < 16; ++q) wgc[q] = wg[q * 1024 + h * 256 + dk];
        const float gb = gbias[h * 256 + dk];
        u32x4 qraw[4], kraw[4];
#pragma unroll
        for (int it = 0; it < 4; ++it) { const int idx = tid + it * 512, c = idx >> 5, g = idx & 31; const bf16_t* pr = PROJ + (size_t)(t0 + c) * LDP + h * 256 + 8 * g;
            qraw[it] = *(const u32x4*)pr; kraw[it] = *(const u32x4*)(pr + 1024); }
        if (tid < 256) *(LAS f32x4*)(sGL + (tid >> 2) * 16 + 4 * (tid & 3)) = *(const f32x4*)(SM + (size_t)(t0 + (tid >> 2)) * 32 + 4 * (tid & 3));
#pragma unroll
        for (int it = 0; it < 4; ++it) { const int idx = tid + it * 512, c = idx >> 5, g = idx & 31; *(LAS u32x4*)(bufA + c * 264 + 8 * g) = qraw[it]; *(LAS u32x4*)(bufB + c * 264 + 8 * g) = kraw[it]; }
        LBAR();
        float cum[32]; float run = 0.f;
#pragma unroll
        for (int i = 0; i < 32; ++i) { const int c = 32 * half + i; float x = gb;
#pragma unroll
            for (int q = 0; q < 16; ++q) x += sGL[c * 16 + q] * wgc[q];
            const float ls = fminf(x, 0.f) - __logf(1.f + __expf(-fabsf(x))); run += ls * 0.0625f; cum[i] = run;
            if ((i & 7) == 7) __builtin_amdgcn_sched_barrier(0); }
        sTot[half * 256 + dk] = run;
        LBAR();
        const float tot0 = sTot[dk], tot1 = sTot[256 + dk], E0 = __expf(tot0);
        if (half == 0) { GE[(size_t)u * 512 + dk] = __expf(tot1); GE[(size_t)u * 512 + 256 + dk] = __expf(tot0 + tot1); }
        const float off = half ? 0.f : -tot0;
        unsigned pkreg[32]; unsigned kbp[16]; unsigned pkq[16];
#pragma unroll
        for (int i = 0; i < 32; ++i) { const int c = 32 * half + i; const float v = cum[i] + off, e = __expf(v), ei = __expf(-v);
            const float q = bf2f(bufA[c * 264 + dk]) * 0.0625f, k = bf2f(bufB[c * 264 + dk]);
            const unsigned a = pk(q * e, k * ei);
            bufA[c * 264 + dk] = (bf16_t)(a & 0xffffu); bufB[c * 264 + dk] = (bf16_t)(a >> 16);
            if (i & 1) kbp[i >> 1] |= (a & 0xffff0000u); else kbp[i >> 1] = a >> 16;
            const unsigned qi = pk(q * e * E0, 0.f);
            if (i & 1) pkq[i >> 1] |= (qi << 16); else pkq[i >> 1] = qi & 0xffffu;
            pkreg[i] = pk(q * ei, k * e);
            if ((i & 7) == 7) __builtin_amdgcn_sched_barrier(0); }
#pragma unroll
        for (int q = 0; q < 4; ++q) { u32x4 o; o.x = kbp[4 * q]; o.y = kbp[4 * q + 1]; o.z = kbp[4 * q + 2]; o.w = kbp[4 * q + 3]; *(LAS u32x4*)(sKbT + dk * 72 + 32 * half + 8 * q) = o; }
        LBAR();
        f32x16 accA = zero16();
        const int ci = (w & 3) >> 1, mi = w & 1;
        if (w < 4) mma32(accA, bufA + 32 * ci * 264, 264, bufB + 32 * mi * 264, 264, 256, lane);
#pragma unroll
        for (int it = 0; it < 4; ++it) { const int idx = tid + it * 512, d = idx >> 3, g = idx & 7; *(u32x4*)(GKBT + ((size_t)u * 256 + d) * 64 + 8 * g) = *(const LAS u32x4*)(sKbT + d * 72 + 8 * g); }
        LBAR();
#pragma unroll
        for (int i = 0; i < 32; ++i) { const int c = 32 * half + i; bufA[c * 264 + dk] = (bf16_t)(pkreg[i] & 0xffffu); bufB[c * 264 + dk] = (bf16_t)(pkreg[i] >> 16); }
        LBAR();
        if (w < 4) { f32x16 accU = zero16(); mma32(accU, bufA + 32 * ci * 264, 264, bufB + 32 * mi * 264, 264, 256, lane);
#pragma unroll
            for (int reg = 0; reg < 16; ++reg) { const int c = 32 * ci + ROWMAP(reg, hh), m = 32 * mi + r; sS[c * 72 + m] = bf1((c >= m) ? accA[reg] : accU[reg]); } }
        LBAR();
#pragma unroll
        for (int i = 0; i < 32; ++i) { const int c = 32 * half + i; bufA[c * 264 + dk] = (bf16_t)((i & 1) ? (pkq[i >> 1] >> 16) : (pkq[i >> 1] & 0xffffu)); }
        *(u32x4*)(GS + ((size_t)u * 64 + (tid >> 3)) * 64 + 8 * (tid & 7)) = *(const LAS u32x4*)(sS + (tid >> 3) * 72 + 8 * (tid & 7));
        LBAR();
#pragma unroll
        for (int it = 0; it < 4; ++it) { const int idx = tid + it * 512, c = idx >> 5, g = idx & 31; *(u32x4*)(GQI + ((size_t)u * 64 + c) * 256 + 8 * g) = *(const LAS u32x4*)(bufA + c * 264 + 8 * g); }
        LBAR();
    }
}
__device__ __forceinline__ void gla_scan_phase(LAS unsigned char* lds, const bf16_t* __restrict__ PROJ, const bf16_t* __restrict__ GQI, const bf16_t* __restrict__ GKBT,
                                               const bf16_t* __restrict__ GS, const float* __restrict__ GE, bf16_t* __restrict__ O, int vcu, int G, int tid_in) {
    constexpr int LDP = NP_GLA;
    LAS bf16_t* bufA = (LAS bf16_t*)lds;
    LAS bf16_t* sKbT = bufA + 64 * 264;
    LAS bf16_t* sVT = sKbT + 256 * 72;
    LAS bf16_t* sS = sVT + 32 * 72;
    LAS bf16_t* sST = sS + 64 * 72;
    LAS float* sE = (LAS float*)(sST + 32 * 264);
    for (int u = vcu; u < 256; u += G) {
        const int bh = u >> 4, jv = u & 15, b = bh >> 2, h = bh & 3;
        f32x16 S = zero16();
        u32x4 rQ[4], rK[4], rS; f32x4 rE = (f32x4){0.f, 0.f, 0.f, 0.f}; u32x2 vv;
#define GLA_PREFETCH(nn) do { const size_t chn = (size_t)bh * 32 + (nn); const int t0p = b * 2048 + (nn) * 64; \
            _Pragma("unroll") for (int it = 0; it < 4; ++it) { const int idx = tidp + it * 512; \
                rQ[it] = *(const u32x4*)(GQI + (chn * 64 + (idx >> 5)) * 256 + 8 * (idx & 31)); rK[it] = *(const u32x4*)(GKBT + (chn * 256 + (idx >> 3)) * 64 + 8 * (idx & 7)); } \
            rS = *(const u32x4*)(GS + (chn * 64 + (tidp >> 3)) * 64 + 8 * (tidp & 7)); \
            if (tidp < 128) rE = *(const f32x4*)(GE + chn * 512 + 4 * tidp); \
            vv = *(const u32x2*)(PROJ + (size_t)(t0p + (tidp >> 3)) * LDP + 2048 + h * 512 + jv * 32 + 4 * (tidp & 7)); } while (0)
        { int tidp = tid_in; asm volatile("" : "+v"(tidp)); GLA_PREFETCH(0); }
        for (int n = 0; n < 32; ++n) {
            int tid = tid_in; asm volatile("" : "+v"(tid)); const int lane = tid & 63, w = __builtin_amdgcn_readfirstlane(tid >> 6), r = lane & 31, hh = lane >> 5;
            const int t0 = b * 2048 + n * 64;
#pragma unroll
            for (int it = 0; it < 4; ++it) { const int idx = tid + it * 512; *(LAS u32x4*)(bufA + (idx >> 5) * 264 + 8 * (idx & 31)) = rQ[it]; *(LAS u32x4*)(sKbT + (idx >> 3) * 72 + 8 * (idx & 7)) = rK[it]; }
            *(LAS u32x4*)(sS + (tid >> 3) * 72 + 8 * (tid & 7)) = rS;
            if (tid < 128) *(LAS f32x4*)(sE + 4 * tid) = rE;
            { const int c = tid >> 3, g = tid & 7;
              sVT[(4 * g) * 72 + c] = (bf16_t)(vv.x & 0xffffu); sVT[(4 * g + 1) * 72 + c] = (bf16_t)(vv.x >> 16); sVT[(4 * g + 2) * 72 + c] = (bf16_t)(vv.y & 0xffffu); sVT[(4 * g + 3) * 72 + c] = (bf16_t)(vv.y >> 16); }
            if (n == 0) {
#pragma unroll
                for (int g4 = 0; g4 < 4; ++g4) { u32x2 a; a.x = 0u; a.y = 0u; *(LAS u32x2*)(sST + r * 264 + 32 * w + 8 * g4 + 4 * hh) = a; } }
            LBAR();
            if (n < 31) { const int tidp = tid; GLA_PREFETCH(n + 1); }
            if (w == 4 || w == 5) { f32x16 acc = zero16(); mma32(acc, bufA + 32 * (w - 4) * 264, 264, sST, 264, 256, lane); mma32(acc, sS + 32 * (w - 4) * 72, 72, sVT, 72, 64, lane);
#pragma unroll
                for (int reg = 0; reg < 16; ++reg) { const int c = 32 * (w - 4) + ROWMAP(reg, hh); O[(size_t)(t0 + c) * 2048 + h * 512 + jv * 32 + r] = bf1(acc[reg]); } }
            { f32x16 up = zero16(); mma32(up, sKbT + 32 * w * 72, 72, sVT, 72, 64, lane);
#pragma unroll
              for (int reg = 0; reg < 16; ++reg) { const int dkr = 32 * w + ROWMAP(reg, hh); S[reg] = S[reg] * sE[256 + dkr] + sE[dkr] * up[reg]; } }
            LBAR();
#pragma unroll
            for (int g4 = 0; g4 < 4; ++g4) { u32x2 a; a.x = pk(S[4 * g4], S[4 * g4 + 1]); a.y = pk(S[4 * g4 + 2], S[4 * g4 + 3]); *(LAS u32x2*)(sST + r * 264 + 32 * w + 8 * g4 + 4 * hh) = a; }
        }
#undef GLA_PREFETCH
        LBAR();
    }
}
__device__ __forceinline__ float gelu_tanh_(float y) { const float z = 0.7978845608028654f * (y + 0.044715f * y * y * y); const float th = 1.f - 2.f * __builtin_amdgcn_rcpf(1.f + __expf(2.f * z)); return 0.5f * y * (1.f + th); }
__device__ __forceinline__ void lru_phase(LAS unsigned char* lds, const bf16_t* __restrict__ PROJ, const float* __restrict__ conv_w, const float* __restrict__ conv_b,
                                          const bf16_t* __restrict__ WTr, const bf16_t* __restrict__ WTi, const float* __restrict__ b_r, const float* __restrict__ b_i,
                                          const float* __restrict__ lam, bf16_t* __restrict__ ON, int vcu, int G, int tid_in) {
    constexpr int LDP = NP_LRU;
    LAS bf16_t* sX = (LAS bf16_t*)lds;
    LAS bf16_t* sWr = sX + 128 * 136;
    LAS bf16_t* sWi = sWr + 32 * 136;
    LAS float* sXf = (LAS float*)(sWi + 32 * 136);
    LAS float* sA = sXf + 128 * 33;
    LAS float* sM = sA + 128 * 33;
    LAS float* sU = sM + 128 * 33;
    LAS float* sSeg = sU + 128 * 33;
    LAS float* sCarry = sSeg + 1024;
    for (int u = vcu; u < 256; u += G) {
        const int b = u >> 6, nb = (u >> 2) & 15, es = u & 3, ch0 = nb * 128 + es * 32;
        int tidu = tid_in; asm volatile("" : "+v"(tidu));
        { const int tid = tidu; const int e = tid >> 4, g = tid & 15; const size_t go = ((size_t)nb * 128 + es * 32 + e) * 128 + 8 * g;
          *(LAS u32x4*)(sWr + e * 136 + 8 * g) = *(const u32x4*)(WTr + go); *(LAS u32x4*)(sWi + e * 136 + 8 * g) = *(const u32x4*)(WTi + go); }
        float cw[4][2];
#pragma unroll
        for (int tap = 0; tap < 4; ++tap) { cw[tap][0] = conv_w[tap * 2048 + nb * 128 + 2 * (tidu & 63)]; cw[tap][1] = conv_w[tap * 2048 + nb * 128 + 2 * (tidu & 63) + 1]; }
        const float cb0 = conv_b[nb * 128 + 2 * (tidu & 63)], cb1 = conv_b[nb * 128 + 2 * (tidu & 63) + 1];
        if (tidu < 32) sCarry[tidu] = 0.f;
        const float br = b_r[ch0 + (tidu & 31)], bi = b_i[ch0 + (tidu & 31)], c8 = -8.f * log1pf(__expf(-lam[ch0 + (tidu & 31)]));
        for (int tt = 0; tt < 16; ++tt) {
            int tid = tid_in; asm volatile("" : "+v"(tid)); const int lane = tid & 63, w = __builtin_amdgcn_readfirstlane(tid >> 6), r = lane & 31, hh = lane >> 5; (void)r; (void)hh; (void)w; (void)lane;
            const int s0 = tt * 128; const size_t t0 = (size_t)b * 2048 + s0;
            __syncthreads();
            { const int p2 = tid & 63, rg = tid >> 6, col = nb * 128 + 2 * p2;
              float xa[3], xb[3];
#pragma unroll
              for (int k = 0; k < 3; ++k) { const int s = s0 + 16 * rg - 3 + k; unsigned xv = 0u; if (s >= 0) xv = *(const unsigned*)(PROJ + (t0 + 16 * rg - 3 + k) * LDP + col); xa[k] = bflo(xv); xb[k] = bfhi(xv); }
              const bool mine = ((2 * p2) >> 5) == es;
#pragma unroll
              for (int i = 0; i < 16; ++i) { const int row = 16 * rg + i; const unsigned xv = *(const unsigned*)(PROJ + (t0 + row) * LDP + col); const float ca = bflo(xv), cbv = bfhi(xv);
                  const float o0 = cb0 + cw[0][0] * xa[0] + cw[1][0] * xa[1] + cw[2][0] * xa[2] + cw[3][0] * ca;
                  const float o1 = cb1 + cw[0][1] * xb[0] + cw[1][1] * xb[1] + cw[2][1] * xb[2] + cw[3][1] * cbv;
                  *(LAS unsigned*)(sX + row * 136 + 2 * p2) = pk(o0, o1);
                  if (mine) { sXf[row * 33 + ((2 * p2) & 31)] = o0; sXf[row * 33 + ((2 * p2) & 31) + 1] = o1; }
                  xa[0] = xa[1]; xa[1] = xa[2]; xa[2] = ca; xb[0] = xb[1]; xb[1] = xb[2]; xb[2] = cbv; } }
            __syncthreads();
            { f32x16 acc = zero16(); const int rt = w & 3;
              if (w < 4) { mma32(acc, sX + 32 * rt * 136, 136, sWr, 136, 128, lane);
#pragma unroll
                  for (int reg = 0; reg < 16; ++reg) { const int row = 32 * rt + ROWMAP(reg, hh); const float la = c8 * sigmoidf_(acc[reg] + br); const float av = __expf(la); sA[row * 33 + r] = av; sM[row * 33 + r] = __builtin_amdgcn_sqrtf(fmaxf(1.f - av * av, 0.f)); } }
              else { mma32(acc, sX + 32 * rt * 136, 136, sWi, 136, 128, lane);
#pragma unroll
                  for (int reg = 0; reg < 16; ++reg) { const int row = 32 * rt + ROWMAP(reg, hh); sU[row * 33 + r] = sigmoidf_(acc[reg] + bi) * sXf[row * 33 + r]; } } }
            __syncthreads();
            { const int e = tid & 31, seg = tid >> 5; float A = 1.f, H = 0.f; float av[8], uv[8];
#pragma unroll
              for (int i = 0; i < 8; ++i) { const int t = seg * 8 + i; av[i] = sA[t * 33 + e]; uv[i] = sM[t * 33 + e] * sU[t * 33 + e]; H = av[i] * H + uv[i]; A *= av[i]; }
              sSeg[(seg * 32 + e) * 2] = A; sSeg[(seg * 32 + e) * 2 + 1] = H;
              __syncthreads();
              float hin = sCarry[e]; float sa_[15], sh_[15];
#pragma unroll
              for (int s2 = 0; s2 < 15; ++s2) { sa_[s2] = sSeg[(s2 * 32 + e) * 2]; sh_[s2] = sSeg[(s2 * 32 + e) * 2 + 1]; }
#pragma unroll
              for (int s2 = 0; s2 < 15; ++s2) hin = (s2 < seg) ? sa_[s2] * hin + sh_[s2] : hin;
#pragma unroll
              for (int i = 0; i < 8; ++i) { hin = av[i] * hin + uv[i]; const size_t t = t0 + seg * 8 + i;
                  const float y = bf2f(PROJ[t * LDP + 2048 + ch0 + e]); ON[t * 2048 + ch0 + e] = bf1(hin * gelu_tanh_(y)); }
              __syncthreads();
              if (seg == 15) sCarry[e] = hin; }
        }
        __syncthreads();
    }
}

#define XB_TMO      128
#define XB_XCNT(j)  (256  + 64 * (j))
#define XB_XSUB(j)  (1280 + 64 * (j))
#define XB_XGEN(j)  (2304 + 64 * (j))
#define XB_TOP      3328
#define XB_TOPGEN   3392
#define XCD_BAR_WORDS 3456
#define XB_SPIN_CAP (1u << 18)

__device__ __forceinline__ unsigned xb_ld(unsigned* p)              { return __hip_atomic_load(p, __ATOMIC_RELAXED, __HIP_MEMORY_SCOPE_AGENT); }
__device__ __forceinline__ unsigned xb_add(unsigned* p, unsigned v) { return __hip_atomic_fetch_add(p, v, __ATOMIC_RELAXED, __HIP_MEMORY_SCOPE_AGENT); }
__device__ __forceinline__ unsigned xb_xcc_id() { return (unsigned)__builtin_amdgcn_s_getreg((3 << 11) | 20) & 0xFu; }
#define XB_SPIN(cond, bar) do { unsigned _sp = 0; while (cond) { __builtin_amdgcn_s_sleep(1); \
    if ((++_sp & 255u) == 0u) { if (xb_ld(&(bar)[XB_TMO])) break; if (_sp > XB_SPIN_CAP) { atomicAdd(&(bar)[XB_TMO], 1u); break; } } } } while (0)

struct XcdBarrier {
    unsigned* bar; unsigned x;
    volatile LAS unsigned* st;
};

__device__ __forceinline__ XcdBarrier xcd_barrier_post(unsigned* bar, volatile LAS unsigned* st) {
    XcdBarrier b; b.bar = bar; b.x = xb_xcc_id(); b.st = st;
    if (threadIdx.x == 0) (void)xb_add(&bar[XB_XCNT(b.x)], 1u);
    return b;
}
__device__ __forceinline__ void xcd_barrier_complete(unsigned* bar, unsigned x, unsigned& nloc, unsigned& nx) {
    const unsigned G = gridDim.x * gridDim.y * gridDim.z;
    unsigned sum, cnt, mine, sp = 0u;
    for (;;) {
        sum = 0u; cnt = 0u; mine = 0u;
#pragma unroll
        for (unsigned j = 0; j < 16; ++j) { const unsigned c = xb_ld(&bar[XB_XCNT(j)]); sum += c; cnt += (c > 0u) ? 1u : 0u; mine = (j == x) ? c : mine; }
        if (sum == G) break;
        __builtin_amdgcn_s_sleep(1);
        if ((++sp & 255u) == 0u) { if (xb_ld(&bar[XB_TMO])) break; if (sp > XB_SPIN_CAP) { atomicAdd(&bar[XB_TMO], 1u); break; } }
    }
    nloc = mine > 0u ? mine : 1u; nx = cnt > 0u ? cnt : 1u;
}

__device__ __forceinline__ void xcd_barrier(const XcdBarrier& b) {
    asm volatile("s_waitcnt vmcnt(0)" ::: "memory");
    __syncthreads();
    if (threadIdx.x == 0) {
        unsigned* bar = b.bar;
        __builtin_amdgcn_s_waitcnt(0);
        unsigned nloc = b.st[0], nx = b.st[1];
        if (nloc == 0u) { xcd_barrier_complete(bar, b.x, nloc, nx); b.st[0] = nloc; b.st[1] = nx; }
        const unsigned old = xb_add(&bar[XB_XSUB(b.x)], 1u);
        const unsigned gen = old / nloc;
        if (old + 1u == (gen + 1u) * nloc) {
            __builtin_amdgcn_fence(__ATOMIC_RELEASE, "agent");
            asm volatile("s_waitcnt vmcnt(0)" ::: "memory");
            const unsigned og = xb_add(&bar[XB_TOP], 1u);
            const unsigned tg = og / nx;
            if (og + 1u == (tg + 1u) * nx) xb_add(&bar[XB_TOPGEN], 1u);
            else XB_SPIN(xb_ld(&bar[XB_TOPGEN]) == tg, bar);
            __builtin_amdgcn_fence(__ATOMIC_ACQUIRE, "agent");
            xb_add(&bar[XB_XGEN(b.x)], 1u);
            asm volatile("s_waitcnt vmcnt(0)" ::: "memory");
        } else {
            XB_SPIN(xb_ld(&bar[XB_XGEN(b.x)]) == gen, bar);
            __builtin_amdgcn_fence(__ATOMIC_ACQUIRE, "agent");
            asm volatile("s_waitcnt vmcnt(0)" ::: "memory");
        }
    }
    __syncthreads();
}

template <class Epi> __device__ __forceinline__ void run_gemm(LAS unsigned char* lds, const bf16_t* A, const bf16_t* Bt, int N, int K, const Epi& E) {
    pg8::Gemm g{A, Bt, T, N, K}; pg8::StaticOrder S; S.init(T, N, (int)gridDim.x, (int)blockIdx.x);
    pg8::gemm_phase<Epi, pg8::StaticOrder, true, true>(lds, g, S, E);
}
template <class Epi> __device__ __forceinline__ void run_gemm_rstd(LAS unsigned char* lds, const bf16_t* A, const bf16_t* Bt, int N, int K, const Epi& E, const float* RSS, LAS float* ldsr) {
    pg8::Gemm g{A, Bt, T, N, K}; pg8::RstdOrder S; S.init(T, N, (int)gridDim.x, (int)blockIdx.x); S.RSS = RSS; S.ldsr = ldsr; S.na = 0;
    pg8::gemm_phase<Epi, pg8::RstdOrder, true, true>(lds, g, S, E);
}
#define GRID_SYNC_CG() do { asm volatile("s_waitcnt vmcnt(0) lgkmcnt(0)" ::: "memory"); grid.sync(); \
    if (wave == 0) { __builtin_amdgcn_fence(__ATOMIC_ACQUIRE, "agent"); asm volatile("s_waitcnt vmcnt(0)" ::: "memory"); } \
    asm volatile("" ::: "memory"); __builtin_amdgcn_s_barrier(); asm volatile("" ::: "memory"); } while (0)
#define GRID_SYNC() xcd_barrier(xbar)
__global__ void __launch_bounds__(NTHR, 2) fwd_kernel(Params p) {
    extern __shared__ __attribute__((aligned(16))) unsigned char lds_raw[];
    LAS unsigned char* lds = (LAS unsigned char*)lds_raw;
    cg::grid_group grid = cg::this_grid();
    const int tid = threadIdx.x, lane = tid & 63, wave = __builtin_amdgcn_readfirstlane(tid >> 6);
    const int G = gridDim.x, bx = blockIdx.x, vcu = (G % 8 == 0) ? (bx % 8) * (G / 8) + bx / 8 : bx;
    const int gw = vcu * 8 + wave, NGW = G * 8;
    unsigned char* ws = p.ws;
    float* X = p.out;
    bf16_t* XN = (bf16_t*)(ws + OFF_XN); bf16_t* PROJ = (bf16_t*)(ws + OFF_PROJ); float* SM = (float*)(ws + OFF_SM);
    bf16_t* O = (bf16_t*)(ws + OFF_O); bf16_t* ON = (bf16_t*)(ws + OFF_ON);
    volatile LAS unsigned* xst = (volatile LAS unsigned*)(lds + LDS_BYTES - 64);
    if (tid == 0) { xst[0] = 0u; xst[1] = 0u; }
    __syncthreads();
    const XcdBarrier xbar = xcd_barrier_post((unsigned*)(ws + OFF_BAR), xst);

#define STAMP(id) do { } while (0)
    p0_phase(p, lds, gw, NGW, wave, lane);
    rmsnorm_phase(inptr<0>(), inptr<1>(), XN, nullptr, nullptr, gw, NGW, lane);
    GRID_SYNC_CG(); STAMP(0);
    for (int hb = 0; hb < HBMAX; ++hb) {
        const int L = hb >> 1, half = hb & 1;
        int tq = tid; asm volatile("" : "+v"(tq)); const int lane = tq & 63;
        {
            const bf16_t* Bt; int N; pg8::EpiBf E; E.O = PROJ; E.SM = SM; E.slo = 0; E.shi = 0; E.relu2 = half;
            if (half) { Bt = (const bf16_t*)(ws + OFF_WT_UP + L * SZ_L); N = FF; }
            else if (L == 0) { Bt = (const bf16_t*)(ws + OFF_WT_RET_IN); N = NP_RET; }
            else if (L == 1) { Bt = (const bf16_t*)(ws + OFF_WT_GDN_IN); N = NP_GDN; E.slo = 8192; E.shi = 8224; }
            else if (L == 2) { Bt = (const bf16_t*)(ws + OFF_WT_GLA_IN); N = NP_GLA; E.slo = 6144; E.shi = 6160; }
            else { Bt = (const bf16_t*)(ws + OFF_WT_LRU_IN); N = NP_LRU; }
            E.ldo = N; E.ldsr = (const LAS float*)(lds + 131072); E.ne = 0;
#if PH_GEMM
            run_gemm_rstd(lds, XN, Bt, N, D, E, (const float*)(ws + OFF_RSS), (LAS float*)(lds + 131072));
#endif
        }
        GRID_SYNC(); STAMP(1);
        int K2 = FF;
        if (!half) {
            K2 = D;
            if (L == 0) {
#if PH_RET
                ret_pre_phase(lds, PROJ, (const float*)(ws + OFF_ROPE), (const float*)(ws + OFF_ROPE) + 2048 * 128, (bf16_t*)(ws + OFF_GQ), (bf16_t*)(ws + OFF_GKE), (bf16_t*)(ws + OFF_GU), vcu, G, tid);
                GRID_SYNC(); STAMP(13);
                ret_scan_phase(lds, PROJ, (const bf16_t*)(ws + OFF_GQ), (const bf16_t*)(ws + OFF_GKE), (const bf16_t*)(ws + OFF_GU), O, ws, vcu, G, tid);
#endif
                GRID_SYNC(); STAMP(2);
                hn512_phase<true>(O, 4096, 8, inptr<5>(), PROJ, NP_RET, 8192, ON, gw, NGW, lane);
                K2 = 4096;
            } else if (L == 1) {
#if PH_GDN
                gdn_prep_phase(lds, PROJ, SM, inptr<8>(), inptr<9>(), inptr<10>(), (bf16_t*)(ws + OFF_GQ), (bf16_t*)(ws + OFF_GKE), (bf16_t*)(ws + OFF_GU), (bf16_t*)(ws + OFF_GW), (float*)(ws + OFF_GG), vcu, G, tid);
#endif
                GRID_SYNC(); STAMP(4);
#if PH_GDN2
                gdn_scan_phase(lds, (const bf16_t*)(ws + OFF_GQ), (const bf16_t*)(ws + OFF_GKE), (const bf16_t*)(ws + OFF_GU), (const bf16_t*)(ws + OFF_GW), (const float*)(ws + OFF_GG), O, ws, vcu, G, tid);
#endif
                GRID_SYNC(); STAMP(5);
                gdn_hn_phase(O, inptr<11>(), PROJ, ON, gw, NGW, lane);
            } else if (L == 2) {
#if PH_GLA
                gla_pre_phase(lds, PROJ, SM, inptr<14>(), inptr<15>(), (bf16_t*)(ws + OFF_GQ), (bf16_t*)(ws + OFF_GKE), (bf16_t*)(ws + OFF_GU), (float*)(ws + OFF_GW), vcu, G, tid);
                GRID_SYNC(); STAMP(12);
                gla_scan_phase(lds, PROJ, (const bf16_t*)(ws + OFF_GQ), (const bf16_t*)(ws + OFF_GKE), (const bf16_t*)(ws + OFF_GU), (const float*)(ws + OFF_GW), O, vcu, G, tid);
#endif
                GRID_SYNC(); STAMP(7);
                hn512_phase<false>(O, 2048, 4, inptr<16>(), PROJ, NP_GLA, 4096, ON, gw, NGW, lane);
            } else {
#if PH_LRU
                lru_phase(lds, PROJ, inptr<19>(), inptr<20>(), (const bf16_t*)(ws + OFF_WT_LRU_GR), (const bf16_t*)(ws + OFF_WT_LRU_GI), inptr<22>(), inptr<24>(), inptr<25>(), ON, vcu, G, tid);
#endif
            }
            GRID_SYNC(); STAMP((L == 0 ? 3 : L == 1 ? 6 : L == 2 ? 8 : 9));
        }
        {
            const bf16_t* A2 = half ? PROJ : ON; const bf16_t* Bt;
            if (half) Bt = (const bf16_t*)(ws + OFF_WT_DOWN + L * SZ_L);
            else Bt = (const bf16_t*)(ws + (L == 0 ? OFF_WT_RET_OUT : L == 1 ? OFF_WT_GDN_OUT : L == 2 ? OFF_WT_GLA_OUT : OFF_WT_LRU_OUT));
            pg8::EpiRes E; E.X = X; E.Xr = (hb == 0) ? inptr<0>() : (const float*)X; E.ldx = D; E.XG = XN; E.RSS = (float*)(ws + OFF_RSS);
            E.g = (hb == HBMAX - 1) ? inptr<3>() : (half ? inptr<1>() + (L + 1) * D : inptr<2>() + L * D);
#if PH_GEMM
            run_gemm(lds, A2, Bt, D, K2, E);
#endif
        }
        GRID_SYNC(); STAMP(10);
        if (hb == HBMAX - 1) { rmsnorm_phase(X, inptr<3>(), nullptr, nullptr, X, gw, NGW, lane); GRID_SYNC(); STAMP(11); }
    }

}

extern "C" void kernel_launch(void* const* d_in, const int* in_sizes, int n_in, void* d_out, int out_size, void* d_ws, size_t ws_size, hipStream_t stream) {
    static int grid_blocks = 0;
    if (!grid_blocks) {
        int dev = 0, cus = 0, per_cu = 0;
        hipGetDevice(&dev);
        hipDeviceGetAttribute(&cus, hipDeviceAttributeMultiprocessorCount, dev);
        hipFuncSetAttribute((const void*)fwd_kernel, hipFuncAttributeMaxDynamicSharedMemorySize, LDS_BYTES);
        hipOccupancyMaxActiveBlocksPerMultiprocessor(&per_cu, (const void*)fwd_kernel, NTHR, LDS_BYTES);
        if (per_cu < 1) { fprintf(stderr, "kernel_launch: occupancy query says %d blocks/CU\n", per_cu); per_cu = 1; }
        grid_blocks = cus * 1;
        if (ws_size < WS_END) fprintf(stderr, "kernel_launch: workspace too small: %zu < %zu\n", ws_size, (size_t)WS_END);
        if (n_in != 29) fprintf(stderr, "kernel_launch: expected 29 inputs, got %d\n", n_in);
    }
    Params p{};
    for (int i = 0; i < 29; ++i) p.in[i] = (const float*)d_in[i];
    p.out = (float*)d_out; p.ws = (unsigned char*)d_ws;
    (void)hipMemsetAsync((unsigned char*)d_ws + OFF_BAR, 0, XCD_BAR_WORDS * 4, stream);
    void* args[] = {&p};
    hipError_t e = hipLaunchCooperativeKernel((const void*)fwd_kernel, dim3(grid_blocks), dim3(NTHR), args, LDS_BYTES, stream);
    if (e != hipSuccess) fprintf(stderr, "cooperative launch failed: %s (grid %d)\n", hipGetErrorString(e), grid_blocks);
}
```
